# Optimizing an MI355X kernel written in HIP

```python
import math
import jax
import jax.numpy as jnp
from jax import lax
import numpy as np

D_MODEL = 1024
BATCH = 8
SEQ = 2048
DEPTH = 2

GRID_W = 64
CTX_LEN = 256
NORM_EPS = 1e-6
ROPE_BASE = 10000.0

RW_HEADS = 6
RW_HEAD_DIM = 64
RW_WIDTH = RW_HEADS * RW_HEAD_DIM
RW_DECAY_LORA = 64
RW_ICLR_LORA = 64
RW_GATE_LORA = 128
RW_GN_EPS = 64e-5
RW_IN = 3 * RW_WIDTH + 2 * RW_DECAY_LORA + 2 * RW_ICLR_LORA + RW_GATE_LORA
RW_SPLITS = (RW_WIDTH, 2 * RW_WIDTH, 3 * RW_WIDTH, 3 * RW_WIDTH + 2 * RW_DECAY_LORA,
             3 * RW_WIDTH + 2 * RW_DECAY_LORA + 2 * RW_ICLR_LORA)

HY_WIDTH = 256
HY_ORDER = 2
HY_SHORT_K = 3
HY_EMB_DIM = 33
HY_FILTER_HIDDEN = 64
HY_DECAY_TARGET = 1e-2
HY_FAST_DECAY = 0.3
HY_SLOW_DECAY = 1.5
HY_IN = (HY_ORDER + 1) * HY_WIDTH

NA_HEADS = 6
NA_HEAD_DIM = 64
NA_WIDTH = NA_HEADS * NA_HEAD_DIM
NA_WIN_ROWS = 8
NA_WIN_COLS = 16
NA_IN = 3 * NA_WIDTH

N_BRANCH = 3
GATE_IN = N_BRANCH * D_MODEL
P_IN = RW_IN + HY_IN + NA_IN + GATE_IN
IN_SPLITS = (RW_IN, RW_IN + HY_IN, RW_IN + HY_IN + NA_IN)

FF_DENSE = 2816
N_EXPERTS = 8
TOP_K = 2
FF_EXPERT = 3584
N_DENSE_LAYERS = (DEPTH + 1) // 2
N_MOE_LAYERS = DEPTH // 2

kernel_name = 'hybrid_rwkv7_hyena_natten_moe_dit'


def rms_norm(x, g, eps=NORM_EPS):
    xf = x.astype(jnp.float32)
    y = xf * lax.rsqrt(jnp.mean(xf * xf, axis=-1, keepdims=True) + eps)
    return (y * g.astype(jnp.float32)).astype(x.dtype)


def modulate(h, shift, scale):
    return h * (1 + scale) + shift


def centred_token_shift(u, mu):
    zero = jnp.zeros_like(u[:, :1])
    prev = jnp.concatenate([zero, u[:, :-1]], axis=1)
    nxt = jnp.concatenate([u[:, 1:], zero], axis=1)
    return u + mu[0] * (prev - u) + mu[1] * (nxt - u)


def centred_depthwise_conv(u, w, b):
    k = w.shape[0]
    pad = k // 2
    n = u.shape[1]
    up = jnp.pad(u, ((0, 0), (pad, pad), (0, 0)))
    out = b
    for j in range(k):
        out = out + w[j] * up[:, j:j + n]
    return out


def axial_rope(u):
    n, dh = u.shape[1], u.shape[-1]
    half = dh // 2
    nf = half // 2
    t = jnp.arange(n)
    inv = ROPE_BASE ** (-jnp.arange(nf, dtype=jnp.float32) / nf)
    uf = u.astype(jnp.float32)

    def rot(z, pos):
        ang = pos.astype(jnp.float32)[:, None] * inv
        cos = jnp.cos(ang)[None, :, None, :]
        sin = jnp.sin(ang)[None, :, None, :]
        z1, z2 = z[..., :nf], z[..., nf:]
        return jnp.concatenate([z1 * cos - z2 * sin, z1 * sin + z2 * cos], axis=-1)

    out = jnp.concatenate([rot(uf[..., :half], t // GRID_W), rot(uf[..., half:], t % GRID_W)], axis=-1)
    return out.astype(u.dtype)


def rwkv7_scan(r, w, k, v, a, b, s0):
    def step(S, inp):
        r_t, w_t, k_t, v_t, a_t, b_t = inp
        sa = jnp.einsum('bhvk,bhk->bhv', S, a_t)
        S = S * w_t[:, :, None, :] + sa[..., None] * b_t[:, :, None, :] + v_t[..., None] * k_t[:, :, None, :]
        return S, jnp.einsum('bhvk,bhk->bhv', S, r_t)

    xs = tuple(jnp.swapaxes(z, 0, 1) for z in (r, w, k, v, a, b))
    s_fin, ys = lax.scan(step, s0, xs)
    return jnp.swapaxes(ys, 0, 1), s_fin


def rwkv7_features(u, shift_mu, w0, w2, a0, a2, g2, k_k, k_a, use_rope):
    bsz, n, _ = u.shape
    heads = lambda z: z.reshape(bsz, n, RW_HEADS, RW_HEAD_DIM)
    u = centred_token_shift(u.astype(jnp.float32), shift_mu)
    r, k, v, lw, la, lg = jnp.split(u, RW_SPLITS, axis=-1)
    r, k, v = heads(r), heads(k), heads(v)
    if use_rope:
        r, k = axial_rope(r), axial_rope(k)
    g = jax.nn.sigmoid(lg) @ g2
    kk = k * k_k.reshape(RW_HEADS, RW_HEAD_DIM)
    kk = kk / jnp.maximum(jnp.sqrt(jnp.sum(kk * kk, axis=-1, keepdims=True)), 1e-12)
    lw = lw.reshape(bsz, n, 2, RW_DECAY_LORA)
    la = la.reshape(bsz, n, 2, RW_ICLR_LORA)
    k_a = k_a.reshape(RW_HEADS, RW_HEAD_DIM)
    per_dir = []
    for d in range(2):
        w_log = -jax.nn.softplus(-(w0[d] + jnp.tanh(lw[:, :, d]) @ w2[d])) - 0.5
        iclr = heads(jax.nn.sigmoid(a0[d] + la[:, :, d] @ a2[d]))
        per_dir.append((heads(jnp.exp(-jnp.exp(w_log))), k * (1 + (iclr - 1) * k_a), kk * iclr))
    return r, v, kk, g, per_dir


def rwkv7_direction(feats, d, s0):
    r, v, kk, _, per_dir = feats
    decay, k_d, b_d = per_dir[d]
    seq = (r, decay, k_d, v, -kk, b_d)
    if d == 1:
        seq = tuple(jnp.flip(z, axis=1) for z in seq)
    y, s_fin = rwkv7_scan(*seq, s0)
    if d == 1:
        y = jnp.flip(y, axis=1)
    return y, s_fin


def rwkv7_readout(feats, y, r_k, gn_g, gn_b):
    r, v, _, g, per_dir = feats
    bsz, n = r.shape[:2]
    mu = jnp.mean(y, axis=-1, keepdims=True)
    var = jnp.mean(jnp.square(y - mu), axis=-1, keepdims=True)
    yn = ((y - mu) * lax.rsqrt(var + RW_GN_EPS)).reshape(bsz, n, RW_WIDTH) * gn_g + gn_b
    k_sum = per_dir[0][1] + per_dir[1][1]
    bonus = jnp.sum(r * k_sum * r_k, axis=-1, keepdims=True) * v
    return (yn + bonus.reshape(bsz, n, RW_WIDTH)) * g


def rwkv7_mixer(u_ctx, u_lat, shift_mu, w0, w2, a0, a2, g2, k_k, k_a, r_k, gn_g, gn_b, with_ctx):
    args = (shift_mu, w0, w2, a0, a2, g2, k_k, k_a)
    f_ctx = rwkv7_features(u_ctx, *args, use_rope=False)
    f_lat = rwkv7_features(u_lat, *args, use_rope=True)
    s0 = jnp.zeros((u_lat.shape[0], RW_HEADS, RW_HEAD_DIM, RW_HEAD_DIM), jnp.float32)
    y_ctx, y_lat = 0.0, 0.0
    for d in range(2):
        yc, s_ctx = rwkv7_direction(f_ctx, d, s0)
        yl, _ = rwkv7_direction(f_lat, d, s_ctx)
        y_ctx = y_ctx + yc
        y_lat = y_lat + yl
    out_lat = rwkv7_readout(f_lat, y_lat, r_k, gn_g, gn_b)
    out_ctx = rwkv7_readout(f_ctx, y_ctx, r_k, gn_g, gn_b) if with_ctx else None
    return out_ctx, out_lat


def hyena_filters(n, w1, b1, w2, b2, w3, freq):
    pos = jnp.arange(n, dtype=jnp.float32)
    t = pos / max(n - 1, 1)
    bands = (HY_EMB_DIM - 1) // 2
    f = jnp.linspace(1e-4, bands - 1, bands, dtype=jnp.float32)
    ang = (2 * math.pi / n) * pos[:, None] * f[None, :]
    z = jnp.concatenate([t[:, None], jnp.cos(ang), -jnp.sin(ang)], axis=-1)
    h = jnp.sin(freq * (z @ w1 + b1))
    h = jnp.sin(freq * (h @ w2 + b2))
    h = (h @ w3).astype(jnp.float32).reshape(n, HY_ORDER, 2, HY_WIDTH)
    max_decay = math.log(HY_DECAY_TARGET) / HY_FAST_DECAY
    min_decay = math.log(HY_DECAY_TARGET) / HY_SLOW_DECAY
    deltas = jnp.abs(jnp.linspace(min_decay, max_decay, HY_WIDTH, dtype=jnp.float32))
    h = h * jnp.exp(-t[:, None] * deltas)[:, None, None, :]
    h_fwd = h[:, :, 0]
    h_bwd = h[1:, :, 1]
    l1 = jnp.sum(jnp.abs(h_fwd), axis=0) + jnp.sum(jnp.abs(h_bwd), axis=0)
    filt = jnp.concatenate([h_fwd, jnp.zeros_like(h_fwd[:1]), h_bwd[::-1]], axis=0) / l1
    return jnp.moveaxis(filt, 1, 0)


def fft_long_conv(z, filt):
    n = z.shape[1]
    zf = jnp.fft.rfft(z, n=2 * n, axis=1)
    hf = jnp.fft.rfft(filt, n=2 * n, axis=0)
    return jnp.fft.irfft(zf * hf[None], n=2 * n, axis=1)[:, :n]


def hyena_sequence(u, conv_w, conv_b, w1, b1, w2, b2, w3, freq, skip):
    n = u.shape[1]
    u = centred_depthwise_conv(u, conv_w, conv_b).astype(jnp.float32)
    streams = jnp.split(u, HY_ORDER + 1, axis=-1)
    filt = hyena_filters(n, w1, b1, w2, b2, w3, freq)
    z = streams[0]
    for o in range(HY_ORDER):
        z = streams[o + 1] * (fft_long_conv(z, filt[o]) + skip[o] * z)
    return z


def neighbourhood_attention(u_ctx, u_lat, q_gain, k_gain, rpb, with_ctx):
    bsz, n, _ = u_lat.shape
    lc = u_ctx.shape[1]
    scale = NA_HEAD_DIM ** -0.5

    def qkv(u):
        q, k, v = (z.reshape(bsz, u.shape[1], NA_HEADS, NA_HEAD_DIM)
                   for z in jnp.split(u.astype(jnp.float32), 3, axis=-1))
        return rms_norm(q, q_gain), rms_norm(k, k_gain), v

    qc, kc, vc = qkv(u_ctx)
    ql, kl, vl = qkv(u_lat)
    out_ctx = None
    if with_ctx:
        p = jax.nn.softmax(jnp.einsum('bqhd,bkhd->bhqk', qc, kc) * scale, axis=-1)
        out_ctx = jnp.einsum('bhqk,bkhd->bqhd', p, vc).reshape(bsz, lc, NA_WIDTH)

    rows = n // GRID_W
    wr = min(NA_WIN_ROWS, rows)
    wc = NA_WIN_COLS
    grid = lambda z: z.reshape(bsz, rows, GRID_W, NA_HEADS, NA_HEAD_DIM)
    ql, kl, vl = grid(ql), grid(kl), grid(vl)
    r_ar = jnp.arange(rows)
    c_ar = jnp.arange(GRID_W)
    r0 = jnp.clip(r_ar - wr // 2, 0, rows - wr)
    c0 = jnp.clip(c_ar - wc // 2, 0, GRID_W - wc)
    row_idx = r0[:, None] + jnp.arange(wr)[None, :]
    kb = jnp.take(kl, row_idx, axis=1)
    vb = jnp.take(vl, row_idx, axis=1)
    s_loc = jnp.einsum('bijhd,birchd->bhijrc', ql, kb) * scale
    dr = row_idx - r_ar[:, None] + NA_WIN_ROWS - 1
    dc = jnp.clip(c_ar[None, :] - c_ar[:, None] + NA_WIN_COLS - 1, 0, 2 * NA_WIN_COLS - 2)
    bias = rpb[:, dr[:, None, :, None], dc[None, :, None, :]]
    in_win = (c_ar[None, :] >= c0[:, None]) & (c_ar[None, :] < c0[:, None] + wc)
    s_loc = jnp.where(in_win[:, None, :], s_loc + bias[None].astype(jnp.float32), -jnp.inf)
    s_ctx = jnp.einsum('bijhd,bkhd->bhijk', ql, kc) * scale
    nloc = wr * GRID_W
    s = jnp.concatenate([s_loc.reshape(bsz, NA_HEADS, rows, GRID_W, nloc), s_ctx], axis=-1)
    p = jax.nn.softmax(s, axis=-1)
    p_loc = p[..., :nloc].reshape(bsz, NA_HEADS, rows, GRID_W, wr, GRID_W)
    o = (jnp.einsum('bhijrc,birchd->bijhd', p_loc, vb)
         + jnp.einsum('bhijk,bkhd->bijhd', p[..., nloc:], vc))
    return out_ctx, o.reshape(bsz, n, NA_WIDTH)


def merge_branches(gate_logits, y_rw, y_hy, y_na, w_rw, w_hy, w_na, w_o):
    g_rw, g_hy, g_na = jnp.split(jax.nn.sigmoid(gate_logits.astype(jnp.float32)), N_BRANCH, axis=-1)
    m = g_rw * (y_rw @ w_rw) + g_hy * (y_hy @ w_hy) + g_na * (y_na @ w_na)
    return m @ w_o


def swiglu(h, w1, w3, w2):
    return (jax.nn.silu(h @ w1) * (h @ w3)) @ w2


def moe_swiglu(h, router, w1, w3, w2):
    logits = (h @ router).astype(jnp.float32)
    top_v, top_i = lax.top_k(logits, TOP_K)
    wts = jax.nn.softmax(top_v, axis=-1)
    gates = jnp.sum(jax.nn.one_hot(top_i, N_EXPERTS, dtype=jnp.float32) * wts[..., None], axis=-2)
    out = jnp.zeros(h.shape, jnp.float32)
    for e in range(N_EXPERTS):
        out = out + gates[..., e:e + 1] * swiglu(h, w1[e], w3[e], w2[e])
    return out.astype(h.dtype)


def setup_inputs(seed: int = 0) -> dict:
    key = jax.random.key(seed)
    keys = iter(jax.random.split(key, 64))
    f32 = jnp.float32
    L, D = DEPTH, D_MODEL

    def nrm(shape, scale):
        return jax.random.normal(next(keys), shape, f32) * scale

    def unif(shape, lo, hi):
        return jax.random.uniform(next(keys), shape, f32, lo, hi)

    return {
        'x': nrm((BATCH, SEQ, D), 1.0),
        'c': nrm((BATCH, D), 1.0),
        'ctx': nrm((BATCH, CTX_LEN, D), 1.0),
        'c_ctx': nrm((D,), 1.0),
        'ada_w': nrm((L, D, 6 * D), 0.5 * D ** -0.5),
        'ada_b': nrm((L, 6 * D), 0.02),
        'norm1_g': 1.0 + nrm((L, D), 0.05),
        'norm2_g': 1.0 + nrm((L, D), 0.05),
        'w_in': nrm((L, D, P_IN), D ** -0.5),
        'rw_shift': unif((L, 2, RW_IN), 0.0, 0.5),
        'rw_w0': unif((L, 2, RW_WIDTH), -6.0, -1.0),
        'rw_w2': nrm((L, 2, RW_DECAY_LORA, RW_WIDTH), 0.1),
        'rw_a0': nrm((L, 2, RW_WIDTH), 0.3),
        'rw_a2': nrm((L, 2, RW_ICLR_LORA, RW_WIDTH), 0.1),
        'rw_g2': nrm((L, RW_GATE_LORA, RW_WIDTH), RW_GATE_LORA ** -0.5),
        'rw_kk': 0.85 + nrm((L, RW_WIDTH), 0.05),
        'rw_ka': 1.0 + nrm((L, RW_WIDTH), 0.05),
        'rw_rk': nrm((L, RW_HEADS, RW_HEAD_DIM), 0.1),
        'rw_gn_g': 1.0 + nrm((L, RW_WIDTH), 0.05),
        'rw_gn_b': nrm((L, RW_WIDTH), 0.02),
        'hy_conv_w': nrm((L, HY_SHORT_K, HY_IN), 0.5),
        'hy_conv_b': nrm((L, HY_IN), 0.02),
        'hy_f_w1': nrm((L, HY_EMB_DIM, HY_FILTER_HIDDEN), HY_EMB_DIM ** -0.5),
        'hy_f_b1': nrm((L, HY_FILTER_HIDDEN), 0.1),
        'hy_f_w2': nrm((L, HY_FILTER_HIDDEN, HY_FILTER_HIDDEN), HY_FILTER_HIDDEN ** -0.5),
        'hy_f_b2': nrm((L, HY_FILTER_HIDDEN), 0.1),
        'hy_f_w3': nrm((L, HY_FILTER_HIDDEN, HY_ORDER * 2 * HY_WIDTH), HY_FILTER_HIDDEN ** -0.5),
        'hy_f_freq': 1.0 + nrm((L, HY_FILTER_HIDDEN), 0.05),
        'hy_skip': nrm((L, HY_ORDER, HY_WIDTH), 0.5),
        'na_q_gain': 1.0 + nrm((L, NA_HEAD_DIM), 0.05),
        'na_k_gain': 1.0 + nrm((L, NA_HEAD_DIM), 0.05),
        'na_rpb': nrm((L, NA_HEADS, 2 * NA_WIN_ROWS - 1, 2 * NA_WIN_COLS - 1), 0.1),
        'w_br_rw': nrm((L, RW_WIDTH, D), RW_WIDTH ** -0.5),
        'w_br_hy': nrm((L, HY_WIDTH, D), HY_WIDTH ** -0.5),
        'w_br_na': nrm((L, NA_WIDTH, D), NA_WIDTH ** -0.5),
        'w_out': nrm((L, D, D), D ** -0.5),
        'ff_w1': nrm((N_DENSE_LAYERS, D, FF_DENSE), D ** -0.5),
        'ff_w3': nrm((N_DENSE_LAYERS, D, FF_DENSE), D ** -0.5),
        'ff_w2': nrm((N_DENSE_LAYERS, FF_DENSE, D), FF_DENSE ** -0.5),
        'moe_router': nrm((N_MOE_LAYERS, D, N_EXPERTS), D ** -0.5),
        'moe_w1': nrm((N_MOE_LAYERS, N_EXPERTS, D, FF_EXPERT), D ** -0.5),
        'moe_w3': nrm((N_MOE_LAYERS, N_EXPERTS, D, FF_EXPERT), D ** -0.5),
        'moe_w2': nrm((N_MOE_LAYERS, N_EXPERTS, FF_EXPERT, D), FF_EXPERT ** -0.5),
    }


def reference(x, c, ctx, c_ctx, ada_w, ada_b, norm1_g, norm2_g, w_in,
              rw_shift, rw_w0, rw_w2, rw_a0, rw_a2, rw_g2, rw_kk, rw_ka, rw_rk, rw_gn_g, rw_gn_b,
              hy_conv_w, hy_conv_b, hy_f_w1, hy_f_b1, hy_f_w2, hy_f_b2, hy_f_w3, hy_f_freq, hy_skip,
              na_q_gain, na_k_gain, na_rpb, w_br_rw, w_br_hy, w_br_na, w_out,
              ff_w1, ff_w3, ff_w2, moe_router, moe_w1, moe_w3, moe_w2):
    lc = ctx.shape[1]
    act_lat = jax.nn.silu(c)
    act_ctx = jax.nn.silu(c_ctx)
    for li in range(DEPTH):
        last = li == DEPTH - 1
        mod_lat = jnp.split((act_lat @ ada_w[li] + ada_b[li])[:, None, :], 6, axis=-1)
        mod_ctx = jnp.split((act_ctx @ ada_w[li] + ada_b[li])[None, None, :], 6, axis=-1)

        h = jnp.concatenate([modulate(rms_norm(ctx, norm1_g[li]), mod_ctx[0], mod_ctx[1]),
                             modulate(rms_norm(x, norm1_g[li]), mod_lat[0], mod_lat[1])], axis=1)
        u_rw, u_hy, u_na, u_gate = jnp.split(h @ w_in[li], IN_SPLITS, axis=-1)
        rw_ctx, rw_lat = rwkv7_mixer(u_rw[:, :lc], u_rw[:, lc:], rw_shift[li], rw_w0[li], rw_w2[li],
                                     rw_a0[li], rw_a2[li], rw_g2[li], rw_kk[li], rw_ka[li], rw_rk[li],
                                     rw_gn_g[li], rw_gn_b[li], not last)
        hy_args = (hy_conv_w[li], hy_conv_b[li], hy_f_w1[li], hy_f_b1[li], hy_f_w2[li], hy_f_b2[li],
                   hy_f_w3[li], hy_f_freq[li], hy_skip[li])
        hy_lat = hyena_sequence(u_hy[:, lc:], *hy_args)
        na_ctx, na_lat = neighbourhood_attention(u_na[:, :lc], u_na[:, lc:], na_q_gain[li], na_k_gain[li],
                                                 na_rpb[li], not last)
        br_w = (w_br_rw[li], w_br_hy[li], w_br_na[li], w_out[li])
        x = x + mod_lat[2] * merge_branches(u_gate[:, lc:], rw_lat, hy_lat, na_lat, *br_w).astype(x.dtype)
        if not last:
            hy_ctx = hyena_sequence(u_hy[:, :lc], *hy_args)
            ctx = ctx + mod_ctx[2] * merge_branches(u_gate[:, :lc], rw_ctx, hy_ctx, na_ctx, *br_w).astype(ctx.dtype)

        h = modulate(rms_norm(x, norm2_g[li]), mod_lat[3], mod_lat[4])
        if not last:
            h = jnp.concatenate([modulate(rms_norm(ctx, norm2_g[li]), mod_ctx[3], mod_ctx[4]), h], axis=1)
        if li % 2 == 0:
            f = swiglu(h, ff_w1[li // 2], ff_w3[li // 2], ff_w2[li // 2])
        else:
            f = moe_swiglu(h, moe_router[li // 2], moe_w1[li // 2], moe_w3[li // 2], moe_w2[li // 2])
        if last:
            x = x + mod_lat[5] * f
        else:
            ctx = ctx + mod_ctx[5] * f[:, :lc]
            x = x + mod_lat[5] * f[:, lc:]
    return x
```

```cpp
#include <hip/hip_runtime.h>
#include <cstdio>
#include <cstdint>

#ifndef MK_ONE_LAUNCH
#define MK_ONE_LAUNCH 1
#endif
#ifndef PROBE_ID
#define PROBE_ID (-1)
#endif
#ifndef PROBE_REPS
#define PROBE_REPS 2
#endif
#ifndef PROBE_SUB
#define PROBE_SUB 0
#endif
#ifndef USE_NAIVE_GEMM
#define USE_NAIVE_GEMM 0
#endif

namespace pg8 {
#define PG8_LAS __attribute__((address_space(3)))
typedef unsigned short bf16_t;
typedef short bf16x8 __attribute__((ext_vector_type(8)));
typedef float f32x4 __attribute__((ext_vector_type(4)));
typedef unsigned u32x4 __attribute__((ext_vector_type(4)));
constexpr int BM = 256, BK = 64, HALF = 128, HTB = HALF * BK * 2  , STAGE_BYTES = 8 * HTB, NXCD = 8, WGM = 8;

__host__ __device__ __forceinline__ int lds_byte(int r, int c) { const int st = (r >> 4) * 2 + (c >> 5), rr = r & 15, cc = c & 31, ob = rr * 64 + cc * 2; return st * 1024 + (ob ^ (((ob >> 9) & 1) << 5)); }
__host__ __device__ __forceinline__ void stage_rc(int b, int& R, int& C) { const int st = b / 1024, sb = b % 1024, swz = sb ^ (((sb >> 9) & 1) << 5); R = (st >> 1) * 16 + swz / 64; C = (st & 1) * 32 + (swz % 64) / 2; }
__host__ __device__ __forceinline__ int perm32(int rho) { const int n = rho >> 4, i = rho & 15; return 8 * (i >> 2) + 4 * n + (i & 3); }

struct Unit { int pm, pn; };
struct Gemm { const bf16_t* A; const bf16_t* Bt; int M, N, K, lda; };

struct StaticOrder {
    int nM, nN, nwg, G, c;
    __host__ __device__ void init(int M, int N, int G_, int c_) { nM = M / BM; nN = N / BM; nwg = nM * nN; G = G_; c = c_; }
    __host__ __device__ bool next(int i, Unit& u) const {
        const long L = (long)i * G + c; if (L >= nwg) return false;
        int wgid = (int)L; { const int q = nwg / NXCD, r = nwg % NXCD, xcd = wgid % NXCD, off = wgid / NXCD; wgid = (xcd < r ? xcd * (q + 1) : r * (q + 1) + (xcd - r) * q) + off; }
        const int nig = WGM * nN, gid = wgid / nig, fm = gid * WGM, gsz = (nM - fm) < WGM ? (nM - fm) : WGM;
        u.pm = fm + ((wgid % nig) % gsz); u.pn = (wgid % nig) / gsz; return true;
    }
    __device__ __forceinline__ void a_ready(const Unit&) const {}
    __device__ __forceinline__ void done(const Unit&) const {}
};
struct MoeOrder {
    int nM, nN, nwg, G, c; int toff[9];
    __device__ void init(const unsigned* cnt, int nN_, int G_, int c_) {
        int t = 0;
#pragma unroll
        for (int e = 0; e < 8; ++e) { toff[e] = t; t += (int)((__builtin_amdgcn_readfirstlane(cnt[64 * e]) + 255u) >> 8); }
        toff[8] = t; nM = t; nN = nN_; nwg = nM * nN; G = G_; c = c_;
    }
    __device__ bool next(int i, Unit& u) const {
        const long L = (long)i * G + c; if (L >= nwg) return false;
        int wgid = (int)L; { const int q = nwg / NXCD, r = nwg % NXCD, xcd = wgid % NXCD, off = wgid / NXCD; wgid = (xcd < r ? xcd * (q + 1) : r * (q + 1) + (xcd - r) * q) + off; }
        const int nig = WGM * nN, gid = wgid / nig, fm = gid * WGM, gsz = (nM - fm) < WGM ? (nM - fm) : WGM;
        const int pm = fm + ((wgid % nig) % gsz), pn = (wgid % nig) / gsz;
        int e = 0;
#pragma unroll
        for (int k = 1; k < 8; ++k) e += (pm >= toff[k]) ? 1 : 0;
        u.pm = pm; u.pn = e * nN + pn; return true;
    }
    __device__ __forceinline__ void a_ready(const Unit&) const {}
    __device__ __forceinline__ void done(const Unit&) const {}
};

__device__ __forceinline__ unsigned cvt_pk_bf16(float lo, float hi) { unsigned r; asm volatile("v_cvt_pk_bf16_f32 %0, %1, %2" : "=v"(r) : "v"(lo), "v"(hi)); return r; }

template <class Epi, class Sched, bool ALIGN_EPI = false, bool SP2 = false>
__device__ __forceinline__ void gemm_phase(PG8_LAS unsigned char* lds, const Gemm g, const Sched& S, const Epi& E) {
    int tid_ = threadIdx.x; asm volatile("" : "+v"(tid_));
    const int tid = tid_, wid = __builtin_amdgcn_readfirstlane(tid >> 6), lane = tid & 63, wr = wid >> 2, wc = wid & 3, fr = lane & 15, fq = lane >> 4;
    const int K = g.K, nt = K / BK, LDA = g.lda;
    unsigned voffA[2], voffB[2];
#pragma unroll
    for (int i = 0; i < 2; ++i) { int R, C; stage_rc(tid * 16 + i * 8192, R, C); const int Rb = Epi::PERM ? ((R & ~31) + perm32(R & 31)) : R;
        voffA[i] = (unsigned)(R * LDA + C) * 2u; voffB[i] = (unsigned)(Rb * K + C) * 2u; }
    const size_t kstep = (size_t)(BK * 2);
    const size_t hstepA = (size_t)HALF * LDA * 2, hstepB = (size_t)HALF * K * 2;
    const size_t tstepA = 2 * hstepA, tstepB = 2 * hstepB;
    const unsigned ldsw = (unsigned)wid * 1024u;
    const int aoff = lds_byte(wr * 64 + fr, fq * 8), boff = lds_byte(wc * 32 + fr, fq * 8);
#define PG8_SA(b, h) (((b) * 2 + (h)) * HTB)
#define PG8_SB(b, h) ((4 + (b) * 2 + (h)) * HTB)
#define PG8_STAGE(bufoff, gbase, voff) do { _Pragma("unroll") for (int _i = 0; _i < 2; ++_i) \
        __builtin_amdgcn_global_load_lds((const unsigned*)((const char*)(gbase) + (voff)[_i]), (PG8_LAS unsigned*)(lds + (bufoff) + ldsw + _i * 8192), 16, 0, 0); } while (0)
#define PG8_LDA(dst, b, h) do { _Pragma("unroll") for (int m = 0; m < 4; ++m) _Pragma("unroll") for (int k = 0; k < 2; ++k) dst[m][k] = *(const PG8_LAS bf16x8*)(lds + PG8_SA(b, h) + aoff + m * 2048 + k * 1024); } while (0)
#define PG8_LDB(dst, b, h) do { _Pragma("unroll") for (int n = 0; n < 2; ++n) _Pragma("unroll") for (int k = 0; k < 2; ++k) dst[n][k] = *(const PG8_LAS bf16x8*)(lds + PG8_SB(b, h) + boff + n * 2048 + k * 1024); } while (0)
#define PG8_MMA(ai, bj, At, Bt) do { __builtin_amdgcn_s_setprio(1); _Pragma("unroll") for (int m = 0; m < 4; ++m) _Pragma("unroll") for (int n = 0; n < 2; ++n) _Pragma("unroll") for (int k = 0; k < 2; ++k) \
        acc[ai][bj][m][n] = __builtin_amdgcn_mfma_f32_16x16x32_bf16(Bt[n][k], At[m][k], acc[ai][bj][m][n], 0, 0, 0); __builtin_amdgcn_s_setprio(0); } while (0)
#define PG8_WAIT_V(n) asm volatile("s_waitcnt vmcnt(" #n ")" ::: "memory")
#define PG8_WAIT_L(n) asm volatile("s_waitcnt lgkmcnt(" #n ")" ::: "memory")
#define PG8_BAR __builtin_amdgcn_s_barrier()
#define PG8_SCHED __builtin_amdgcn_sched_barrier(0)
    Unit cur, nxt; int ui = 0;
    if (!S.next(0, cur)) return;
    f32x4 acc[2][2][4][2];
#pragma unroll
    for (int a = 0; a < 2; ++a)
#pragma unroll
        for (int b = 0; b < 2; ++b)
#pragma unroll
            for (int m = 0; m < 4; ++m)
#pragma unroll
                for (int n = 0; n < 2; ++n) acc[a][b][m][n] = (f32x4){0.f, 0.f, 0.f, 0.f};
    bf16x8 At[4][2], B0[2][2], B1[2][2];
    const char* cA = (const char*)g.A + (size_t)cur.pm * tstepA; const char* cB = (const char*)g.Bt + (size_t)cur.pn * tstepB;
    S.a_ready(cur);
    if constexpr (SP2) {
        PG8_STAGE(PG8_SB(0, 0), cB, voffB); PG8_STAGE(PG8_SB(0, 1), cB + hstepB, voffB); PG8_STAGE(PG8_SA(0, 0), cA, voffA); PG8_STAGE(PG8_SA(0, 1), cA + hstepA, voffA);
        if (wr == 1) PG8_BAR;
        PG8_WAIT_V(2); PG8_BAR;
        PG8_STAGE(PG8_SB(1, 0), cB + kstep, voffB); PG8_STAGE(PG8_SA(1, 0), cA + kstep, voffA); PG8_STAGE(PG8_SB(1, 1), cB + hstepB + kstep, voffB);
        PG8_WAIT_V(6); PG8_BAR;
    } else {
        PG8_STAGE(PG8_SB(0, 0), cB, voffB); PG8_STAGE(PG8_SA(0, 0), cA, voffA); PG8_STAGE(PG8_SB(0, 1), cB + hstepB, voffB); PG8_STAGE(PG8_SA(0, 1), cA + hstepA, voffA);
        if (wr == 1) PG8_BAR;
        PG8_WAIT_V(4); PG8_BAR;
        PG8_STAGE(PG8_SB(1, 0), cB + kstep, voffB); PG8_STAGE(PG8_SA(1, 0), cA + kstep, voffA); PG8_STAGE(PG8_SB(1, 1), cB + hstepB + kstep, voffB);
        PG8_WAIT_V(6); PG8_BAR;
    }
    for (;;) {
        const bool has_next = S.next(ui + 1, nxt);
        const char* nA = has_next ? (const char*)g.A + (size_t)nxt.pm * tstepA : cA; const char* nB = has_next ? (const char*)g.Bt + (size_t)nxt.pn * tstepB : cB;
        for (int t = 0; t < nt; t += 2) {
            const bool last = (t == nt - 2);
            const char* a1 = cA + (size_t)(t + 1) * kstep;
            const char* a2 = last ? nA : cA + (size_t)(t + 2) * kstep; const char* b2 = last ? nB : cB + (size_t)(t + 2) * kstep;
            const char* a3 = a2 + kstep; const char* b3 = b2 + kstep;
            if (last && has_next) S.a_ready(nxt);
            if constexpr (SP2) {
            PG8_LDB(B0, 0, 0); PG8_LDB(B1, 0, 1); PG8_SCHED; PG8_LDA(At, 0, 0); PG8_STAGE(PG8_SA(1, 1), a1 + hstepA, voffA);
            PG8_WAIT_V(8); PG8_WAIT_L(0); PG8_BAR; PG8_MMA(0, 0, At, B0); PG8_MMA(0, 1, At, B1); PG8_BAR; PG8_SCHED;
            PG8_LDA(At, 0, 1); PG8_STAGE(PG8_SB(0, 0), b2, voffB); PG8_STAGE(PG8_SB(0, 1), b2 + hstepB, voffB); PG8_STAGE(PG8_SA(0, 0), a2, voffA);
            PG8_WAIT_V(8); PG8_WAIT_L(0); PG8_BAR; PG8_MMA(1, 0, At, B0); PG8_MMA(1, 1, At, B1); PG8_BAR; PG8_SCHED;
            PG8_LDB(B0, 1, 0); PG8_LDB(B1, 1, 1); PG8_SCHED; PG8_LDA(At, 1, 0); PG8_STAGE(PG8_SA(0, 1), a2 + hstepA, voffA);
            PG8_WAIT_V(8); PG8_WAIT_L(0); PG8_BAR; PG8_MMA(0, 0, At, B0); PG8_MMA(0, 1, At, B1); PG8_BAR; PG8_SCHED;
            PG8_LDA(At, 1, 1); PG8_STAGE(PG8_SB(1, 0), b3, voffB); PG8_STAGE(PG8_SB(1, 1), b3 + hstepB, voffB); PG8_STAGE(PG8_SA(1, 0), a3, voffA);
            PG8_WAIT_V(8); PG8_WAIT_L(0); PG8_BAR; PG8_MMA(1, 0, At, B0); PG8_MMA(1, 1, At, B1); PG8_BAR; PG8_SCHED;
            } else {
            PG8_LDB(B0, 0, 0); PG8_SCHED; PG8_LDA(At, 0, 0); PG8_STAGE(PG8_SA(1, 1), a1 + hstepA, voffA);
            PG8_WAIT_L(8); PG8_BAR; PG8_WAIT_L(0); PG8_MMA(0, 0, At, B0); PG8_BAR; PG8_SCHED;
            PG8_LDB(B1, 0, 1); PG8_STAGE(PG8_SB(0, 0), b2, voffB);
            PG8_BAR; PG8_WAIT_L(0); PG8_MMA(0, 1, At, B1); PG8_BAR;
            PG8_LDA(At, 0, 1); PG8_STAGE(PG8_SA(0, 0), a2, voffA);
            PG8_BAR; PG8_WAIT_L(0); PG8_MMA(1, 0, At, B0); PG8_BAR; PG8_SCHED;
            PG8_STAGE(PG8_SB(0, 1), b2 + hstepB, voffB);
            PG8_WAIT_V(6); PG8_BAR; PG8_MMA(1, 1, At, B1); PG8_BAR;
            PG8_LDB(B0, 1, 0); PG8_SCHED; PG8_LDA(At, 1, 0); PG8_STAGE(PG8_SA(0, 1), a2 + hstepA, voffA);
            PG8_WAIT_L(8); PG8_BAR; PG8_WAIT_L(0); PG8_MMA(0, 0, At, B0); PG8_BAR; PG8_SCHED;
            PG8_LDB(B1, 1, 1); PG8_STAGE(PG8_SB(1, 0), b3, voffB);
            PG8_BAR; PG8_WAIT_L(0); PG8_MMA(0, 1, At, B1); PG8_BAR;
            PG8_LDA(At, 1, 1); PG8_STAGE(PG8_SA(1, 0), a3, voffA);
            PG8_BAR; PG8_WAIT_L(0); PG8_MMA(1, 0, At, B0); PG8_BAR; PG8_SCHED;
            PG8_STAGE(PG8_SB(1, 1), b3 + hstepB, voffB);
            PG8_WAIT_V(6); PG8_BAR; PG8_MMA(1, 1, At, B1); PG8_BAR;
            }
        }
        if constexpr (ALIGN_EPI) { if (wr == 0) PG8_BAR; }
        E(acc, cur, wr, wc, fr, fq); S.done(cur);
        if (!has_next) break;
#pragma unroll
        for (int a = 0; a < 2; ++a)
#pragma unroll
            for (int b = 0; b < 2; ++b)
#pragma unroll
                for (int m = 0; m < 4; ++m)
#pragma unroll
                    for (int n = 0; n < 2; ++n) acc[a][b][m][n] = (f32x4){0.f, 0.f, 0.f, 0.f};
        cur = nxt; cA = nA; cB = nB; ++ui;
        if constexpr (ALIGN_EPI) { if (wr == 1) PG8_BAR; }
    }
    PG8_WAIT_V(0);
    if constexpr (!ALIGN_EPI) { if (wr == 0) PG8_BAR; }
    PG8_BAR;
#undef PG8_SA
#undef PG8_SB
#undef PG8_STAGE
#undef PG8_LDA
#undef PG8_LDB
#undef PG8_MMA
#undef PG8_WAIT_V
#undef PG8_WAIT_L
#undef PG8_BAR
#undef PG8_SCHED
}

template <class Epi, class Sched>
__device__ __forceinline__ void gemm_naive(PG8_LAS unsigned char* lds, const Gemm g, const Sched& S, const Epi& E) {
    const int tid = threadIdx.x, wid = __builtin_amdgcn_readfirstlane(tid >> 6), lane = tid & 63, wr = wid >> 2, wc = wid & 3, fr = lane & 15, fq = lane >> 4;
    PG8_LAS float* As = (PG8_LAS float*)lds; PG8_LAS float* Bs = As + 256 * 33;
    Unit u;
    for (int ui = 0; S.next(ui, u); ++ui) {
        f32x4 acc[2][2][4][2];
#pragma unroll
        for (int a = 0; a < 2; ++a)
#pragma unroll
            for (int b = 0; b < 2; ++b)
#pragma unroll
                for (int m = 0; m < 4; ++m)
#pragma unroll
                    for (int n = 0; n < 2; ++n) acc[a][b][m][n] = (f32x4){0.f, 0.f, 0.f, 0.f};
        for (int k0 = 0; k0 < g.K; k0 += 32) {
            __syncthreads();
            for (int i = tid; i < 256 * 32; i += 512) { const int r = i >> 5, c = i & 31;
                As[r * 33 + c] = __uint_as_float(((unsigned)g.A[(size_t)(u.pm * 256 + r) * g.lda + k0 + c]) << 16);
                Bs[r * 33 + c] = __uint_as_float(((unsigned)g.Bt[(size_t)(u.pn * 256 + r) * g.K + k0 + c]) << 16); }
            __syncthreads();
            for (int kk = 0; kk < 32; ++kk) {
                float a[2][4], b[2][2][4];
#pragma unroll
                for (int ai = 0; ai < 2; ++ai)
#pragma unroll
                    for (int m = 0; m < 4; ++m) a[ai][m] = As[(128 * ai + 64 * wr + 16 * m + fr) * 33 + kk];
#pragma unroll
                for (int bj = 0; bj < 2; ++bj)
#pragma unroll
                    for (int n = 0; n < 2; ++n)
#pragma unroll
                        for (int j = 0; j < 4; ++j) { const int cl = Epi::PERM ? (128 * bj + 32 * wc + 8 * fq + 4 * n + j) : (128 * bj + 32 * wc + 16 * n + 4 * fq + j); b[bj][n][j] = Bs[cl * 33 + kk]; }
#pragma unroll
                for (int ai = 0; ai < 2; ++ai)
#pragma unroll
                    for (int bj = 0; bj < 2; ++bj)
#pragma unroll
                        for (int m = 0; m < 4; ++m)
#pragma unroll
                            for (int n = 0; n < 2; ++n)
#pragma unroll
                                for (int j = 0; j < 4; ++j) acc[ai][bj][m][n][j] += a[ai][m] * b[bj][n][j];
            }
        }
        E(acc, u, wr, wc, fr, fq);
    }
    __syncthreads();
}
}

constexpr int D = 1024, NB = 8, SEQ = 2048, LC = 256, NLAYER = 2;
constexpr int NL = NB * SEQ;
constexpr int NC = NB * LC;
constexpr int MT = NL + NC;
constexpr int GRID_W = 64;
constexpr int RW_W = 384, RW_IN = 1536, HY_W = 256, HY_IN = 768, NA_W = 384, NA_IN = 1152, GATE_IN = 3072, P_IN = 6528;
constexpr int UA_W = 3584;
constexpr int UA_HY = 1536, UA_NA = 2304;
constexpr int WIN_ROWS = UA_W + GATE_IN;
constexpr int FF = 2816, FFE = 3584, NE = 8;
constexpr int MOE_ROWS = 2 * NL + NE * 256;
constexpr int NFEAT = 8;
constexpr float NORM_EPS = 1e-6f, RW_GN_EPS = 64e-5f;

enum { I_X = 0, I_C, I_CTX, I_CCTX, I_ADAW, I_ADAB, I_N1G, I_N2G, I_WIN, I_RWSHIFT, I_RWW0, I_RWW2, I_RWA0, I_RWA2, I_RWG2, I_RWKK, I_RWKA, I_RWRK, I_RWGNG, I_RWGNB,
       I_HYCW, I_HYCB, I_HYW1, I_HYB1, I_HYW2, I_HYB2, I_HYW3, I_HYFREQ, I_HYSKIP, I_NAQG, I_NAKG, I_NARPB, I_WBRRW, I_WBRHY, I_WBRNA, I_WOUT, I_FFW1, I_FFW3, I_FFW2,
       I_MOER, I_MOEW1, I_MOEW3, I_MOEW2, N_IN };

constexpr size_t al256(size_t x) { return (x + 255) & ~(size_t)255; }
constexpr size_t WS_CTL = 0, CTL_ZERO_BYTES = 1u << 20;
constexpr size_t CTL_MODS_OFF = 65536;
static_assert(CTL_MODS_OFF + (size_t)NLAYER * 9 * 6144 * 4 <= CTL_ZERO_BYTES, "mods inside memset region");
constexpr int CW_BAR = 4096;
constexpr int CW_MOECNT = 8192;
constexpr size_t WS_WIN = CTL_ZERO_BYTES;
constexpr size_t SZ_WIN1 = (size_t)WIN_ROWS * D * 2;
constexpr size_t WS_WBR = WS_WIN + 2 * SZ_WIN1;
constexpr size_t SZ_WBR1 = (size_t)D * 1024 * 2;
constexpr size_t WS_WOUT = WS_WBR + 2 * SZ_WBR1;
constexpr size_t SZ_WOUT1 = (size_t)D * D * 2;
constexpr size_t WS_WFF13 = WS_WOUT + 2 * SZ_WOUT1;
constexpr size_t WS_WFF2 = WS_WFF13 + (size_t)2 * FF * D * 2;
constexpr size_t WS_WM13 = WS_WFF2 + (size_t)D * FF * 2;
constexpr size_t WS_WM2 = WS_WM13 + (size_t)NE * 2 * FFE * D * 2;
constexpr size_t WS_CTXRES = WS_WM2 + (size_t)NE * D * FFE * 2;
constexpr size_t WS_FILT = WS_CTXRES + (size_t)NC * D * 4;
constexpr size_t WS_FILTC = WS_FILT + (size_t)2 * 2 * 256 * 4096 * 2;
constexpr size_t WS_H2BUF = WS_FILTC + (size_t)2 * 256 * 512 * 2;
constexpr size_t WS_MISC = WS_H2BUF + (size_t)2 * 2 * 2048 * 64 * 4;
constexpr size_t MISC_SEL = 0;
constexpr size_t MISC_ROWTOK = MISC_SEL + (size_t)NL * 32;
constexpr size_t MISC_ROWWGT = MISC_ROWTOK + (size_t)MOE_ROWS * 4;
constexpr int RWT_W2 = 0, RWT_A2 = 2 * 384 * 64, RWT_G2 = 4 * 384 * 64, RWT_PER_LAYER = 4 * 384 * 64 + 384 * 128;
constexpr size_t MISC_RWT = al256(MISC_ROWWGT + (size_t)MOE_ROWS * 4);
constexpr size_t MISC_ROPE = MISC_RWT + (size_t)2 * (4 * 384 * 64 + 384 * 128) * 2;
constexpr size_t WS_RA = al256(WS_MISC + MISC_ROPE + 64 * 16 * 2 * 4);
constexpr size_t SZ_RA = (size_t)MT * D * 2;
constexpr size_t WS_RB = WS_RA + SZ_RA;
constexpr size_t RB_YHY = (size_t)2 * MT * RW_W * 2;
static_assert(RB_YHY + (size_t)MT * HY_W * 2 <= SZ_RA, "RB map");
constexpr size_t WS_R1 = WS_RB + SZ_RA;
constexpr size_t SZ_UA = (size_t)MT * UA_W * 2;
constexpr size_t R1_FEAT = SZ_UA;
constexpr size_t R1_G = SZ_UA;
constexpr size_t SZ_R1 = (size_t)MOE_ROWS * FFE * 2;
static_assert(SZ_UA + (size_t)MT * NFEAT * RW_W * 2 <= SZ_R1 && SZ_UA + (size_t)MT * GATE_IN * 2 <= SZ_R1 && (size_t)MT * FF * 2 <= SZ_R1, "R1 map");
static_assert((size_t)MOE_ROWS * D * 2 <= 2 * SZ_RA, "A_sorted fits RA+RB");
constexpr size_t R1_H2U = 0;
constexpr size_t WS_END = WS_R1 + SZ_R1;

constexpr int LDS_BYTES = 147456;
constexpr int LDS_CTL_OFF = LDS_BYTES - 256;
constexpr int NWAVES = 8, NTHREADS = 512;

#define GAS __attribute__((address_space(1)))
#define LAS __attribute__((address_space(3)))
typedef unsigned short bf16;
typedef unsigned v4u __attribute__((ext_vector_type(4)));
typedef unsigned v2u __attribute__((ext_vector_type(2)));
typedef float f32x4 __attribute__((ext_vector_type(4)));
typedef float f32x2 __attribute__((ext_vector_type(2)));
__device__ __forceinline__ unsigned f2bf(float f) { unsigned u = __builtin_bit_cast(unsigned, f); return (u + 0x7fffu + ((u >> 16) & 1u)) >> 16; }
__device__ __forceinline__ unsigned pk2(float lo, float hi) { return f2bf(lo) | (f2bf(hi) << 16); }
__device__ __forceinline__ float bf2f(bf16 v) { return __uint_as_float(((unsigned)v) << 16); }
__device__ __forceinline__ float bflo(unsigned w) { return __uint_as_float(w << 16); }
__device__ __forceinline__ float bfhi(unsigned w) { return __uint_as_float(w & 0xffff0000u); }
__device__ __forceinline__ void unpack8(const v4u w, float (&x)[8]) { x[0] = bflo(w.x); x[1] = bfhi(w.x); x[2] = bflo(w.y); x[3] = bfhi(w.y); x[4] = bflo(w.z); x[5] = bfhi(w.z); x[6] = bflo(w.w); x[7] = bfhi(w.w); }
__device__ __forceinline__ v4u pack8(const float (&x)[8]) { v4u w; w.x = pk2(x[0], x[1]); w.y = pk2(x[2], x[3]); w.z = pk2(x[4], x[5]); w.w = pk2(x[6], x[7]); return w; }
__device__ __forceinline__ float sigmoidf_(float x) { return 1.0f / (1.0f + __expf(-x)); }
__device__ __forceinline__ float siluf_(float x) { return x / (1.0f + __expf(-x)); }
__device__ __forceinline__ float wave_sum(float v) {
#pragma unroll
    for (int o = 1; o < 64; o <<= 1) v += __shfl_xor(v, o);
    return v;
}
__device__ __forceinline__ float wave_max(float v) {
#pragma unroll
    for (int o = 1; o < 64; o <<= 1) v = fmaxf(v, __shfl_xor(v, o));
    return v;
}
#define LDS_WAIT() asm volatile("s_waitcnt lgkmcnt(0)" ::: "memory")
#define VM_WAIT() asm volatile("s_waitcnt vmcnt(0)" ::: "memory")

#define XB_TMO      128
#define XB_XCNT(j)  (256  + 64 * (j))
#define XB_XSUB(j)  (1280 + 64 * (j))
#define XB_XGEN(j)  (2304 + 64 * (j))
#define XB_TOP      3328
#define XB_TOPGEN   3392
#define XCD_BAR_WORDS 3456
#define XB_SPIN_CAP (1u << 18)
__device__ __forceinline__ unsigned xb_ld(unsigned* p)              { return __hip_atomic_load(p, __ATOMIC_RELAXED, __HIP_MEMORY_SCOPE_AGENT); }
__device__ __forceinline__ unsigned xb_add(unsigned* p, unsigned v) { return __hip_atomic_fetch_add(p, v, __ATOMIC_RELAXED, __HIP_MEMORY_SCOPE_AGENT); }
__device__ __forceinline__ unsigned xb_xcc_id() { return (unsigned)__builtin_amdgcn_s_getreg((3 << 11) | 20) & 0xFu; }
#define XB_SPIN(cond, bar) do { unsigned _sp = 0; while (cond) { __builtin_amdgcn_s_sleep(1); \
    if ((++_sp & 255u) == 0u) { if (xb_ld(&(bar)[XB_TMO])) break; if (_sp > XB_SPIN_CAP) { atomicAdd(&(bar)[XB_TMO], 1u); break; } } } } while (0)
struct XcdBarrier { unsigned* bar; unsigned x; volatile LAS unsigned* st; };
__device__ __forceinline__ XcdBarrier xcd_barrier_post(unsigned* bar, volatile LAS unsigned* st) {
    XcdBarrier b; b.bar = bar; b.x = xb_xcc_id(); b.st = st;
    if (threadIdx.x == 0) (void)xb_add(&bar[XB_XCNT(b.x)], 1u);
    return b;
}
__device__ __forceinline__ void xcd_barrier_complete(unsigned* bar, unsigned x, unsigned& nloc, unsigned& nx) {
    const unsigned G = gridDim.x * gridDim.y * gridDim.z;
    unsigned sum, cnt, mine, sp = 0u;
    for (;;) {
        sum = 0u; cnt = 0u; mine = 0u;
#pragma unroll
        for (unsigned j = 0; j < 16; ++j) { const unsigned c = xb_ld(&bar[XB_XCNT(j)]); sum += c; cnt += (c > 0u) ? 1u : 0u; mine = (j == x) ? c : mine; }
        if (sum == G) break;
        __builtin_amdgcn_s_sleep(1);
        if ((++sp & 255u) == 0u) { if (xb_ld(&bar[XB_TMO])) break; if (sp > XB_SPIN_CAP) { atomicAdd(&bar[XB_TMO], 1u); break; } }
    }
    nloc = mine > 0u ? mine : 1u; nx = cnt > 0u ? cnt : 1u;
}
__device__ __forceinline__ void xcd_barrier(const XcdBarrier& b) {
    asm volatile("s_waitcnt vmcnt(0)" ::: "memory");
    __syncthreads();
    if (threadIdx.x == 0) {
        unsigned* bar = b.bar;
        __builtin_amdgcn_s_waitcnt(0);
        unsigned nloc = b.st[0], nx = b.st[1];
        if (nloc == 0u) { xcd_barrier_complete(bar, b.x, nloc, nx); b.st[0] = nloc; b.st[1] = nx; }
        const unsigned old = xb_add(&bar[XB_XSUB(b.x)], 1u);
        const unsigned gen = old / nloc;
        if (old + 1u == (gen + 1u) * nloc) {
            __builtin_amdgcn_fence(__ATOMIC_RELEASE, "agent");
            asm volatile("s_waitcnt vmcnt(0)" ::: "memory");
            const unsigned og = xb_add(&bar[XB_TOP], 1u);
            const unsigned tg = og / nx;
            if (og + 1u == (tg + 1u) * nx) xb_add(&bar[XB_TOPGEN], 1u);
            else XB_SPIN(xb_ld(&bar[XB_TOPGEN]) == tg, bar);
            __builtin_amdgcn_fence(__ATOMIC_ACQUIRE, "agent");
            xb_add(&bar[XB_XGEN(b.x)], 1u);
            asm volatile("s_waitcnt vmcnt(0)" ::: "memory");
        } else {
            XB_SPIN(xb_ld(&bar[XB_XGEN(b.x)]) == gen, bar);
            __builtin_amdgcn_fence(__ATOMIC_ACQUIRE, "agent");
            asm volatile("s_waitcnt vmcnt(0)" ::: "memory");
        }
    }
    __syncthreads();
}

struct Args { const float* in[N_IN]; float* out; unsigned char* ws; int ph_lo, ph_hi; };
static_assert(sizeof(Args) == N_IN * 8 + 8 + 8 + 8, "Args has no padding");
#define CAS __attribute__((address_space(4)))
typedef const float* cfp;
struct Frame {
    LAS unsigned char* lds;
    int tid, lane, wave, bid, G;
    const CAS cfp* in;
    float* out; unsigned char* ws;
    __device__ __forceinline__ void fresh() { int t = threadIdx.x, b = blockIdx.x, g = gridDim.x; asm volatile("" : "+v"(t), "+s"(b), "+s"(g)); tid = t; lane = t & 63; wave = __builtin_amdgcn_readfirstlane(t >> 6); bid = b; G = g; }
    template <class T> __device__ __forceinline__ T* wsp(size_t off) const { return (T*)(ws + off); }
    __device__ __forceinline__ const float* mods(int li, int r9) const { return (const float*)(ws + CTL_MODS_OFF) + (size_t)(li * 9 + r9) * 6144; }
};

using pg8::Unit; using pg8::cvt_pk_bf16;
template <int ACT  > struct EpiBf16S {
    static constexpr bool PERM = true;
    bf16* O; int ldc;
    __device__ __forceinline__ void operator()(const f32x4 (&acc)[2][2][4][2], const Unit& u, int wr, int wc, int fr, int fq) const {
        const int row0 = u.pm * 256 + wr * 64 + fr, col0 = u.pn * 256 + wc * 32 + 8 * fq;
        if (ACT == 0 && u.pn >= 6 && u.pn <= 8) {
#pragma unroll
            for (int ai = 0; ai < 2; ++ai)
#pragma unroll
                for (int m = 0; m < 4; ++m) { const int blk = u.pm * 256 + ai * 128 + wr * 64, i = m * 16 + fr;
#pragma unroll
                    for (int bj = 0; bj < 2; ++bj) { const int cb = bj * 128 + wc * 32 + 8 * fq;
                        bf16* tp = O + (size_t)(blk + (cb >> 2)) * ldc + u.pn * 256 + i; const f32x4 v0 = acc[ai][bj][m][0], v1 = acc[ai][bj][m][1];
#pragma unroll
                        for (int e = 0; e < 4; ++e) { tp[e * 64] = (bf16)f2bf(v0[e]); tp[ldc + e * 64] = (bf16)f2bf(v1[e]); } } }
            return; }
        if (ACT == 0 && u.pn >= 12) {
#pragma unroll
            for (int ai = 0; ai < 2; ++ai)
#pragma unroll
                for (int m = 0; m < 4; ++m) { const int blk = u.pm * 256 + ai * 128 + wr * 64, i = m * 16 + fr;
#pragma unroll
                    for (int bj = 0; bj < 2; ++bj) { const int cb = (u.pn - 12) * 256 + bj * 128 + wc * 32 + 8 * fq;
                        if (cb < 384) { const f32x4 v0 = acc[ai][bj][m][0], v1 = acc[ai][bj][m][1];
#pragma unroll
                            for (int e = 0; e < 8; ++e) { const int cv = cb + e, q6 = (cv * 10923) >> 16, r6 = cv - 6 * q6; O[(size_t)(blk + q6) * ldc + 3072 + r6 * 64 + i] = (bf16)f2bf(e < 4 ? v0[e & 3] : v1[e & 3]); } } } }
            return; }
#pragma unroll
        for (int ai = 0; ai < 2; ++ai)
#pragma unroll
            for (int m = 0; m < 4; ++m) { bf16* rowp = O + (size_t)(row0 + ai * 128 + m * 16) * ldc + col0;
#pragma unroll
                for (int bj = 0; bj < 2; ++bj) { f32x4 v0 = acc[ai][bj][m][0], v1 = acc[ai][bj][m][1];
                    if (ACT == 1) {
#pragma unroll
                        for (int j = 0; j < 4; ++j) { v0[j] = sigmoidf_(v0[j]); v1[j] = sigmoidf_(v1[j]); } }
                    v4u w; w.x = cvt_pk_bf16(v0[0], v0[1]); w.y = cvt_pk_bf16(v0[2], v0[3]); w.z = cvt_pk_bf16(v1[0], v1[1]); w.w = cvt_pk_bf16(v1[2], v1[3]);
                    *(v4u*)(rowp + bj * 128) = w; } }
    }
};
template <int MODE  > struct EpiMerge {
    static constexpr bool PERM = true;
    const bf16* Gt; int ldg; bf16* Mo;
    __device__ __forceinline__ void operator()(const f32x4 (&acc)[2][2][4][2], const Unit& u, int wr, int wc, int fr, int fq) const {
        const int row0 = u.pm * 256 + wr * 64 + fr, col0 = u.pn * 256 + wc * 32 + 8 * fq;
#pragma unroll
        for (int ai = 0; ai < 2; ++ai)
#pragma unroll
            for (int m = 0; m < 4; ++m) { const size_t r = (size_t)(row0 + ai * 128 + m * 16);
#pragma unroll
                for (int bj = 0; bj < 2; ++bj) { const int c = col0 + bj * 128;
                    const v4u gw = *(const v4u*)(Gt + r * ldg + c);
                    f32x4 v0 = acc[ai][bj][m][0], v1 = acc[ai][bj][m][1];
                    v0[0] *= bflo(gw.x); v0[1] *= bfhi(gw.x); v0[2] *= bflo(gw.y); v0[3] *= bfhi(gw.y);
                    v1[0] *= bflo(gw.z); v1[1] *= bfhi(gw.z); v1[2] *= bflo(gw.w); v1[3] *= bfhi(gw.w);
                    bf16* mp = Mo + r * D + c;
                    if (MODE == 1) { const v4u mw = *(const v4u*)mp;
                        v0[0] += bflo(mw.x); v0[1] += bfhi(mw.x); v0[2] += bflo(mw.y); v0[3] += bfhi(mw.y);
                        v1[0] += bflo(mw.z); v1[1] += bfhi(mw.z); v1[2] += bflo(mw.w); v1[3] += bfhi(mw.w); }
                    v4u w; w.x = cvt_pk_bf16(v0[0], v0[1]); w.y = cvt_pk_bf16(v0[2], v0[3]); w.z = cvt_pk_bf16(v1[0], v1[1]); w.w = cvt_pk_bf16(v1[2], v1[3]);
                    *(v4u*)mp = w; } }
    }
};
struct EpiRes {
    static constexpr bool PERM = false;
    const float* base_l; float* out_l; const float* base_c; float* out_c; const float* modl; int goff; float sc;
    __device__ __forceinline__ void operator()(const f32x4 (&acc)[2][2][4][2], const Unit& u, int wr, int wc, int fr, int fq) const {
        const bool isl = u.pm < 64; const int pml = isl ? u.pm : u.pm - 64; const int r9 = isl ? (u.pm >> 3) : 8;
        const float* base = isl ? base_l : base_c; float* out = isl ? out_l : out_c; const float* gate = modl + (size_t)r9 * 6144 + goff;
        const int row0 = pml * 256 + wr * 64 + fr, col0 = u.pn * 256 + wc * 32 + 4 * fq;
        f32x4 gv[2][2];
#pragma unroll
        for (int bj = 0; bj < 2; ++bj)
#pragma unroll
            for (int n = 0; n < 2; ++n) gv[bj][n] = *(const f32x4*)(gate + col0 + bj * 128 + n * 16);
#pragma unroll
        for (int ai = 0; ai < 2; ++ai)
#pragma unroll
            for (int m = 0; m < 4; ++m) { const size_t off = (size_t)(row0 + ai * 128 + m * 16) * D + col0;
#pragma unroll
                for (int bj = 0; bj < 2; ++bj)
#pragma unroll
                    for (int n = 0; n < 2; ++n) { const f32x4 bs = *(const f32x4*)(base + off + bj * 128 + n * 16);
                        *(f32x4*)(out + off + bj * 128 + n * 16) = bs + gv[bj][n] * acc[ai][bj][m][n] * sc; } }
    }
};
struct EpiSwiGLU {
    static constexpr bool PERM = true;
    bf16* H; int ldh; int ntl;
    __device__ __forceinline__ void operator()(const f32x4 (&acc)[2][2][4][2], const Unit& u, int wr, int wc, int fr, int fq) const {
        const int row0 = u.pm * 256 + wr * 64 + fr, col0 = (u.pn % ntl) * 128 + wc * 32 + 8 * fq;
#pragma unroll
        for (int ai = 0; ai < 2; ++ai)
#pragma unroll
            for (int m = 0; m < 4; ++m) { bf16* rowp = H + (size_t)(row0 + ai * 128 + m * 16) * ldh + col0;
                f32x4 h0, h1;
#pragma unroll
                for (int j = 0; j < 4; ++j) { h0[j] = siluf_(acc[ai][0][m][0][j]) * acc[ai][1][m][0][j]; h1[j] = siluf_(acc[ai][0][m][1][j]) * acc[ai][1][m][1][j]; }
                v4u w; w.x = cvt_pk_bf16(h0[0], h0[1]); w.y = cvt_pk_bf16(h0[2], h0[3]); w.z = cvt_pk_bf16(h1[0], h1[1]); w.w = cvt_pk_bf16(h1[2], h1[3]);
                *(v4u*)rowp = w; }
    }
};
struct EpiMoeY {
    static constexpr bool PERM = true;
    bf16* O;
    __device__ __forceinline__ void operator()(const f32x4 (&acc)[2][2][4][2], const Unit& u, int wr, int wc, int fr, int fq) const {
        const int row0 = u.pm * 256 + wr * 64 + fr, col0 = (u.pn & 3) * 256 + wc * 32 + 8 * fq;
#pragma unroll
        for (int ai = 0; ai < 2; ++ai)
#pragma unroll
            for (int m = 0; m < 4; ++m) { bf16* rowp = O + (size_t)(row0 + ai * 128 + m * 16) * D + col0;
#pragma unroll
                for (int bj = 0; bj < 2; ++bj) { const f32x4 v0 = acc[ai][bj][m][0], v1 = acc[ai][bj][m][1];
                    v4u w; w.x = cvt_pk_bf16(v0[0], v0[1]); w.y = cvt_pk_bf16(v0[2], v0[3]); w.z = cvt_pk_bf16(v1[0], v1[1]); w.w = cvt_pk_bf16(v1[2], v1[3]);
                    *(v4u*)(rowp + bj * 128) = w; } }
    }
};

#if USE_NAIVE_GEMM
#define GEMM_CALL(EpiT, SchedT, lds, g, S, E) pg8::gemm_naive<EpiT, SchedT>(lds, g, S, E)
#else
#define GEMM_CALL(EpiT, SchedT, lds, g, S, E) pg8::gemm_phase<EpiT, SchedT, true, true>(lds, g, S, E)
#endif

__device__ __forceinline__ void tr_item(const float* W, int ldw, int col0, int ncols, int K, bf16* WT, int mode, int row_off, LAS float* scr, int item, int lane) {
    const int nblk = ncols / 32, kb = item / nblk, nb = item % nblk, k0 = 64 * kb, n0 = 32 * nb;
    float tv[32];
#pragma unroll
    for (int i = 0; i < 32; ++i) { const int kk = 2 * i + (lane >> 5); tv[i] = W[(size_t)(k0 + kk) * ldw + col0 + n0 + (lane & 31)]; }
#pragma unroll
    for (int i = 0; i < 32; ++i) { const int kk = 2 * i + (lane >> 5); scr[kk * 33 + (lane & 31)] = tv[i]; }
    LDS_WAIT(); asm volatile("" ::: "memory");
    const int c = lane & 7;
#pragma unroll
    for (int j = 0; j < 4; ++j) { const int n = (lane >> 3) + 8 * j; const LAS float* s = scr + (8 * c) * 33 + n;
        v4u o; o.x = pk2(s[0 * 33], s[1 * 33]); o.y = pk2(s[2 * 33], s[3 * 33]); o.z = pk2(s[4 * 33], s[5 * 33]); o.w = pk2(s[6 * 33], s[7 * 33]);
        const int nn = n0 + n; const int drow = mode == 0 ? row_off + nn : row_off + (nn >> 7) * 256 + (nn & 127);
        *(v4u*)(WT + (size_t)drow * K + k0 + 8 * c) = o; }
    LDS_WAIT(); asm volatile("" ::: "memory");
}
struct TrDesc { const float* W; int ldw, col0, ncols, K; bf16* WT; int mode, row_off; };
__device__ __forceinline__ void tr_desc_small(const Frame& F, int idx, TrDesc& d) {
    if (idx < 12) { const int li = idx / 6, k = idx % 6;
        if (k == 0) d = TrDesc{F.in[I_WIN] + (size_t)li * D * P_IN, P_IN, 0, 3456, D, F.wsp<bf16>(WS_WIN + li * SZ_WIN1), 0, 0};
        else if (k == 1) d = TrDesc{F.in[I_WIN] + (size_t)li * D * P_IN, P_IN, 3456, GATE_IN, D, F.wsp<bf16>(WS_WIN + li * SZ_WIN1), 0, UA_W};
        else if (k == 2) d = TrDesc{F.in[I_WBRRW] + (size_t)li * RW_W * D, D, 0, D, RW_W, F.wsp<bf16>(WS_WBR + li * SZ_WBR1), 0, 0};
        else if (k == 3) d = TrDesc{F.in[I_WBRHY] + (size_t)li * HY_W * D, D, 0, D, HY_W, F.wsp<bf16>(WS_WBR + li * SZ_WBR1 + (size_t)D * RW_W * 2), 0, 0};
        else if (k == 4) d = TrDesc{F.in[I_WBRNA] + (size_t)li * NA_W * D, D, 0, D, NA_W, F.wsp<bf16>(WS_WBR + li * SZ_WBR1 + (size_t)D * (RW_W + HY_W) * 2), 0, 0};
        else d = TrDesc{F.in[I_WOUT] + (size_t)li * D * D, D, 0, D, D, F.wsp<bf16>(WS_WOUT + li * SZ_WOUT1), 0, 0};
    } else if (idx == 12) d = TrDesc{F.in[I_FFW1], FF, 0, FF, D, F.wsp<bf16>(WS_WFF13), 1, 0};
    else if (idx == 13) d = TrDesc{F.in[I_FFW3], FF, 0, FF, D, F.wsp<bf16>(WS_WFF13), 1, 128};
    else d = TrDesc{F.in[I_FFW2], D, 0, D, FF, F.wsp<bf16>(WS_WFF2), 0, 0};
}
__device__ __forceinline__ void tr_load(const TrDesc& d, int item, int lane, float (&tv)[32]) {
    const int nblk = d.ncols / 32, kb = item / nblk, nb = item % nblk, k0 = 64 * kb, n0 = 32 * nb;
#pragma unroll
    for (int i = 0; i < 32; ++i) { const int kk = 2 * i + (lane >> 5); tv[i] = d.W[(size_t)(k0 + kk) * d.ldw + d.col0 + n0 + (lane & 31)]; }
}
__device__ __forceinline__ void tr_store(const TrDesc& d, int item, int lane, const float (&tv)[32], LAS float* scr) {
    const int nblk = d.ncols / 32, kb = item / nblk, nb = item % nblk, k0 = 64 * kb, n0 = 32 * nb;
#pragma unroll
    for (int i = 0; i < 32; ++i) { const int kk = 2 * i + (lane >> 5); scr[kk * 33 + (lane & 31)] = tv[i]; }
    LDS_WAIT(); asm volatile("" ::: "memory");
    const int c = lane & 7;
#pragma unroll
    for (int j = 0; j < 4; ++j) { const int n = (lane >> 3) + 8 * j; const LAS float* s = scr + (8 * c) * 33 + n;
        v4u o; o.x = pk2(s[0 * 33], s[1 * 33]); o.y = pk2(s[2 * 33], s[3 * 33]); o.z = pk2(s[4 * 33], s[5 * 33]); o.w = pk2(s[6 * 33], s[7 * 33]);
        const int nn = n0 + n; const int drow = d.mode == 0 ? d.row_off + nn : d.row_off + (nn >> 7) * 256 + (nn & 127);
        *(v4u*)(d.WT + (size_t)drow * d.K + k0 + 8 * c) = o; }
    LDS_WAIT(); asm volatile("" ::: "memory");
}
__device__ __forceinline__ void moe_desc(const Frame& F, int mi, TrDesc& d) { const int e = mi / 3, w = mi % 3;
    if (w == 0) d = TrDesc{F.in[I_MOEW1] + (size_t)e * D * FFE, FFE, 0, FFE, D, F.wsp<bf16>(WS_WM13), 1, e * 2 * FFE};
    else if (w == 1) d = TrDesc{F.in[I_MOEW3] + (size_t)e * D * FFE, FFE, 0, FFE, D, F.wsp<bf16>(WS_WM13), 1, e * 2 * FFE + 128};
    else d = TrDesc{F.in[I_MOEW2] + (size_t)e * FFE * D, D, 0, D, FFE, F.wsp<bf16>(WS_WM2), 0, e * D}; }
__device__ __forceinline__ void moe_weight_transposes(Frame& F) {
    const int gw = F.bid * NWAVES + F.wave, NGW = F.G * NWAVES;
    LAS float* scr = (LAS float*)(F.lds + F.wave * 16384);
    constexpr int MOE_ITEMS = 1792, NIT = 24 * MOE_ITEMS;
    int it = gw; if (it >= NIT) return;
    TrDesc dc; moe_desc(F, it / MOE_ITEMS, dc); float tvc[32]; tr_load(dc, it % MOE_ITEMS, F.lane, tvc);
#pragma unroll 1
    for (;;) {
        const int itn = it + NGW; const bool hn = itn < NIT; TrDesc dn = dc; float tvn[32];
        if (hn) { moe_desc(F, itn / MOE_ITEMS, dn); tr_load(dn, itn % MOE_ITEMS, F.lane, tvn); }
        tr_store(dc, it % MOE_ITEMS, F.lane, tvc, scr);
        if (!hn) break;
        dc = dn; it = itn;
#pragma unroll
        for (int i = 0; i < 32; ++i) tvc[i] = tvn[i];
    }
}
__device__ __forceinline__ void p0_prologue(Frame& F) {
    const int gw = F.bid * NWAVES + F.wave, NGW = F.G * NWAVES;
    for (int i = F.bid * NTHREADS + F.tid; i < 2 * 128 * D / 8; i += F.G * NTHREADS) { const int li = i / (128 * D / 8), r = i % (128 * D / 8);
        *(v4u*)(F.wsp<bf16>(WS_WIN + li * SZ_WIN1) + (size_t)3456 * D + (size_t)r * 8) = (v4u){0u, 0u, 0u, 0u}; }
    for (int i = F.bid * NTHREADS + F.tid; i < 2 * RWT_PER_LAYER; i += F.G * NTHREADS) { const int li = i / RWT_PER_LAYER, idx = i % RWT_PER_LAYER; float v;
        if (idx < 4 * 384 * 64) { const int m = idx / (384 * 64), rem = idx % (384 * 64), nn = rem >> 6, k = rem & 63;
            v = m < 2 ? F.in[I_RWW2][((size_t)(li * 2 + m) * 64 + k) * RW_W + nn] : F.in[I_RWA2][((size_t)(li * 2 + (m - 2)) * 64 + k) * RW_W + nn]; }
        else { const int rem = idx - 4 * 384 * 64, nn = rem >> 7, k = rem & 127; v = F.in[I_RWG2][((size_t)li * 128 + k) * RW_W + nn]; }
        F.wsp<bf16>(WS_MISC + MISC_RWT)[i] = (bf16)f2bf(v); }
    if (F.bid == 0) { for (int i = F.tid; i < 1024; i += NTHREADS) { const int pos = i >> 4, fi = i & 15; float sn, cs; sincosf((float)pos * powf(10000.0f, -(float)fi / 16.0f), &sn, &cs);
        float* rt = F.wsp<float>(WS_MISC + MISC_ROPE) + 2 * i; rt[0] = cs; rt[1] = sn; } }
    {
        LAS float* zs = (LAS float*)F.lds;
        LAS float* h1s = zs + 64 * 36;
        const int pl = F.tid >> 3, sub = F.tid & 7;
#pragma unroll 1
        for (int job = F.bid; job < 72; job += F.G) { const int li = job / 36, q = job % 36, seg = q >= 32 ? 1 : 0, p = (seg ? q - 32 : q) * 64 + pl, n = seg ? 256 : 2048;
            __syncthreads();
            if (sub == 0) zs[pl * 36] = (float)p / (float)(n - 1);
#pragma unroll
            for (int e = 0; e < 4; ++e) { const int i = 1 + sub * 4 + e, fi = (i - 1) & 15; const float f = 1e-4f + (float)fi * ((15.0f - 1e-4f) / 15.0f); const float ang = (6.283185307179586f / (float)n) * (float)p * f;
                zs[pl * 36 + i] = i <= 16 ? cosf(ang) : -sinf(ang); }
            __syncthreads();
            const float* w1 = F.in[I_HYW1] + li * 33 * 64 + sub * 8; const float* b1 = F.in[I_HYB1] + li * 64 + sub * 8; const float* fr = F.in[I_HYFREQ] + li * 64 + sub * 8;
            float a[8];
#pragma unroll
            for (int e = 0; e < 8; ++e) a[e] = b1[e];
#pragma unroll 3
            for (int i = 0; i < 33; ++i) { const float z = zs[pl * 36 + i]; const f32x4 wa = *(const f32x4*)(w1 + i * 64), wb = *(const f32x4*)(w1 + i * 64 + 4);
                a[0] += z * wa.x; a[1] += z * wa.y; a[2] += z * wa.z; a[3] += z * wa.w; a[4] += z * wb.x; a[5] += z * wb.y; a[6] += z * wb.z; a[7] += z * wb.w; }
#pragma unroll
            for (int e = 0; e < 8; ++e) h1s[pl * 68 + sub * 8 + e] = sinf(fr[e] * a[e]);
            __syncthreads();
            const float* w2 = F.in[I_HYW2] + li * 64 * 64 + sub * 8; const float* b2 = F.in[I_HYB2] + li * 64 + sub * 8;
#pragma unroll
            for (int e = 0; e < 8; ++e) a[e] = b2[e];
#pragma unroll 4
            for (int i = 0; i < 64; ++i) { const float z = h1s[pl * 68 + i]; const f32x4 wa = *(const f32x4*)(w2 + i * 64), wb = *(const f32x4*)(w2 + i * 64 + 4);
                a[0] += z * wa.x; a[1] += z * wa.y; a[2] += z * wa.z; a[3] += z * wa.w; a[4] += z * wb.x; a[5] += z * wb.y; a[6] += z * wb.z; a[7] += z * wb.w; }
            float* o = F.wsp<float>(WS_H2BUF) + ((size_t)(li * 2 + seg) * 2048 + p) * 64 + sub * 8;
            *(f32x4*)o = (f32x4){sinf(fr[0] * a[0]), sinf(fr[1] * a[1]), sinf(fr[2] * a[2]), sinf(fr[3] * a[3])}; *(f32x4*)(o + 4) = (f32x4){sinf(fr[4] * a[4]), sinf(fr[5] * a[5]), sinf(fr[6] * a[6]), sinf(fr[7] * a[7])};
        }
    }
    __syncthreads();
    if (F.bid < 2 * 96) {
        LAS float* act = (LAS float*)F.lds;
        LAS float* part = act + 9 * 1024;
        for (int i = F.tid; i < 9 * 1024; i += NTHREADS) { const int r = i >> 10, k = i & 1023; const float v = r < 8 ? F.in[I_C][r * D + k] : F.in[I_CCTX][k]; act[i] = siluf_(v); }
        __syncthreads();
#pragma unroll 1
        for (int job = F.bid; job < 2 * 96; job += F.G) { const int li = job / 96, cb = job % 96; const int c = F.tid & 63, kg = F.tid >> 6, col = cb * 64 + c;
            float a[9];
#pragma unroll
            for (int r = 0; r < 9; ++r) a[r] = 0.f;
            const float* wp = F.in[I_ADAW] + ((size_t)li * D + kg * 128) * 6144 + col;
#pragma unroll 1
            for (int k0 = 0; k0 < 128; k0 += 16) { float w[16];
#pragma unroll
                for (int u = 0; u < 16; ++u) w[u] = wp[(size_t)(k0 + u) * 6144];
#pragma unroll
                for (int u = 0; u < 16; ++u)
#pragma unroll
                    for (int r = 0; r < 9; ++r) a[r] += act[r * 1024 + kg * 128 + k0 + u] * w[u]; }
#pragma unroll
            for (int r = 0; r < 9; ++r) part[(kg * 9 + r) * 64 + c] = a[r];
            __syncthreads();
            for (int i = F.tid; i < 9 * 64; i += NTHREADS) { const int r = i >> 6, cc = i & 63; float s = F.in[I_ADAB][li * 6144 + cb * 64 + cc];
#pragma unroll
                for (int g = 0; g < 8; ++g) s += part[(g * 9 + r) * 64 + cc];
                ((float*)(F.ws + CTL_MODS_OFF))[(size_t)(li * 9 + r) * 6144 + cb * 64 + cc] = s; }
            __syncthreads();
        }
    }
    __syncthreads();
    {
        LAS float* scr = (LAS float*)(F.lds + F.wave * 16384);
        for (int mi = 0; mi < 15; ++mi) { TrDesc d; tr_desc_small(F, mi, d); const int items = (d.K / 64) * (d.ncols / 32);
            for (int it = gw; it < items; it += NGW) tr_item(d.W, d.ldw, d.col0, d.ncols, d.K, d.WT, d.mode, d.row_off, scr, it, F.lane); }
    }
}

__device__ __forceinline__ void norm_row(const float* xrow, const float* g, const float* shift, const float* scale, int lane, f32x4 (&v)[4]) {
    const f32x4* xr = (const f32x4*)xrow + lane; float s = 0.f;
#pragma unroll
    for (int j = 0; j < 4; ++j) { v[j] = xr[64 * j]; s += (v[j].x * v[j].x + v[j].y * v[j].y) + (v[j].z * v[j].z + v[j].w * v[j].w); }
    const float rs = 1.0f / sqrtf(wave_sum(s) * (1.f / D) + NORM_EPS);
#pragma unroll
    for (int j = 0; j < 4; ++j) { const f32x4 gg = ((const f32x4*)g)[lane + 64 * j], sh = ((const f32x4*)shift)[lane + 64 * j], sc = ((const f32x4*)scale)[lane + 64 * j];
        v[j] = (v[j] * rs * gg) * (sc + 1.0f) + sh; }
}
__device__ __forceinline__ void store_row_bf16(bf16* orow, int lane, const f32x4 (&v)[4]) {
    v2u* o8 = (v2u*)orow + lane;
#pragma unroll
    for (int j = 0; j < 4; ++j) { v2u w; w.x = pk2(v[j].x, v[j].y); w.y = pk2(v[j].z, v[j].w); o8[64 * j] = w; }
}
__device__ __forceinline__ void hy_filter_job(Frame& F, int layer, int seg, int o, int cg) {
    const int n = seg ? 256 : 2048;
    const float* w3 = F.in[I_HYW3] + (size_t)layer * 64 * 1024;
    const float* h2b = F.wsp<float>(WS_H2BUF) + (size_t)(layer * 2 + seg) * 2048 * 64;
    LAS float* raw = (LAS float*)F.lds;
    LAS float* red = raw + 2048 * 16;
    LAS float* wl = red + 64;
    const float mind = -3.0701134573253945f, maxd = -15.350567286626972f;
    float asum[8];
#pragma unroll
    for (int c = 0; c < 8; ++c) asum[c] = 0.f;
    __syncthreads();
    for (int i = F.tid; i < 1024; i += NTHREADS) { const int q = i >> 6, k = i & 63; wl[i] = w3[(size_t)k * 1024 + o * 512 + (q >> 3) * 256 + cg * 8 + (q & 7)]; }
    __syncthreads();
#pragma unroll 1
    for (int p = F.tid; p < n; p += NTHREADS) {
        f32x4 h[16];
#pragma unroll
        for (int i = 0; i < 16; ++i) h[i] = ((const f32x4*)(h2b + (size_t)p * 64))[i];
        const float tt = (float)p / (float)(n - 1);
#pragma unroll 1
        for (int q = 0; q < 16; ++q) { const int dir = q >> 3, c = q & 7, ch = cg * 8 + c, col = o * 512 + dir * 256 + ch; float a = 0.f;
            (void)col;
#pragma unroll
            for (int i = 0; i < 16; ++i) { const f32x4 w4 = *(const LAS f32x4*)(wl + q * 64 + 4 * i); a += h[i].x * w4.x; a += h[i].y * w4.y; a += h[i].z * w4.z; a += h[i].w * w4.w; }
            const float delta = fabsf(mind + (maxd - mind) * ((float)ch / 255.0f));
            a *= __expf(-tt * delta);
            raw[p * 16 + q] = a;
            const float aa = (dir == 0 || p >= 1) ? fabsf(a) : 0.f;
#pragma unroll
            for (int k = 0; k < 8; ++k) asum[k] += (k == c) ? aa : 0.f; }
    }
#pragma unroll
    for (int c = 0; c < 8; ++c) asum[c] = wave_sum(asum[c]);
    if (F.lane == 0) {
#pragma unroll
        for (int c = 0; c < 8; ++c) red[F.wave * 8 + c] = asum[c]; }
    __syncthreads();
    float inv[8];
#pragma unroll
    for (int c = 0; c < 8; ++c) { float l1 = 0.f;
#pragma unroll
        for (int w = 0; w < 8; ++w) l1 += red[w * 8 + c];
        inv[c] = 1.0f / l1; }
    bf16* dst = seg ? F.wsp<bf16>(WS_FILTC) + (size_t)(o * 256 + cg * 8) * 512 : F.wsp<bf16>(WS_FILT) + (size_t)((layer * 2 + o) * 256 + cg * 8) * 4096;
    const int stride = 2 * n;
#pragma unroll 1
    for (int i = F.tid; i < 8 * n; i += NTHREADS) { const int c = i / n, p = i - c * n; float ic = 0.f;
#pragma unroll
        for (int k = 0; k < 8; ++k) ic = (k == c) ? inv[k] : ic;
        dst[(size_t)c * stride + n + p] = (bf16)f2bf(raw[p * 16 + c] * ic);
        if (p >= 1) dst[(size_t)c * stride + n - p] = (bf16)f2bf(raw[p * 16 + 8 + c] * ic); }
    if (F.tid < 8) dst[(size_t)F.tid * stride] = 0;
}
__device__ __forceinline__ void p1_norm1(Frame& F, int li) {
    const int gw = F.bid * NWAVES + F.wave, NGW = F.G * NWAVES;
    bf16* A1 = F.wsp<bf16>(WS_RA);
    const float* xl = li == 0 ? F.in[I_X] : F.out; const float* xc = li == 0 ? F.in[I_CTX] : F.wsp<float>(WS_CTXRES);
    const float* g = F.in[I_N1G] + li * D;
    for (int row = gw; row < MT; row += NGW) { const bool isl = row < NL; const int r9 = isl ? row >> 11 : 8;
        const float* xr = isl ? xl + (size_t)row * D : xc + (size_t)(row - NL) * D; const float* md = F.mods(li, r9);
        f32x4 v[4]; norm_row(xr, g, md + 0 * D, md + 1 * D, F.lane, v); store_row_bf16(A1 + (size_t)row * D, F.lane, v); }
    if (li == 0) {
        __syncthreads();
        for (int job = F.bid; job < 192; job += F.G) {
            { const int seg = job >= 128 ? 1 : 0, j2 = job - 128 * seg; hy_filter_job(F, seg ? 0 : j2 >> 6, seg, (j2 >> 5) & 1, j2 & 31); }
            __syncthreads(); }
    }
}

__device__ __forceinline__ void rw_scan_chain(Frame& F, int li, int chain) {
    const int b = chain / 12, h = (chain % 12) >> 1, d = chain & 1, lane = F.lane;
    const bf16* FEAT = F.wsp<bf16>(WS_R1 + R1_FEAT); float* Y = F.wsp<float>(WS_RB);
    LAS float* bc = (LAS float*)(F.lds + F.wave * 2048);
    const float k_k = F.in[I_RWKK][li * RW_W + h * 64 + lane], k_a = F.in[I_RWKA][li * RW_W + h * 64 + lane];
    float S[64];
#pragma unroll
    for (int k = 0; k < 64; ++k) S[k] = 0.f;
    const int fe = 3 + d, fi = 5 + d;
    for (int seg = 0; seg < 2; ++seg) { const int n = seg ? SEQ : LC; const int base = seg ? b * SEQ : NL + b * LC;
        int t = d ? n - 1 : 0;
        const bf16* fp = FEAT + (size_t)(base + t) * NFEAT * RW_W + h * 64 + lane;
        bf16 nr = fp[0], nk = fp[RW_W], nv = fp[2 * RW_W], ne = fp[fe * RW_W], ni = fp[fi * RW_W];
        for (int step = 0; step < n; ++step) {
            const float r = bf2f(nr), k = bf2f(nk), v = bf2f(nv), e = bf2f(ne), ic = bf2f(ni);
            const int row = base + t;
            if (step + 1 < n) { t = d ? t - 1 : t + 1; fp = FEAT + (size_t)(base + t) * NFEAT * RW_W + h * 64 + lane; nr = fp[0]; nk = fp[RW_W]; nv = fp[2 * RW_W]; ne = fp[fe * RW_W]; ni = fp[fi * RW_W]; }
            float kkv = k * k_k; const float ss = wave_sum(kkv * kkv); kkv = kkv / fmaxf(sqrtf(ss), 1e-12f);
            bc[0 * 64 + lane] = __expf(-e); bc[1 * 64 + lane] = k * (1.0f + (ic - 1.0f) * k_a); bc[2 * 64 + lane] = -kkv; bc[3 * 64 + lane] = kkv * ic; bc[4 * 64 + lane] = r;
            LDS_WAIT(); asm volatile("" ::: "memory");
            float sa = 0.f;
#pragma unroll
            for (int k4 = 0; k4 < 16; ++k4) { const f32x4 a4 = ((const LAS f32x4*)(bc + 2 * 64))[k4]; sa += S[4 * k4] * a4.x + S[4 * k4 + 1] * a4.y + S[4 * k4 + 2] * a4.z + S[4 * k4 + 3] * a4.w; }
            float y = 0.f;
#pragma unroll
            for (int k4 = 0; k4 < 16; ++k4) { const f32x4 w4 = ((const LAS f32x4*)(bc + 0 * 64))[k4], kd4 = ((const LAS f32x4*)(bc + 1 * 64))[k4], b4 = ((const LAS f32x4*)(bc + 3 * 64))[k4], r4 = ((const LAS f32x4*)(bc + 4 * 64))[k4];
                S[4 * k4 + 0] = S[4 * k4 + 0] * w4.x + sa * b4.x + v * kd4.x; y += S[4 * k4 + 0] * r4.x;
                S[4 * k4 + 1] = S[4 * k4 + 1] * w4.y + sa * b4.y + v * kd4.y; y += S[4 * k4 + 1] * r4.y;
                S[4 * k4 + 2] = S[4 * k4 + 2] * w4.z + sa * b4.z + v * kd4.z; y += S[4 * k4 + 2] * r4.z;
                S[4 * k4 + 3] = S[4 * k4 + 3] * w4.w + sa * b4.w + v * kd4.w; y += S[4 * k4 + 3] * r4.w; }
            __hip_atomic_fetch_add(Y + (size_t)row * RW_W + h * 64 + lane, y, __ATOMIC_RELAXED, __HIP_MEMORY_SCOPE_AGENT);
            asm volatile("" ::: "memory");
        }
    }
}

__device__ __forceinline__ float hy_short(const bf16* U, const float* cw, float cb, int rowbase, int t, int n, int chcol) {
    const float u0 = t > 0 ? bf2f(U[(size_t)(rowbase + t - 1) * UA_W + UA_HY + chcol]) : 0.f;
    const float u1 = bf2f(U[(size_t)(rowbase + t) * UA_W + UA_HY + chcol]);
    const float u2 = t < n - 1 ? bf2f(U[(size_t)(rowbase + t + 1) * UA_W + UA_HY + chcol]) : 0.f;
    return cb + cw[0] * u0 + cw[HY_IN] * u1 + cw[2 * HY_IN] * u2;
}
__device__ __forceinline__ void hy_job(Frame& F, int li, int seg, int b, int cg) {
    const int n = seg ? LC : SEQ, rowbase = seg ? NL + b * LC : b * SEQ;
    bf16* U = F.wsp<bf16>(WS_R1);
    LAS bf16* zA = (LAS bf16*)F.lds; LAS bf16* zB = zA + 2048 * 8; LAS bf16* Fl = zB + 2048 * 8;
    const float* cw = F.in[I_HYCW] + (size_t)li * 3 * HY_IN; const float* cbv = F.in[I_HYCB] + (size_t)li * HY_IN;
    __syncthreads();
    for (int idx = F.tid; idx < n * 8; idx += NTHREADS) { const int t = idx >> 3, c = idx & 7, ch = cg * 8 + c;
        zA[idx] = (bf16)f2bf(hy_short(U, cw + ch, cbv[ch], rowbase, t, n, ch)); }
    LAS bf16* zin = zA; LAS bf16* zout = zB;
    for (int o = 0; o < 2; ++o) {
        const bf16* fsrc = seg ? F.wsp<bf16>(WS_FILTC) + (size_t)(o * 256 + cg * 8) * 512 : F.wsp<bf16>(WS_FILT) + (size_t)((li * 2 + o) * 256 + cg * 8) * 4096;
        __syncthreads();
        for (int idx = F.tid; idx < 8 * 2 * n / 8; idx += NTHREADS) ((LAS v4u*)Fl)[idx] = ((const v4u*)fsrc)[idx];
        __syncthreads();
        const int c = F.tid & 7, tq = F.tid >> 3, ch = cg * 8 + c;
        const LAS bf16* fl = Fl + c * 2 * n;
        const float skip = F.in[I_HYSKIP][(li * 2 + o) * HY_W + ch];
        const int xcol = (o + 1) * HY_W + ch;
        for (int blk = 0; blk < n / 512 + (n < 512 ? 1 : 0); ++blk) { const int t0 = (blk * 64 + tq) * 8;
            if (t0 < n) {
                float acc[8];
#pragma unroll
                for (int j = 0; j < 8; ++j) acc[j] = 0.f;
                for (int s8 = 0; s8 < n; s8 += 8) {
                    float fw[15], zz[8];
                    const int fb = t0 - s8 - 7 + n;
#pragma unroll
                    for (int i = 0; i < 15; ++i) fw[i] = bf2f(fl[fb + i]);
#pragma unroll
                    for (int q = 0; q < 8; ++q) zz[q] = bf2f(zin[(s8 + q) * 8 + c]);
#pragma unroll
                    for (int j = 0; j < 8; ++j)
#pragma unroll
                        for (int q = 0; q < 8; ++q) acc[j] += fw[j - q + 7] * zz[q];
                }
#pragma unroll
                for (int j = 0; j < 8; ++j) { const int t = t0 + j; const float xo = hy_short(U, cw + xcol, cbv[xcol], rowbase, t, n, xcol);
                    const float zo = bf2f(zin[t * 8 + c]); const float zn = xo * (acc[j] + skip * zo);
                    if (o == 0) zout[t * 8 + c] = (bf16)f2bf(zn); else U[(size_t)(rowbase + t) * UA_W + UA_HY + ch] = (bf16)f2bf(zn); }
            } }
        LAS bf16* tmp = zin; zin = zout; zout = tmp;
    }
    __syncthreads();
#undef HY_STAGE_RAW
#undef HY_CONV
}

__device__ __forceinline__ void na_job(Frame& F, int li, int kind, int b, int h, int blk) {
    bf16* U = F.wsp<bf16>(WS_R1);
    LAS float* qs = (LAS float*)F.lds; LAS float* ks = qs + 64 * 65; LAS float* Sc = ks + 64 * 65;
    constexpr int SP = 388;
    const int nloc = kind == 0 ? 128 : 0, ntot = nloc + 256, nch = kind == 0 ? 12 : 4;
    const int qrow0 = kind == 0 ? b * SEQ + blk * 64 : NL + b * LC + blk * 64;
    const int gi = blk, r0 = min(max(gi - 4, 0), 24);
    const int qi = F.tid >> 3, sub = F.tid & 7, d0 = sub * 8;
    const int c0 = min(max(qi - 8, 0), 48);
    const float* qg = F.in[I_NAQG] + li * 64; const float* kg = F.in[I_NAKG] + li * 64;
    const float* rpb = F.in[I_NARPB] + (size_t)(li * 6 + h) * 15 * 31;
    __syncthreads();
    { const v4u w = *(const v4u*)(U + (size_t)(qrow0 + qi) * UA_W + UA_NA + h * 64 + d0);
      float x[8] = {bflo(w.x), bfhi(w.x), bflo(w.y), bfhi(w.y), bflo(w.z), bfhi(w.z), bflo(w.w), bfhi(w.w)}; float ss = 0.f;
#pragma unroll
      for (int e = 0; e < 8; ++e) ss += x[e] * x[e];
      ss += __shfl_xor(ss, 1); ss += __shfl_xor(ss, 2); ss += __shfl_xor(ss, 4);
      const float sc = 0.125f / sqrtf(ss * (1.f / 64.f) + NORM_EPS);
#pragma unroll
      for (int e = 0; e < 8; ++e) qs[qi * 65 + d0 + e] = x[e] * sc * qg[d0 + e]; }
    for (int ch = 0; ch < nch; ++ch) {
        const bool loc = kind == 0 && ch < 8; const int cc = kind == 0 ? ch - 8 : ch;
        const int krow0 = loc ? b * SEQ + (r0 + ch) * 64 : NL + b * LC + cc * 64;
        __syncthreads();
        { const v4u w = *(const v4u*)(U + (size_t)(krow0 + qi) * UA_W + UA_NA + NA_W + h * 64 + d0);
          float x[8] = {bflo(w.x), bfhi(w.x), bflo(w.y), bfhi(w.y), bflo(w.z), bfhi(w.z), bflo(w.w), bfhi(w.w)}; float ss = 0.f;
#pragma unroll
          for (int e = 0; e < 8; ++e) ss += x[e] * x[e];
          ss += __shfl_xor(ss, 1); ss += __shfl_xor(ss, 2); ss += __shfl_xor(ss, 4);
          const float sc = 1.0f / sqrtf(ss * (1.f / 64.f) + NORM_EPS);
#pragma unroll
          for (int e = 0; e < 8; ++e) ks[qi * 65 + d0 + e] = x[e] * sc * kg[d0 + e]; }
        __syncthreads();
        if (loc) {
#pragma unroll 1
            for (int e = 0; e < 2; ++e) { const int kc = c0 + sub * 2 + e; float s = 0.f;
#pragma unroll 8
                for (int dd = 0; dd < 64; ++dd) s += qs[qi * 65 + dd] * ks[kc * 65 + dd];
                const int dr = (r0 + ch) - gi + 7, dc = min(max(kc - qi + 15, 0), 30);
                Sc[qi * SP + ch * 16 + sub * 2 + e] = s + rpb[dr * 31 + dc]; }
        } else {
#pragma unroll 1
            for (int e = 0; e < 8; ++e) { const int kj = sub * 8 + e; float s = 0.f;
#pragma unroll 8
                for (int dd = 0; dd < 64; ++dd) s += qs[qi * 65 + dd] * ks[kj * 65 + dd];
                Sc[qi * SP + nloc + cc * 64 + kj] = s; }
        }
    }
    __syncthreads();
    { float mx = -3.0e38f;
      for (int idx = sub; idx < ntot; idx += 8) mx = fmaxf(mx, Sc[qi * SP + idx]);
      mx = fmaxf(mx, __shfl_xor(mx, 1)); mx = fmaxf(mx, __shfl_xor(mx, 2)); mx = fmaxf(mx, __shfl_xor(mx, 4));
      float sm = 0.f;
      for (int idx = sub; idx < ntot; idx += 8) { const float p = __expf(Sc[qi * SP + idx] - mx); Sc[qi * SP + idx] = p; sm += p; }
      sm += __shfl_xor(sm, 1); sm += __shfl_xor(sm, 2); sm += __shfl_xor(sm, 4);
      const float inv = 1.0f / sm;
      for (int idx = sub; idx < ntot; idx += 8) Sc[qi * SP + idx] *= inv; }
    float acc[8];
#pragma unroll
    for (int e = 0; e < 8; ++e) acc[e] = 0.f;
    for (int ch = 0; ch < nch; ++ch) {
        const bool loc = kind == 0 && ch < 8; const int cc = kind == 0 ? ch - 8 : ch;
        const int krow0 = loc ? b * SEQ + (r0 + ch) * 64 : NL + b * LC + cc * 64;
        __syncthreads();
        { const v4u w = *(const v4u*)(U + (size_t)(krow0 + qi) * UA_W + UA_NA + 2 * NA_W + h * 64 + d0);
          ks[qi * 65 + d0 + 0] = bflo(w.x); ks[qi * 65 + d0 + 1] = bfhi(w.x); ks[qi * 65 + d0 + 2] = bflo(w.y); ks[qi * 65 + d0 + 3] = bfhi(w.y);
          ks[qi * 65 + d0 + 4] = bflo(w.z); ks[qi * 65 + d0 + 5] = bfhi(w.z); ks[qi * 65 + d0 + 6] = bflo(w.w); ks[qi * 65 + d0 + 7] = bfhi(w.w); }
        __syncthreads();
        if (loc) {
#pragma unroll 4
            for (int e = 0; e < 16; ++e) { const float p = Sc[qi * SP + ch * 16 + e]; const int kc = c0 + e;
#pragma unroll
                for (int dd = 0; dd < 8; ++dd) acc[dd] += p * ks[kc * 65 + d0 + dd]; } }
        else {
#pragma unroll 4
            for (int kj = 0; kj < 64; ++kj) { const float p = Sc[qi * SP + nloc + cc * 64 + kj];
#pragma unroll
                for (int dd = 0; dd < 8; ++dd) acc[dd] += p * ks[kj * 65 + d0 + dd]; } }
    }
    v4u w; w.x = pk2(acc[0], acc[1]); w.y = pk2(acc[2], acc[3]); w.z = pk2(acc[4], acc[5]); w.w = pk2(acc[6], acc[7]);
    *(v4u*)(U + (size_t)(qrow0 + qi) * UA_W + UA_NA + h * 64 + d0) = w;
    __syncthreads();
}
__device__ __forceinline__ void p5_rw_readout(Frame& F, int li) {
    const int gw = F.bid * NWAVES + F.wave, NGW = F.G * NWAVES, lane = F.lane;
    const bf16* FEAT = F.wsp<bf16>(WS_R1 + R1_FEAT); const bf16* Y = F.wsp<bf16>(WS_RB); bf16* U = F.wsp<bf16>(WS_R1);
    const int nrows = li == NLAYER - 1 ? NL : MT;
    if (lane >= 48) return;
    const int j0 = 8 * lane;
    float gg[8], gb[8], ka[8], rk[8];
#pragma unroll
    for (int e = 0; e < 8; ++e) { gg[e] = F.in[I_RWGNG][li * RW_W + j0 + e]; gb[e] = F.in[I_RWGNB][li * RW_W + j0 + e]; ka[e] = F.in[I_RWKA][li * RW_W + j0 + e]; rk[e] = F.in[I_RWRK][li * RW_W + j0 + e]; }
#pragma unroll 1
    for (int row0 = gw; row0 < nrows; row0 += 2 * NGW) {
        v4u wy0[2], wy1[2], wr[2], wk[2], wv[2], wi0[2], wi1[2], wg[2];
#pragma unroll
        for (int u = 0; u < 2; ++u) { const int row = min(row0 + u * NGW, nrows - 1);
            wy0[u] = *(const v4u*)(Y + (size_t)row * RW_W + j0); wy1[u] = *(const v4u*)(Y + ((size_t)MT + row) * RW_W + j0);
            const bf16* fp = FEAT + (size_t)row * NFEAT * RW_W + j0;
            wr[u] = *(const v4u*)fp; wk[u] = *(const v4u*)(fp + RW_W); wv[u] = *(const v4u*)(fp + 2 * RW_W); wi0[u] = *(const v4u*)(fp + 5 * RW_W); wi1[u] = *(const v4u*)(fp + 6 * RW_W); wg[u] = *(const v4u*)(fp + 7 * RW_W); }
#pragma unroll
        for (int u = 0; u < 2; ++u) { const int row = row0 + u * NGW;
            float y0[8], y1[8], r[8], k[8], v[8], i0[8], i1[8], g[8];
            unpack8(wy0[u], y0); unpack8(wy1[u], y1); unpack8(wr[u], r); unpack8(wk[u], k); unpack8(wv[u], v); unpack8(wi0[u], i0); unpack8(wi1[u], i1); unpack8(wg[u], g);
            float sm = 0.f;
#pragma unroll
            for (int e = 0; e < 8; ++e) { y0[e] += y1[e]; sm += y0[e]; }
            sm += __shfl_xor(sm, 1); sm += __shfl_xor(sm, 2); sm += __shfl_xor(sm, 4);
            const float mu = sm * (1.f / 64.f); float sq = 0.f, bs = 0.f;
#pragma unroll
            for (int e = 0; e < 8; ++e) { y0[e] -= mu; sq += y0[e] * y0[e]; bs += r[e] * (k[e] * (2.0f + (i0[e] + i1[e] - 2.0f) * ka[e])) * rk[e]; }
            sq += __shfl_xor(sq, 1); sq += __shfl_xor(sq, 2); sq += __shfl_xor(sq, 4);
            bs += __shfl_xor(bs, 1); bs += __shfl_xor(bs, 2); bs += __shfl_xor(bs, 4);
            const float rs = 1.0f / sqrtf(sq * (1.f / 64.f) + RW_GN_EPS);
            float o[8];
#pragma unroll
            for (int e = 0; e < 8; ++e) o[e] = (y0[e] * rs * gg[e] + gb[e] + bs * v[e]) * g[e];
            if (row < nrows) *(v4u*)(U + (size_t)row * UA_W + j0) = pack8(o); }
    }
}

__device__ __forceinline__ void p8_norm2(Frame& F, int li, int dry) {
    const int gw = F.bid * NWAVES + F.wave, NGW = F.G * NWAVES, lane = F.lane;
    const float* g = F.in[I_N2G] + li * D;
    if (li == 0) {
        bf16* H2 = F.wsp<bf16>(WS_RA);
        for (int row = gw; row < MT; row += NGW) { const bool isl = row < NL; const int r9 = isl ? row >> 11 : 8;
            const float* xr = isl ? F.out + (size_t)row * D : F.wsp<float>(WS_CTXRES) + (size_t)(row - NL) * D; const float* md = F.mods(li, r9);
            f32x4 v[4]; norm_row(xr, g, md + 3 * D, md + 4 * D, lane, v); store_row_bf16(H2 + (size_t)row * D, lane, v); }
    } else {
        bf16* H2 = F.wsp<bf16>(WS_R1 + R1_H2U);
        int* rowtok = (int*)(F.ws + WS_MISC + MISC_ROWTOK);
        if (!dry) for (int i = F.bid * NTHREADS + F.tid; i < MOE_ROWS; i += F.G * NTHREADS) rowtok[i] = -1;
        unsigned* cnt = (unsigned*)(F.ws + WS_CTL) + CW_MOECNT;
        const float* router = F.in[I_MOER];
        int* sel = (int*)(F.ws + WS_MISC + MISC_SEL);
        for (int row = gw; row < NL; row += NGW) { const float* md = F.mods(li, row >> 11);
            f32x4 v[4]; norm_row(F.out + (size_t)row * D, g, md + 3 * D, md + 4 * D, lane, v); store_row_bf16(H2 + (size_t)row * D, lane, v);
            float lg[8];
#pragma unroll
            for (int e = 0; e < 8; ++e) lg[e] = 0.f;
#pragma unroll
            for (int j = 0; j < 4; ++j) { const int k0 = 4 * lane + 256 * j;
#pragma unroll
                for (int q = 0; q < 4; ++q) { const f32x4 ra = ((const f32x4*)(router + (size_t)(k0 + q) * 8))[0], rb = ((const f32x4*)(router + (size_t)(k0 + q) * 8))[1]; const float x = v[j][q];
                    lg[0] += x * ra.x; lg[1] += x * ra.y; lg[2] += x * ra.z; lg[3] += x * ra.w; lg[4] += x * rb.x; lg[5] += x * rb.y; lg[6] += x * rb.z; lg[7] += x * rb.w; } }
#pragma unroll
            for (int e = 0; e < 8; ++e) lg[e] = wave_sum(lg[e]);
            int ea = 0; float la = lg[0];
#pragma unroll
            for (int e = 1; e < 8; ++e) if (lg[e] > la) { la = lg[e]; ea = e; }
            int eb = -1; float lb = -3.0e38f;
#pragma unroll
            for (int e = 0; e < 8; ++e) if (e != ea && lg[e] > lb) { lb = lg[e]; eb = e; }
            const float wa = 1.0f / (1.0f + __expf(lb - la)), wb = 1.0f - wa;
            if (lane == 0) { const unsigned inc = dry ? 0u : 1u; const unsigned ra = __hip_atomic_fetch_add(cnt + 64 * ea, inc, __ATOMIC_RELAXED, __HIP_MEMORY_SCOPE_AGENT), rb = __hip_atomic_fetch_add(cnt + 64 * eb, inc, __ATOMIC_RELAXED, __HIP_MEMORY_SCOPE_AGENT);
                if (!dry) {
                int* s = sel + (size_t)row * 8; s[0] = ea; s[1] = (int)ra; s[2] = __float_as_int(wa); s[3] = eb; s[4] = (int)rb; s[5] = __float_as_int(wb); } }
        }
    }
}
__device__ __forceinline__ void p8b_gather(Frame& F) {
    const int gw = F.bid * NWAVES + F.wave, NGW = F.G * NWAVES, lane = F.lane;
    const unsigned* cnt = (const unsigned*)(F.ws + WS_CTL) + CW_MOECNT;
    int off[8]; { int t = 0;
#pragma unroll
        for (int e = 0; e < 8; ++e) { off[e] = t * 256; t += (int)((__builtin_amdgcn_readfirstlane(cnt[64 * e]) + 255u) >> 8); } }
    const bf16* H2 = F.wsp<bf16>(WS_R1 + R1_H2U); bf16* AS = F.wsp<bf16>(WS_RA);
    int* rowtok = (int*)(F.ws + WS_MISC + MISC_ROWTOK); float* rowwgt = (float*)(F.ws + WS_MISC + MISC_ROWWGT);
    const int* sel = (const int*)(F.ws + WS_MISC + MISC_SEL);
    for (int row = gw; row < NL; row += NGW) { const int* s = sel + (size_t)row * 8;
        const int ea = s[0], ra = s[1], eb = s[3], rb = s[4];
        int oa = 0, ob = 0;
#pragma unroll
        for (int e = 0; e < 8; ++e) { oa = (e == ea) ? off[e] : oa; ob = (e == eb) ? off[e] : ob; }
        const int pa = oa + ra, pb = ob + rb;
        const v4u* src = (const v4u*)(H2 + (size_t)row * D); v4u* da = (v4u*)(AS + (size_t)pa * D); v4u* db = (v4u*)(AS + (size_t)pb * D);
#pragma unroll
        for (int j = 0; j < 2; ++j) { const v4u w = src[lane + 64 * j]; da[lane + 64 * j] = w; db[lane + 64 * j] = w; }
        if (lane == 0) { rowtok[pa] = row; rowwgt[pa] = __int_as_float(s[2]); rowtok[pb] = row; rowwgt[pb] = __int_as_float(s[5]); }
    }
}

__device__ __forceinline__ void p11_moe_combine(Frame& F, int li, int dry) {
    const int gw = F.bid * NWAVES + F.wave, NGW = F.G * NWAVES, lane = F.lane;
    const unsigned* cnt = (const unsigned*)(F.ws + WS_CTL) + CW_MOECNT;
    int off[8]; { int t = 0;
#pragma unroll
        for (int e = 0; e < 8; ++e) { off[e] = t * 256; t += (int)((__builtin_amdgcn_readfirstlane(cnt[64 * e]) + 255u) >> 8); } }
    const bf16* YP = F.wsp<bf16>(WS_RA); const int* sel = (const int*)(F.ws + WS_MISC + MISC_SEL);
    for (int row = gw; row < NL; row += NGW) { const int* s = sel + (size_t)row * 8;
        const int ea = s[0], ra = s[1], eb = s[3], rb = s[4]; const float wa = dry ? 0.f : __int_as_float(s[2]), wb = dry ? 0.f : __int_as_float(s[5]);
        int oa = 0, ob = 0;
#pragma unroll
        for (int e = 0; e < 8; ++e) { oa = (e == ea) ? off[e] : oa; ob = (e == eb) ? off[e] : ob; }
        const v2u* ya = (const v2u*)(YP + (size_t)(oa + ra) * D) + lane; const v2u* yb = (const v2u*)(YP + (size_t)(ob + rb) * D) + lane;
        const float* gate = F.mods(li, row >> 11) + 5 * D; f32x4* op = (f32x4*)(F.out + (size_t)row * D) + lane;
#pragma unroll
        for (int j = 0; j < 4; ++j) { const v2u a = ya[64 * j], b = yb[64 * j]; const f32x4 g = ((const f32x4*)gate)[lane + 64 * j]; f32x4 x = op[64 * j];
            x.x += g.x * (wa * bflo(a.x) + wb * bflo(b.x)); x.y += g.y * (wa * bfhi(a.x) + wb * bfhi(b.x));
            x.z += g.z * (wa * bflo(a.y) + wb * bflo(b.y)); x.w += g.w * (wa * bfhi(a.y) + wb * bfhi(b.y));
            op[64 * j] = x; }
    }
}

constexpr int NCHUNK = 36, NCHAIN = 96;
constexpr size_t SCR_GH = WS_WM13;
constexpr size_t SZ_GHSLOT = 2 * 64 * 64 * 4;
constexpr size_t SCR_AW = SCR_GH + (size_t)NCHAIN * NCHUNK * SZ_GHSLOT;
constexpr size_t SZ_AWSLOT = 128 * 64 * 2;
static_assert(SCR_AW + (size_t)NCHAIN * NCHUNK * SZ_AWSLOT <= WS_CTXRES, "RWKV scratch fits in the MoE weight region");
constexpr int LDK = 72;
constexpr int LDF = 68;
constexpr int MATB = 64 * LDK * 2, MATF = 64 * LDF * 4;
typedef short bf16x8_t __attribute__((ext_vector_type(8)));

__device__ __forceinline__ int rw_row(int b, int d, int p) {
    if (p < LC) { const int t = d ? LC - 1 - p : p; return NL + b * LC + t; }
    const int q = p - LC, t = d ? SEQ - 1 - q : q; return b * SEQ + t;
}
__device__ __forceinline__ f32x4 rw_mma(const LAS bf16* A, const LAS bf16* Bt, int lane, f32x4 acc) {
    const int r = lane & 15, q = lane >> 4;
#pragma unroll
    for (int ks = 0; ks < 2; ++ks) { const bf16x8_t a = *(const LAS bf16x8_t*)(A + r * LDK + ks * 32 + q * 8); const bf16x8_t b = *(const LAS bf16x8_t*)(Bt + r * LDK + ks * 32 + q * 8);
        acc = __builtin_amdgcn_mfma_f32_16x16x32_bf16(a, b, acc, 0, 0, 0); }
    return acc;
}

template <int PH>
__device__ __forceinline__ void rw_stage(Frame& F, int li, int b, int h, int d, int c, LAS unsigned char* L, LAS float* ecum,
                                         LAS bf16* m0, LAS bf16* m1, LAS bf16* m2, LAS bf16* t0, LAS bf16* t1, LAS bf16* vt, LAS float* xa, LAS float* gC) {
    const int t = F.tid >> 3, d0 = (F.tid & 7) * 8;
    const int row = rw_row(b, d, c * 64 + t);
    const bf16* fp = F.wsp<bf16>(WS_R1 + R1_FEAT) + (size_t)row * NFEAT * RW_W + h * 64 + d0;
    float r[8], k[8], v[8], e[8], ic[8], kk[8];
    unpack8(*(const v4u*)(fp), r); unpack8(*(const v4u*)(fp + RW_W), k); unpack8(*(const v4u*)(fp + 2 * RW_W), v); unpack8(*(const v4u*)(fp + (3 + d) * RW_W), e); unpack8(*(const v4u*)(fp + (5 + d) * RW_W), ic);
    const float* kkp = F.in[I_RWKK] + li * RW_W + h * 64 + d0; const float* kap = F.in[I_RWKA] + li * RW_W + h * 64 + d0;
    float ss = 0.f;
#pragma unroll
    for (int j = 0; j < 8; ++j) { kk[j] = k[j] * kkp[j]; ss += kk[j] * kk[j]; }
    ss += __shfl_xor(ss, 1); ss += __shfl_xor(ss, 2); ss += __shfl_xor(ss, 4);
    const float inv = 1.0f / fmaxf(sqrtf(ss), 1e-12f);
    float cs[8];
#pragma unroll
    for (int j = 0; j < 8; ++j) { kk[j] *= inv; cs[j] = e[j]; }
#pragma unroll
    for (int off = 8; off < 64; off <<= 1) {
#pragma unroll
        for (int j = 0; j < 8; ++j) { const float u = __shfl_up(cs[j], off); if ((F.tid & 63) >= off) cs[j] += u; } }
    if (((F.tid & 63) >> 3) == 7) {
#pragma unroll
        for (int j = 0; j < 8; ++j) ecum[(F.tid >> 6) * 64 + d0 + j] = cs[j]; }
    __syncthreads();
#pragma unroll
    for (int wq = 0; wq < 7; ++wq) { if (wq < (F.tid >> 6)) { const f32x4 o0 = *(const LAS f32x4*)(ecum + wq * 64 + d0), o1 = *(const LAS f32x4*)(ecum + wq * 64 + d0 + 4);
        cs[0] += o0.x; cs[1] += o0.y; cs[2] += o0.z; cs[3] += o0.w; cs[4] += o1.x; cs[5] += o1.y; cs[6] += o1.z; cs[7] += o1.w; } }
    float at[8], bt[8], kt[8], rt[8];
#pragma unroll
    for (int j = 0; j < 8; ++j) { const float cv = cs[j]; const float g = __expf(-cv), gi = __expf(cv), gp = __expf(e[j] - cv);
        at[j] = -kk[j] * gp; bt[j] = kk[j] * ic[j] * gi; kt[j] = k[j] * (1.0f + (ic[j] - 1.0f) * kap[j]) * gi; rt[j] = r[j] * g;
        if (PH == 0 && t == 63) gC[d0 + j] = g; }
    if (PH == 0) {
        *(LAS v4u*)(m0 + t * LDK + d0) = pack8(at); *(LAS v4u*)(m1 + t * LDK + d0) = pack8(bt); *(LAS v4u*)(m2 + t * LDK + d0) = pack8(kt);
#pragma unroll
        for (int j = 0; j < 8; ++j) { t0[(d0 + j) * LDK + t] = (bf16)f2bf(bt[j]); t1[(d0 + j) * LDK + t] = (bf16)f2bf(kt[j]); vt[(d0 + j) * LDK + t] = (bf16)f2bf(v[j]); xa[(d0 + j) * LDF + t] = at[j]; }
    } else {
        *(LAS v4u*)(m0 + t * LDK + d0) = pack8(bt); *(LAS v4u*)(m1 + t * LDK + d0) = pack8(kt); *(LAS v4u*)(m2 + t * LDK + d0) = pack8(rt);
#pragma unroll
        for (int j = 0; j < 8; ++j) vt[(d0 + j) * LDK + t] = (bf16)f2bf(v[j]);
    }
}

__device__ __forceinline__ void rw_phaseA_job(Frame& F, int li, int chain, int c) {
    const int b = chain / 12, h = (chain % 12) >> 1, d = chain & 1, lane = F.lane, w = F.wave;
    LAS unsigned char* L = F.lds;
    LAS bf16* At = (LAS bf16*)(L + 0 * MATB); LAS bf16* Bt = (LAS bf16*)(L + 1 * MATB); LAS bf16* Kt = (LAS bf16*)(L + 2 * MATB);
    LAS bf16* BtT = (LAS bf16*)(L + 3 * MATB); LAS bf16* KtT = (LAS bf16*)(L + 4 * MATB); LAS bf16* VT = (LAS bf16*)(L + 5 * MATB); LAS bf16* NakT = (LAS bf16*)(L + 6 * MATB);
    LAS bf16* AW = (LAS bf16*)(L + 7 * MATB);
    LAS float* Nab = (LAS float*)(L + 9 * MATB);
    LAS float* X = (LAS float*)(L + 9 * MATB + MATF);
    LAS float* gC = (LAS float*)(L + 9 * MATB + 3 * MATF);
    LAS float* MinvB = gC + 64;
    __syncthreads();
    rw_stage<0>(F, li, b, h, d, c, L, Nab, At, Bt, Kt, BtT, KtT, VT, X, gC);
    __syncthreads();
    const int tr = w >> 1, tcb = (w & 1) * 2, q = lane >> 4, rr = lane & 15;
    f32x4 nab[2], nak[2];
#pragma unroll
    for (int i = 0; i < 2; ++i) { const f32x4 z = {0.f, 0.f, 0.f, 0.f}; nab[i] = rw_mma(Bt + tr * 16 * LDK, At + (tcb + i) * 16 * LDK, lane, z); nak[i] = rw_mma(Kt + tr * 16 * LDK, At + (tcb + i) * 16 * LDK, lane, z); }
    __syncthreads();
#pragma unroll
    for (int i = 0; i < 2; ++i)
#pragma unroll
        for (int g = 0; g < 4; ++g) { const int s = tr * 16 + q * 4 + g, t = (tcb + i) * 16 + rr; const bool keep = s < t;
            Nab[s * LDF + t] = keep ? nab[i][g] : 0.f; NakT[t * LDK + s] = (bf16)f2bf(keep ? nak[i][g] : 0.f); }
    __syncthreads();
#pragma unroll
    for (int i = 0; i < 2; ++i) { const f32x4 z = {0.f, 0.f, 0.f, 0.f}; const f32x4 o = rw_mma(VT + tr * 16 * LDK, NakT + (tcb + i) * 16 * LDK, lane, z);
#pragma unroll
        for (int g = 0; g < 4; ++g) X[(64 + tr * 16 + q * 4 + g) * LDF + (tcb + i) * 16 + rr] = o[g]; }
    if (F.tid < 64) { const int blk = F.tid >> 4, i = F.tid & 15; float m[16];
#pragma unroll
        for (int t = 0; t < 16; ++t) { float a = (t == i) ? 1.f : 0.f;
#pragma unroll
            for (int s = 0; s < 16; ++s) if (s < t) a += m[s] * Nab[(16 * blk + s) * LDF + 16 * blk + t];
            m[t] = a; }
#pragma unroll
        for (int t = 0; t < 16; ++t) MinvB[(blk * 16 + i) * 16 + t] = m[t]; }
    __syncthreads();
#define RW_QB(v_, c_) __builtin_bit_cast(float, __builtin_amdgcn_update_dpp(0, __builtin_bit_cast(int, (v_)), (c_), 0xf, 0xf, false))
    { const int row = F.tid >> 2, cq = (F.tid & 3) * 4; bf16* gslot = (bf16*)(F.ws + SCR_AW + (size_t)(chain * NCHUNK + c) * SZ_AWSLOT);
      float xall[64];
#pragma unroll
      for (int jb = 0; jb < 4; ++jb) {
          f32x4 x4 = *(const LAS f32x4*)(X + row * LDF + 16 * jb + cq);
          if (jb > 0) { f32x4 acc = {0.f, 0.f, 0.f, 0.f};
#pragma unroll
              for (int s = 0; s < 16 * jb; ++s) { const f32x4 n4 = *(const LAS f32x4*)(Nab + s * LDF + 16 * jb + cq); acc += xall[s] * n4; }
              x4 += acc; }
          float xr[16];
#pragma unroll
          for (int e = 0; e < 4; ++e) { const float xe = x4[e];
              xr[e] = RW_QB(xe, 0x00); xr[4 + e] = RW_QB(xe, 0x55); xr[8 + e] = RW_QB(xe, 0xAA); xr[12 + e] = RW_QB(xe, 0xFF); }
          f32x4 o = {0.f, 0.f, 0.f, 0.f};
#pragma unroll
          for (int s = 0; s < 16; ++s) { const f32x4 m4 = *(const LAS f32x4*)(MinvB + (jb * 16 + s) * 16 + cq); o += xr[s] * m4; }
#pragma unroll
          for (int e = 0; e < 4; ++e) { const float oe = o[e]; xall[16 * jb + e] = RW_QB(oe, 0x00); xall[16 * jb + 4 + e] = RW_QB(oe, 0x55); xall[16 * jb + 8 + e] = RW_QB(oe, 0xAA); xall[16 * jb + 12 + e] = RW_QB(oe, 0xFF); }
          const v2u pw = {pk2(o[0], o[1]), pk2(o[2], o[3])};
          *(LAS v2u*)(AW + row * LDK + 16 * jb + cq) = pw; *(v2u*)(gslot + row * 64 + 16 * jb + cq) = pw;
      } }
#undef RW_QB
    __syncthreads();
    { float* gh = (float*)(F.ws + SCR_GH + (size_t)(chain * NCHUNK + c) * SZ_GHSLOT);
#pragma unroll
      for (int i = 0; i < 2; ++i) { const f32x4 z = {0.f, 0.f, 0.f, 0.f};
          const f32x4 gg = rw_mma(BtT + (tcb + i) * 16 * LDK, AW + tr * 16 * LDK, lane, z);
          f32x4 hh = rw_mma(BtT + (tcb + i) * 16 * LDK, AW + (64 + tr * 16) * LDK, lane, z); hh = rw_mma(KtT + (tcb + i) * 16 * LDK, VT + tr * 16 * LDK, lane, hh);
          const int k0 = (tcb + i) * 16 + 4 * q, j = tr * 16 + rr; const f32x4 gk = *(const LAS f32x4*)(gC + k0);
          f32x4 go = gg * gk, ho = hh * gk;
#pragma unroll
          for (int g = 0; g < 4; ++g) go[g] += (j == k0 + g) ? gk[g] : 0.f;
          *(f32x4*)(gh + j * 64 + k0) = go; *(f32x4*)(gh + 4096 + j * 64 + k0) = ho; } }
}

__device__ __forceinline__ void rw_phaseB_chain(Frame& F, int chain, int dry) {
    LAS float* Ss = (LAS float*)F.lds;
    LAS float* Gs = Ss + 64 * LDF;
    const int v = F.tid >> 3, k0 = (F.tid & 7) * 8;
    const unsigned char* base = F.ws + SCR_GH + (size_t)chain * NCHUNK * SZ_GHSLOT;
    f32x4 sp0 = {0.f, 0.f, 0.f, 0.f}, sp1 = sp0;
    __syncthreads();
    *(LAS f32x4*)(Ss + v * LDF + k0) = sp0; *(LAS f32x4*)(Ss + v * LDF + k0 + 4) = sp1;
    f32x4 g0[2], g1[2], h0[2], h1[2];
#pragma unroll
    for (int p = 0; p < 2; ++p) { const float* gh = (const float*)(base + (size_t)p * SZ_GHSLOT);
        g0[p] = *(const f32x4*)(gh + v * 64 + k0); g1[p] = *(const f32x4*)(gh + v * 64 + k0 + 4); h0[p] = *(const f32x4*)(gh + 4096 + v * 64 + k0); h1[p] = *(const f32x4*)(gh + 4096 + v * 64 + k0 + 4); }
#pragma unroll 1
    for (int c2 = 0; c2 < NCHUNK; c2 += 2) {
#pragma unroll
        for (int p = 0; p < 2; ++p) { const int c = c2 + p;
            const f32x4 gc0 = g0[p], gc1 = g1[p]; f32x4 a0 = h0[p], a1 = h1[p];
            asm volatile("" ::: "memory");
            __syncthreads();
            *(LAS f32x4*)(Gs + v * LDF + k0) = gc0; *(LAS f32x4*)(Gs + v * LDF + k0 + 4) = gc1;
            *(LAS f32x4*)(Ss + v * LDF + k0) = sp0; *(LAS f32x4*)(Ss + v * LDF + k0 + 4) = sp1;
            if (c >= 1 && !dry) { float x[8] = {sp0.x, sp0.y, sp0.z, sp0.w, sp1.x, sp1.y, sp1.z, sp1.w}; *(v4u*)((bf16*)(base + (size_t)(c - 1) * SZ_GHSLOT) + v * 64 + k0) = pack8(x); }
            if (c + 2 < NCHUNK) { const float* gh = (const float*)(base + (size_t)(c + 2) * SZ_GHSLOT);
                g0[p] = *(const f32x4*)(gh + v * 64 + k0); g1[p] = *(const f32x4*)(gh + v * 64 + k0 + 4); h0[p] = *(const f32x4*)(gh + 4096 + v * 64 + k0); h1[p] = *(const f32x4*)(gh + 4096 + v * 64 + k0 + 4); }
            __syncthreads();
#pragma unroll 8
            for (int j = 0; j < 64; ++j) { const float s = Ss[v * LDF + j]; const f32x4 ga = *(const LAS f32x4*)(Gs + j * LDF + k0), gb = *(const LAS f32x4*)(Gs + j * LDF + k0 + 4); a0 += s * ga; a1 += s * gb; }
            sp0 = a0; sp1 = a1; }
    }
    __syncthreads();
}

__device__ __forceinline__ void rw_phaseC_job(Frame& F, int li, int chain, int c, int dry) {
    const int b = chain / 12, h = (chain % 12) >> 1, d = chain & 1, lane = F.lane, w = F.wave;
    LAS unsigned char* L = F.lds;
    LAS bf16* Bt = (LAS bf16*)(L + 0 * MATB); LAS bf16* Kt = (LAS bf16*)(L + 1 * MATB); LAS bf16* Rt = (LAS bf16*)(L + 2 * MATB); LAS bf16* VT = (LAS bf16*)(L + 3 * MATB);
    LAS bf16* NrbT = (LAS bf16*)(L + 4 * MATB); LAS bf16* NrkT = (LAS bf16*)(L + 5 * MATB); LAS bf16* QT = (LAS bf16*)(L + 6 * MATB); LAS bf16* AW = (LAS bf16*)(L + 7 * MATB);
    LAS float* ecum = (LAS float*)(L + 9 * MATB); LAS bf16* Sb = (LAS bf16*)(L + 9 * MATB + MATF); LAS float* Yt = (LAS float*)(L + 10 * MATB + MATF);
    __syncthreads();
    rw_stage<1>(F, li, b, h, d, c, L, ecum, Bt, Kt, Rt, nullptr, nullptr, VT, nullptr, nullptr);
    { const bf16* gslot = (const bf16*)(F.ws + SCR_AW + (size_t)(chain * NCHUNK + c) * SZ_AWSLOT);
      const int row = F.tid >> 2, c0 = (F.tid & 3) * 16;
      *(LAS v4u*)(AW + row * LDK + c0) = *(const v4u*)(gslot + row * 64 + c0); *(LAS v4u*)(AW + row * LDK + c0 + 8) = *(const v4u*)(gslot + row * 64 + c0 + 8);
      const bf16* sg = (const bf16*)(F.ws + SCR_GH + (size_t)(chain * NCHUNK + (c > 0 ? c - 1 : 0)) * SZ_GHSLOT);
      const int v = F.tid >> 3, k0 = (F.tid & 7) * 8; v4u sw = *(const v4u*)(sg + v * 64 + k0); if (c == 0) sw = (v4u){0u, 0u, 0u, 0u}; *(LAS v4u*)(Sb + v * LDK + k0) = sw; }
    __syncthreads();
    const int tr = w >> 1, tcb = (w & 1) * 2, q = lane >> 4, rr = lane & 15;
#pragma unroll
    for (int i = 0; i < 2; ++i) { const f32x4 z = {0.f, 0.f, 0.f, 0.f}; const f32x4 nb = rw_mma(Bt + tr * 16 * LDK, Rt + (tcb + i) * 16 * LDK, lane, z), nk = rw_mma(Kt + tr * 16 * LDK, Rt + (tcb + i) * 16 * LDK, lane, z);
#pragma unroll
        for (int g = 0; g < 4; ++g) { const int s = tr * 16 + q * 4 + g, t = (tcb + i) * 16 + rr; const bool keep = s <= t;
            NrbT[t * LDK + s] = (bf16)f2bf(keep ? nb[g] : 0.f); NrkT[t * LDK + s] = (bf16)f2bf(keep ? nk[g] : 0.f); } }
    __syncthreads();
#pragma unroll
    for (int i = 0; i < 2; ++i) { const f32x4 z = {0.f, 0.f, 0.f, 0.f}; const f32x4 o = rw_mma(AW + tr * 16 * LDK, NrbT + (tcb + i) * 16 * LDK, lane, z);
#pragma unroll
        for (int g = 0; g < 4; ++g) { const int k = tr * 16 + q * 4 + g, t = (tcb + i) * 16 + rr; QT[t * LDK + k] = (bf16)f2bf(o[g] + bf2f(Rt[t * LDK + k])); } }
    __syncthreads();
#pragma unroll
    for (int i = 0; i < 2; ++i) { f32x4 o = {0.f, 0.f, 0.f, 0.f};
        o = rw_mma(Sb + tr * 16 * LDK, QT + (tcb + i) * 16 * LDK, lane, o); o = rw_mma(AW + (64 + tr * 16) * LDK, NrbT + (tcb + i) * 16 * LDK, lane, o); o = rw_mma(VT + tr * 16 * LDK, NrkT + (tcb + i) * 16 * LDK, lane, o);
#pragma unroll
        for (int g = 0; g < 4; ++g) Yt[((tcb + i) * 16 + rr) * LDF + tr * 16 + q * 4 + g] = o[g]; }
    __syncthreads();
    { const int t = F.tid >> 3, d0 = (F.tid & 7) * 8; const int row = rw_row(b, d, c * 64 + t); bf16* yp = F.wsp<bf16>(WS_RB) + ((size_t)d * MT + row) * RW_W + h * 64 + d0;
      float x[8];
#pragma unroll
      for (int j = 0; j < 8; ++j) x[j] = Yt[t * LDF + d0 + j];
      *(v4u*)yp = pack8(x); (void)dry; }
}


constexpr int P3_AS = 392;
constexpr int P3_WAVE_LDS = 16 * P3_AS * 2;
constexpr int P3_ROWS = 72;
__device__ __forceinline__ void p3_job(Frame& F, int li, int job) {
    const int lane = F.lane, r = lane & 15, g = lane >> 4;
    const int row0 = job * P3_ROWS;
    const bf16* U = F.wsp<bf16>(WS_R1); bf16* FEAT = F.wsp<bf16>(WS_R1 + R1_FEAT);
    LAS bf16* Ain = (LAS bf16*)F.lds;
    const float* mu0 = F.in[I_RWSHIFT] + (size_t)li * 2 * RW_IN; const float* mu1 = mu0 + RW_IN;
    const float* rope = F.wsp<float>(WS_MISC + MISC_ROPE);
    __syncthreads();
    for (int i = F.tid; i < 8 * P3_AS / 8; i += NTHREADS) *(LAS v4u*)(Ain + 72 * P3_AS + 8 * i) = (v4u){0u, 0u, 0u, 0u};
#pragma unroll 1
    for (int it = 0; it < 3; ++it) {
        const int idx = F.tid + NTHREADS * it, slot = idx % 192, run = idx / 192;
        int c1, c2, kindv;
        int fsel = 0, ocol1 = 0, half = 0, p = 0;
        if (slot < 96) { const int tensor = slot / 48, hd = (slot % 48) >> 3, sub = slot & 7; half = sub >> 2; p = (sub & 3) * 4; c1 = tensor * RW_W + hd * 64 + half * 32 + p; c2 = c1 + 16; kindv = 0; fsel = tensor; ocol1 = hd * 64 + half * 32 + p; }
        else if (slot < 144) { c1 = 2 * RW_W + (slot - 96) * 8; c2 = c1 + 4; kindv = 1; fsel = 2; ocol1 = (slot - 96) * 8; }
        else { c1 = 3 * RW_W + (slot - 144) * 8; c2 = c1 + 4; kindv = 2; ocol1 = (slot - 144) * 8; }
        float m0a[4], m0b[4], m1a[4], m1b[4];
#pragma unroll
        for (int e = 0; e < 4; ++e) { m0a[e] = mu0[c1 + e]; m0b[e] = mu0[c2 + e]; m1a[e] = mu1[c1 + e]; m1b[e] = mu1[c2 + e]; }
        v2u ra[11], rb[11];
#pragma unroll
        for (int i = 0; i < 11; ++i) { const int rw = min(max(row0 + 9 * run - 1 + i, 0), MT - 1); const bf16* up = U + (size_t)rw * UA_W; ra[i] = *(const v2u*)(up + c1); rb[i] = *(const v2u*)(up + c2); }
#pragma unroll
        for (int t9 = 0; t9 < 9; ++t9) { const int tt = 9 * run + t9, row = row0 + tt;
            const bool isl = row < NL; const int t = isl ? (row & (SEQ - 1)) : ((row - NL) & (LC - 1)); const int n = isl ? SEQ : LC;
            const bool hp = t > 0, hn = t < n - 1;
            float xa[4], xb[4];
            { const v2u pa = ra[t9], ca = ra[t9 + 1], na = ra[t9 + 2], pb2 = rb[t9], cb = rb[t9 + 1], nb = rb[t9 + 2];
              const float pav[4] = {bflo(pa.x), bfhi(pa.x), bflo(pa.y), bfhi(pa.y)}, cav[4] = {bflo(ca.x), bfhi(ca.x), bflo(ca.y), bfhi(ca.y)}, nav[4] = {bflo(na.x), bfhi(na.x), bflo(na.y), bfhi(na.y)};
              const float pbv[4] = {bflo(pb2.x), bfhi(pb2.x), bflo(pb2.y), bfhi(pb2.y)}, cbv[4] = {bflo(cb.x), bfhi(cb.x), bflo(cb.y), bfhi(cb.y)}, nbv[4] = {bflo(nb.x), bfhi(nb.x), bflo(nb.y), bfhi(nb.y)};
#pragma unroll
              for (int e = 0; e < 4; ++e) { const float pva = hp ? pav[e] : 0.f, nva = hn ? nav[e] : 0.f, pvb = hp ? pbv[e] : 0.f, nvb = hn ? nbv[e] : 0.f;
                  xa[e] = cav[e] + m0a[e] * (pva - cav[e]) + m1a[e] * (nva - cav[e]); xb[e] = cbv[e] + m0b[e] * (pvb - cbv[e]) + m1b[e] * (nvb - cbv[e]); } }
            if (kindv == 0) {
                float o1[4], o2[4];
                if (isl) { const int pos = half == 0 ? (t >> 6) : (t & 63); const float* rp = rope + (pos * 16 + p) * 2;
#pragma unroll
                    for (int e = 0; e < 4; ++e) { const float cs = rp[2 * e], sn = rp[2 * e + 1]; o1[e] = xa[e] * cs - xb[e] * sn; o2[e] = xa[e] * sn + xb[e] * cs; } }
                else {
#pragma unroll
                    for (int e = 0; e < 4; ++e) { o1[e] = xa[e]; o2[e] = xb[e]; } }
                bf16* fo = FEAT + ((size_t)row * NFEAT + fsel) * RW_W + ocol1;
                *(v2u*)fo = (v2u){pk2(o1[0], o1[1]), pk2(o1[2], o1[3])}; *(v2u*)(fo + 16) = (v2u){pk2(o2[0], o2[1]), pk2(o2[2], o2[3])};
            } else if (kindv == 1) {
                bf16* fo = FEAT + ((size_t)row * NFEAT + 2) * RW_W + ocol1;
                *(v4u*)fo = (v4u){pk2(xa[0], xa[1]), pk2(xa[2], xa[3]), pk2(xb[0], xb[1]), pk2(xb[2], xb[3])};
            } else {
                const int lc = ocol1;
#pragma unroll
                for (int e = 0; e < 4; ++e) { if (lc < 128) { xa[e] = tanhf(xa[e]); xb[e] = tanhf(xb[e]); } else if (lc >= 256) { xa[e] = sigmoidf_(xa[e]); xb[e] = sigmoidf_(xb[e]); } }
                *(LAS v4u*)(Ain + tt * P3_AS + lc) = (v4u){pk2(xa[0], xa[1]), pk2(xa[2], xa[3]), pk2(xb[0], xb[1]), pk2(xb[2], xb[3])};
            }
        }
    }
    __syncthreads();
    const bf16* RWT = F.wsp<bf16>(WS_MISC + MISC_RWT) + (size_t)li * RWT_PER_LAYER;
#pragma unroll 1
    for (int q3 = 0; q3 < 3; ++q3) { const int nt = 3 * F.wave + q3, nc = nt * 16 + r;
        v4u wc[12];
#pragma unroll
        for (int pr = 0; pr < 4; ++pr) { const bf16* wt = RWT + (size_t)pr * 384 * 64 + (size_t)nc * 64 + 8 * g; wc[2 * pr] = *(const v4u*)wt; wc[2 * pr + 1] = *(const v4u*)(wt + 32); }
        { const bf16* wt = RWT + RWT_G2 + (size_t)nc * 128 + 8 * g;
#pragma unroll
          for (int ks = 0; ks < 4; ++ks) wc[8 + ks] = *(const v4u*)(wt + 32 * ks); }
        const int nc0 = nt * 16 + 4 * g;
        const f32x4 w00 = *(const f32x4*)(F.in[I_RWW0] + (li * 2 + 0) * RW_W + nc0), w01 = *(const f32x4*)(F.in[I_RWW0] + (li * 2 + 1) * RW_W + nc0);
        const f32x4 a00 = *(const f32x4*)(F.in[I_RWA0] + (li * 2 + 0) * RW_W + nc0), a01 = *(const f32x4*)(F.in[I_RWA0] + (li * 2 + 1) * RW_W + nc0);
#pragma unroll 1
        for (int mt = 0; mt < 5; ++mt) {
            f32x4 acc[5];
#pragma unroll
            for (int pr = 0; pr < 5; ++pr) acc[pr] = (f32x4){0.f, 0.f, 0.f, 0.f};
            const LAS bf16* ap = Ain + (mt * 16 + r) * P3_AS + 8 * g;
#pragma unroll
            for (int pr = 0; pr < 4; ++pr)
#pragma unroll
                for (int ks = 0; ks < 2; ++ks) acc[pr] = __builtin_amdgcn_mfma_f32_16x16x32_bf16(__builtin_bit_cast(bf16x8_t, wc[2 * pr + ks]), *(const LAS bf16x8_t*)(ap + 32 * (2 * pr + ks)), acc[pr], 0, 0, 0);
#pragma unroll
            for (int ks = 0; ks < 4; ++ks) acc[4] = __builtin_amdgcn_mfma_f32_16x16x32_bf16(__builtin_bit_cast(bf16x8_t, wc[8 + ks]), *(const LAS bf16x8_t*)(ap + 32 * (8 + ks)), acc[4], 0, 0, 0);
            const int tt = mt * 16 + r;
            if (tt < P3_ROWS) { bf16* fo = FEAT + (size_t)(row0 + tt) * NFEAT * RW_W + nc0; float o[4];
#pragma unroll
                for (int e = 0; e < 4; ++e) o[e] = 0.6065306597126334f * sigmoidf_(acc[0][e] + w00[e]);
                *(v2u*)(fo + 3 * RW_W) = (v2u){pk2(o[0], o[1]), pk2(o[2], o[3])};
#pragma unroll
                for (int e = 0; e < 4; ++e) o[e] = 0.6065306597126334f * sigmoidf_(acc[1][e] + w01[e]);
                *(v2u*)(fo + 4 * RW_W) = (v2u){pk2(o[0], o[1]), pk2(o[2], o[3])};
#pragma unroll
                for (int e = 0; e < 4; ++e) o[e] = sigmoidf_(acc[2][e] + a00[e]);
                *(v2u*)(fo + 5 * RW_W) = (v2u){pk2(o[0], o[1]), pk2(o[2], o[3])};
#pragma unroll
                for (int e = 0; e < 4; ++e) o[e] = sigmoidf_(acc[3][e] + a01[e]);
                *(v2u*)(fo + 6 * RW_W) = (v2u){pk2(o[0], o[1]), pk2(o[2], o[3])};
                *(v2u*)(fo + 7 * RW_W) = (v2u){pk2(acc[4][0], acc[4][1]), pk2(acc[4][2], acc[4][3])}; }
        }
    }
}
__device__ __forceinline__ void p3_rw_features(Frame& F, int li) {
#pragma unroll 1
    for (int job = F.bid; job < MT / P3_ROWS; job += F.G) p3_job(F, li, job);
    __syncthreads();
}

typedef float f32x16 __attribute__((ext_vector_type(16)));
constexpr int HY_ZS = 72;
__device__ __forceinline__ void hy_job_mfma(Frame& F, int li, int seg, int c, int dry) {
    const int n = seg ? LC : SEQ, nI = n >> 6, lane = F.lane, b = F.wave;
    bf16* U = F.wsp<bf16>(WS_R1);
    LAS unsigned char* L = F.lds;
    const int cstride = 2 * n + 16;
    LAS bf16* frev8 = (LAS bf16*)L;
    constexpr int FREV_BYTES = 8 * (2 * SEQ + 16) * 2;
    constexpr int Z_BYTES = 8 * 32 * HY_ZS * 2;
    LAS bf16* zin = (LAS bf16*)(L + FREV_BYTES); LAS bf16* zout = (LAS bf16*)(L + FREV_BYTES + Z_BYTES);
    LAS bf16* xg = (LAS bf16*)L;
    static_assert(FREV_BYTES + 2 * Z_BYTES <= LDS_CTL_OFF, "hyena LDS map");
    const float* cw = F.in[I_HYCW] + (size_t)li * 3 * HY_IN; const float* cbv = F.in[I_HYCB] + (size_t)li * HY_IN;
    __syncthreads();
#define HY_STAGE_RAW(dst_, col_, tid_) do { const int s_ = (col_) >> 8, c_ = (col_) & 255; _Pragma("unroll 1") for (int v0_ = (tid_); v0_ < 8 * nI * 8; v0_ += 4 * NTHREADS) { v4u rv_[4]; \
        _Pragma("unroll") for (int k_ = 0; k_ < 4; ++k_) { const int vec_ = v0_ + k_ * NTHREADS; rv_[k_] = (v4u){0u, 0u, 0u, 0u}; if (vec_ < 8 * nI * 8) { const int bb_ = vec_ / (nI * 8), I_ = (vec_ >> 3) % nI, p_ = vec_ & 7; \
            rv_[k_] = *(const v4u*)(U + (size_t)((seg ? NL + bb_ * LC : bb_ * SEQ) + 64 * I_ + (c_ >> 2)) * UA_W + UA_HY + s_ * 256 + (c_ & 3) * 64 + 8 * p_); } } \
        _Pragma("unroll") for (int k_ = 0; k_ < 4; ++k_) { const int vec_ = v0_ + k_ * NTHREADS; if (vec_ < 8 * nI * 8) { const int bb_ = vec_ / (nI * 8), I_ = (vec_ >> 3) % nI, p_ = vec_ & 7; *(LAS v4u*)((dst_) + (bb_ * nI + I_) * HY_ZS + 8 * p_) = rv_[k_]; } } } } while (0)
#define HY_CONV(raw_, bb_, t_, col_) (cbv[col_] + cw[col_] * ((t_) > 0 ? bf2f((raw_)[((bb_) * nI + (((t_) - 1) >> 6)) * HY_ZS + (((t_) - 1) & 63)]) : 0.f) \
        + cw[HY_IN + (col_)] * bf2f((raw_)[((bb_) * nI + ((t_) >> 6)) * HY_ZS + ((t_) & 63)]) + cw[2 * HY_IN + (col_)] * ((t_) < n - 1 ? bf2f((raw_)[((bb_) * nI + (((t_) + 1) >> 6)) * HY_ZS + (((t_) + 1) & 63)]) : 0.f))
    HY_STAGE_RAW(zout, c, F.tid);
    __syncthreads();
#pragma unroll 1
    for (int idx = F.tid; idx < 8 * n; idx += NTHREADS) { const int bb = idx / n, t = idx - bb * n;
        zin[(bb * nI + (t >> 6)) * HY_ZS + (t & 63)] = (bf16)f2bf(HY_CONV(zout, bb, t, c)); }
#pragma unroll 1
    for (int o = 0; o < 2; ++o) {
        const bf16* fsrc = seg ? F.wsp<bf16>(WS_FILTC) + (size_t)(o * 256 + c) * 512 : F.wsp<bf16>(WS_FILT) + (size_t)((li * 2 + o) * 256 + c) * 4096;
        __syncthreads();
        int tid_o = F.tid; asm volatile("" : "+v"(tid_o));
#pragma unroll 1
        for (int m = tid_o; m < 2 * n / 8; m += NTHREADS) { float x[8];
#pragma unroll
            for (int e = 0; e < 8; ++e) { const int y = 8 * m + e; x[e] = y == 0 ? 0.f : bf2f(fsrc[2 * n - y]); }
            *(LAS v4u*)(frev8 + 8 * m) = pack8(x); }
        __syncthreads();
        if (b >= 1) { const int rho = b, q = rho >> 1; const bool odd = rho & 1; LAS bf16* dst = frev8 + rho * cstride;
#pragma unroll 1
            for (int m = (tid_o & 63); m < 2 * n / 8; m += 64) { const v4u lo = *(const LAS v4u*)(frev8 + 8 * m); v4u hi = {0u, 0u, 0u, 0u}; if (m + 1 < 2 * n / 8) hi = *(const LAS v4u*)(frev8 + 8 * m + 8);
                unsigned a0, a1, a2, a3, a4;
                if (q == 0) { a0 = lo.x; a1 = lo.y; a2 = lo.z; a3 = lo.w; a4 = hi.x; } else if (q == 1) { a0 = lo.y; a1 = lo.z; a2 = lo.w; a3 = hi.x; a4 = hi.y; }
                else if (q == 2) { a0 = lo.z; a1 = lo.w; a2 = hi.x; a3 = hi.y; a4 = hi.z; } else { a0 = lo.w; a1 = hi.x; a2 = hi.y; a3 = hi.z; a4 = hi.w; }
                v4u ov; if (odd) { ov.x = (a0 >> 16) | (a1 << 16); ov.y = (a1 >> 16) | (a2 << 16); ov.z = (a2 >> 16) | (a3 << 16); ov.w = (a3 >> 16) | (a4 << 16); } else { ov.x = a0; ov.y = a1; ov.z = a2; ov.w = a3; }
                *(LAS v4u*)(dst + 8 * m) = ov; } }
        __syncthreads();
        f32x16 acc0, acc1;
#pragma unroll
        for (int r = 0; r < 16; ++r) { acc0[r] = 0.f; acc1[r] = 0.f; }
        { const int I = tid_o & 31, hh = (tid_o >> 5) & 1;
#pragma unroll 1
          for (int Dd = -(nI - 1); Dd <= nI - 1; ++Dd) { const int J = I - Dd; const bool valid = (I < nI) && (J >= 0) && (J < nI);
              const LAS bf16* zrow = zin + (b * nI + (valid ? J : 0)) * HY_ZS + 8 * hh;
              const int ybase = n - 64 * Dd - I + 8 * hh;
#pragma unroll
              for (int ks = 0; ks < 4; ++ks) {
                  v4u bw = *(const LAS v4u*)(zrow + 16 * ks); if (!valid) bw = (v4u){0u, 0u, 0u, 0u};
                  const int y0 = ybase + 16 * ks, y1 = y0 - 32;
                  const v4u aw0 = *(const LAS v4u*)(frev8 + (y0 & 7) * cstride + (y0 & ~7)); const v4u aw1 = *(const LAS v4u*)(frev8 + (y1 & 7) * cstride + (y1 & ~7));
                  acc0 = __builtin_amdgcn_mfma_f32_32x32x16_bf16(__builtin_bit_cast(bf16x8_t, aw0), __builtin_bit_cast(bf16x8_t, bw), acc0, 0, 0, 0);
                  acc1 = __builtin_amdgcn_mfma_f32_32x32x16_bf16(__builtin_bit_cast(bf16x8_t, aw1), __builtin_bit_cast(bf16x8_t, bw), acc1, 0, 0, 0);
              } } }
        __syncthreads();
        const int xcol = (o + 1) * HY_W + c;
        HY_STAGE_RAW(xg, xcol, tid_o);
        __syncthreads();
        { const int I = tid_o & 31, hh = (tid_o >> 5) & 1; const float skip = F.in[I_HYSKIP][(li * 2 + o) * HY_W + c]; const int rowbase = seg ? NL + b * LC : b * SEQ;
          if (I < nI) {
#pragma unroll
              for (int ti = 0; ti < 2; ++ti)
#pragma unroll
                  for (int r = 0; r < 16; ++r) { const int i = 32 * ti + (r & 3) + 8 * (r >> 2) + 4 * hh; const int idx = (b * nI + I) * HY_ZS + i;
                      const float a = ti == 0 ? acc0[r] : acc1[r]; const int tq = 64 * I + i; const float zn = HY_CONV(xg, b, tq, xcol) * (a + skip * bf2f(zin[idx]));
                      if (o == 0) zout[idx] = (bf16)f2bf(zn); else { if (dry) U[(size_t)(rowbase + 64 * I + i) * UA_W + 3456 + (c & 127)] = (bf16)f2bf(zn); else F.wsp<bf16>(WS_RB + RB_YHY)[(size_t)(rowbase + 64 * I + i) * HY_W + c] = (bf16)f2bf(zn); } } } }
        LAS bf16* tmp = zin; zin = zout; zout = tmp;
    }
    __syncthreads();
#undef HY_STAGE_RAW
#undef HY_CONV
}


constexpr int NA_KS = 72;
constexpr int NA_BUF = 2 * 64 * NA_KS * 2 + 256;
template <int kind>
__device__ __forceinline__ void na_job(Frame& F, int li, int b, int h, int gi, int dry) {
    const int lane = F.lane, r = lane & 15, g = lane >> 4, w = F.wave, qg = w & 3, kh = w >> 2;
    bf16* U = F.wsp<bf16>(WS_R1);
    LAS unsigned char* L = F.lds;
    LAS float* rpbs = (LAS float*)(L + 2 * NA_BUF);
    LAS float* comb = (LAS float*)(L + 2 * NA_BUF + 2048);
    const int r0 = min(max(gi - 4, 0), 24);
    const int qrow0 = (kind == 0 ? b * SEQ + gi * 64 : NL + b * LC + gi * 64) + qg * 16;
    const int nloc = kind == 0 ? 8 : 0, nsteps = nloc + 4;
    __syncthreads();
    { const float* rp = F.in[I_NARPB] + (size_t)(li * 6 + h) * 465; if (F.tid < 465) rpbs[F.tid] = rp[F.tid]; }
    bf16x8_t aq[2];
    { const bf16* qp = U + (size_t)(qrow0 + r) * UA_W + UA_NA + h * 64 + 8 * g; float x0[8], x1[8]; unpack8(*(const v4u*)qp, x0); unpack8(*(const v4u*)(qp + 32), x1);
      float ss = 0.f;
#pragma unroll
      for (int e = 0; e < 8; ++e) ss += x0[e] * x0[e] + x1[e] * x1[e];
      ss += __shfl_xor(ss, 16); ss += __shfl_xor(ss, 32);
      const float rq = 0.125f / sqrtf(ss * (1.f / 64.f) + NORM_EPS);
      const float* qg_ = F.in[I_NAQG] + li * 64 + 8 * g; const float* kg_ = F.in[I_NAKG] + li * 64 + 8 * g;
#pragma unroll
      for (int e = 0; e < 8; ++e) { x0[e] *= rq * qg_[e] * kg_[e]; x1[e] *= rq * qg_[32 + e] * kg_[32 + e]; }
      aq[0] = __builtin_bit_cast(bf16x8_t, pack8(x0)); aq[1] = __builtin_bit_cast(bf16x8_t, pack8(x1)); }
    const int qj = qg * 16 + r, c0q = min(max(qj - 8, 0), 48);
    const int wlo = min(max(qg * 16 - 8, 0), 48), whi = min(max(qg * 16 + 15 - 8, 0), 48) + 15;
    const bool half_live = !(32 * kh > whi || 32 * kh + 31 < wlo);
    float lsum = 0.f;
    f32x4 O[4];
#pragma unroll
    for (int dt = 0; dt < 4; ++dt) O[dt] = (f32x4){0.f, 0.f, 0.f, 0.f};
    const int sx = F.tid >> 3, sp = F.tid & 7;
    const int cvs = h * 64 + sx, q6s = (cvs * 10923) >> 16, vsoff = q6s * UA_W + 3072 + (cvs - 6 * q6s) * 64 + 8 * sp;
#define NA_KROW0(s_) (((s_) < nloc) ? (b * SEQ + (r0 + (s_)) * 64) : (NL + b * LC + 64 * ((s_) - nloc)))
    v4u kst, vst;
#define NA_GLOAD(s_) do { const int kb_ = NA_KROW0(s_); kst = *(const v4u*)(U + (size_t)(kb_ + sx) * UA_W + UA_NA + NA_W + h * 64 + 8 * sp); vst = *(const v4u*)(U + (size_t)kb_ * UA_W + vsoff); } while (0)
#define NA_LSTORE(buf_) do { LAS unsigned char* B_ = L + (buf_) * NA_BUF; float y_[8]; unpack8(kst, y_); float ss_ = 0.f; \
        _Pragma("unroll") for (int e = 0; e < 8; ++e) ss_ += y_[e] * y_[e]; \
        ss_ += __shfl_xor(ss_, 1); ss_ += __shfl_xor(ss_, 2); ss_ += __shfl_xor(ss_, 4); \
        *(LAS v4u*)((LAS bf16*)B_ + sx * NA_KS + 8 * sp) = kst; *(LAS v4u*)((LAS bf16*)(B_ + 64 * NA_KS * 2) + sx * NA_KS + 8 * sp) = vst; \
        if (sp == 0) ((LAS float*)(B_ + 2 * 64 * NA_KS * 2))[sx] = 1.0f / sqrtf(ss_ * (1.f / 64.f) + NORM_EPS); } while (0)
    NA_GLOAD(0); NA_LSTORE(0);
    __syncthreads();
#pragma unroll 1
    for (int s = 0; s < nsteps; ++s) {
        const bool loc = s < nloc;
        { const int s1 = s + 1 < nsteps ? s + 1 : s; NA_GLOAD(s1); }
        if (!loc || half_live) {
            LAS unsigned char* B_ = L + (s & 1) * NA_BUF; const LAS bf16* Ks = (const LAS bf16*)B_; const LAS bf16* Vt = (const LAS bf16*)(B_ + 64 * NA_KS * 2); const LAS float* rks = (const LAS float*)(B_ + 2 * 64 * NA_KS * 2);
            float p[8];
#pragma unroll
            for (int kt = 0; kt < 2; ++kt) { const int key0 = 32 * kh + 16 * kt;
                const bf16x8_t k0 = *(const LAS bf16x8_t*)(Ks + (key0 + r) * NA_KS + 8 * g), k1 = *(const LAS bf16x8_t*)(Ks + (key0 + r) * NA_KS + 32 + 8 * g);
                const f32x4 rk = *(const LAS f32x4*)(rks + key0 + 4 * g);
                f32x4 acc = {0.f, 0.f, 0.f, 0.f};
                acc = __builtin_amdgcn_mfma_f32_16x16x32_bf16(k0, aq[0], acc, 0, 0, 0);
                acc = __builtin_amdgcn_mfma_f32_16x16x32_bf16(k1, aq[1], acc, 0, 0, 0);
#pragma unroll
                for (int e = 0; e < 4; ++e) { float v = acc[e] * rk[e]; bool ok = true;
                    if (loc) { const int kcol = key0 + 4 * g + e; ok = kcol >= c0q && kcol < c0q + 16; const int dr = r0 + s - gi + 7, dc = min(max(kcol - qj + 15, 0), 30); v += rpbs[dr * 31 + dc]; }
                    const float pe = ok ? __expf(v) : 0.f; lsum += pe; p[4 * kt + e] = pe; } }
            const v4u pw = {pg8::cvt_pk_bf16(p[0], p[1]), pg8::cvt_pk_bf16(p[2], p[3]), pg8::cvt_pk_bf16(p[4], p[5]), pg8::cvt_pk_bf16(p[6], p[7])}; const bf16x8_t pb = __builtin_bit_cast(bf16x8_t, pw);
#pragma unroll
            for (int dt = 0; dt < 4; ++dt) { const v2u va = *(const LAS v2u*)(Vt + (16 * dt + r) * NA_KS + 32 * kh + 4 * g), vb = *(const LAS v2u*)(Vt + (16 * dt + r) * NA_KS + 32 * kh + 16 + 4 * g);
                const v4u vw = {va.x, va.y, vb.x, vb.y};
                O[dt] = __builtin_amdgcn_mfma_f32_16x16x32_bf16(__builtin_bit_cast(bf16x8_t, vw), pb, O[dt], 0, 0, 0); }
        }
        NA_LSTORE((s + 1) & 1);
        __syncthreads();
    }
#undef NA_KROW0
#undef NA_GLOAD
#undef NA_LSTORE
    if (kh == 1) { LAS float* cp = comb + (qg * 64 + lane) * 17;
#pragma unroll
        for (int dt = 0; dt < 4; ++dt)
#pragma unroll
            for (int e = 0; e < 4; ++e) cp[4 * dt + e] = O[dt][e];
        cp[16] = lsum; }
    __syncthreads();
    if (kh == 0) { const LAS float* cp = comb + (qg * 64 + lane) * 17;
#pragma unroll
        for (int dt = 0; dt < 4; ++dt)
#pragma unroll
            for (int e = 0; e < 4; ++e) O[dt][e] += cp[4 * dt + e];
        lsum += cp[16];
        lsum += __shfl_xor(lsum, 16); lsum += __shfl_xor(lsum, 32);
        const float inv = 1.0f / lsum;
        bf16* op = U + (size_t)(qrow0 + r) * UA_W + (dry ? 3456 + (h & 1) * 64 : UA_NA + h * 64) + 4 * g;
#pragma unroll
        for (int dt = 0; dt < 4; ++dt) *(v2u*)(op + 16 * dt) = (v2u){pk2(O[dt][0] * inv, O[dt][1] * inv), pk2(O[dt][2] * inv, O[dt][3] * inv)}; }
}

constexpr int CW_HYQ = 9216;
__device__ __forceinline__ void p4_hy_na(Frame& F, int li, int dry) {
    unsigned* qh = (unsigned*)(F.ws + WS_CTL) + CW_HYQ + li + 4 * dry;
    volatile LAS unsigned* slot = (volatile LAS unsigned*)(F.lds + LDS_CTL_OFF) + 16;
    const int nhl = (dry && (PROBE_SUB == 2 || PROBE_SUB == 3)) ? 0 : 256, nhc = (dry && (PROBE_SUB == 2 || PROBE_SUB == 3)) ? 0 : (li == 0 ? 256 : 0);
    const int nnl = (dry && (PROBE_SUB == 1 || PROBE_SUB == 3)) ? 0 : 1536, nnc = (dry && (PROBE_SUB == 1 || PROBE_SUB == 3)) ? 0 : (li == 0 ? 192 : 0);
#pragma unroll 1
    for (;;) {
        __syncthreads();
        if (F.tid == 0) *slot = __hip_atomic_fetch_add(qh, 1u, __ATOMIC_RELAXED, __HIP_MEMORY_SCOPE_AGENT);
        __syncthreads();
        int job = (int)*slot;
        if (job >= nhl + nnl + nhc + nnc) break;
        if (job < nhl) { hy_job_mfma(F, li, 0, job, dry); continue; } job -= nhl;
        if (job < nnl) { const int bb = job / 192, q = job % 192; na_job<0>(F, li, bb, q >> 5, q & 31, dry); continue; } job -= nnl;
        if (job < nhc) { hy_job_mfma(F, li, 1, job, dry); continue; } job -= nhc;
        { const int bb = job / 24, q = job % 24; na_job<1>(F, li, bb, q >> 2, q & 3, dry); }
    }
    __syncthreads();
}

constexpr int PPL = 14;
constexpr int N_PHASES = 1 + PPL * NLAYER + 1;
#define IN(k) (lo <= (k) && (k) < hi)
#define SEAM(k) do { if (IN(k) && IN((k) + 1)) xcd_barrier(bar); } while (0)
template <int li> __device__ __forceinline__ void layer_body(Frame& F, const int lo, const int hi, const XcdBarrier& bar) {
    LAS unsigned char* L = F.lds;
    constexpr int pb = 1 + PPL * li;
    constexpr bool last = li == NLAYER - 1;
    constexpr int Mrows = last ? NL : MT;
    bf16* const RA = F.wsp<bf16>(WS_RA); bf16* const UA = F.wsp<bf16>(WS_R1); bf16* const GT = F.wsp<bf16>(WS_R1 + R1_G);
    const bf16* const WIN = F.wsp<bf16>(WS_WIN + li * SZ_WIN1);
    if (IN(pb + 0)) { for (int rep_ = 0; rep_ < (PROBE_ID == (pb + 0) ? PROBE_REPS : 1); ++rep_) { const int dry = rep_ > 0; (void)dry; F.fresh(); if (rep_) { VM_WAIT(); __syncthreads(); } p1_norm1(F, li); } } SEAM(pb + 0);
    if (IN(pb + 1)) { for (int rep_ = 0; rep_ < (PROBE_ID == (pb + 1) ? PROBE_REPS : 1); ++rep_) { const int dry = rep_ > 0; (void)dry; F.fresh(); if (rep_) { VM_WAIT(); __syncthreads(); }
        pg8::Gemm g{RA, WIN, MT, UA_W, D, D}; pg8::StaticOrder S; S.init(MT, UA_W, F.G, F.bid);
        EpiBf16S<0> E{UA, UA_W};
        GEMM_CALL(EpiBf16S<0>, pg8::StaticOrder, L, g, S, E);
    } } SEAM(pb + 1);
    if (IN(pb + 2)) { for (int rep_ = 0; rep_ < (PROBE_ID == (pb + 2) ? PROBE_REPS : 1); ++rep_) { const int dry = rep_ > 0; (void)dry; F.fresh(); if (rep_) { VM_WAIT(); __syncthreads(); } p3_rw_features(F, li); } } SEAM(pb + 2);
    if (IN(pb + 3)) { for (int rep_ = 0; rep_ < (PROBE_ID == (pb + 3) ? PROBE_REPS : 1); ++rep_) { const int dry = rep_ > 0; (void)dry; F.fresh(); if (rep_) { VM_WAIT(); __syncthreads(); }
#pragma unroll 1
        for (int job = F.bid; job < NCHAIN * NCHUNK; job += F.G) rw_phaseA_job(F, li, job / NCHUNK, job % NCHUNK);
    } } SEAM(pb + 3);
    if (IN(pb + 4)) { for (int rep_ = 0; rep_ < (PROBE_ID == (pb + 4) ? PROBE_REPS : 1); ++rep_) { const int dry = rep_ > 0; (void)dry; F.fresh(); if (rep_) { VM_WAIT(); __syncthreads(); }
        if (F.bid < NCHAIN && !(dry && (PROBE_SUB == 1 || PROBE_SUB == 2))) rw_phaseB_chain(F, F.bid, dry);
        p4_hy_na(F, li, dry);
    } } SEAM(pb + 4);
    if (IN(pb + 5)) { for (int rep_ = 0; rep_ < (PROBE_ID == (pb + 5) ? PROBE_REPS : 1); ++rep_) { const int dry = rep_ > 0; (void)dry; F.fresh(); if (rep_) { VM_WAIT(); __syncthreads(); }
#pragma unroll 1
        for (int job = F.bid; job < NCHAIN * NCHUNK; job += F.G) rw_phaseC_job(F, li, job / NCHUNK, job % NCHUNK, dry);
    } } SEAM(pb + 5);
    if (IN(pb + 6)) { for (int rep_ = 0; rep_ < (PROBE_ID == (pb + 6) ? PROBE_REPS : 1); ++rep_) { const int dry = rep_ > 0; (void)dry; F.fresh(); if (rep_) { VM_WAIT(); __syncthreads(); } p5_rw_readout(F, li); } } SEAM(pb + 6);
    if (IN(pb + 7)) { for (int rep_ = 0; rep_ < (PROBE_ID == (pb + 7) ? PROBE_REPS : 1); ++rep_) { const int dry = rep_ > 0; (void)dry; F.fresh(); if (rep_) { VM_WAIT(); __syncthreads(); }
        pg8::Gemm g{RA, WIN + (size_t)UA_W * D, Mrows, GATE_IN, D, D}; pg8::StaticOrder S; S.init(Mrows, GATE_IN, F.G, F.bid);
        EpiBf16S<1> E{GT, GATE_IN};
        GEMM_CALL(EpiBf16S<1>, pg8::StaticOrder, L, g, S, E);
    } } SEAM(pb + 7);
    if (IN(pb + 8)) { for (int rep_ = 0; rep_ < (PROBE_ID == (pb + 8) ? PROBE_REPS : 1); ++rep_) { const int dry = rep_ > 0; (void)dry; F.fresh(); if (rep_) { VM_WAIT(); __syncthreads(); }
        const bf16* WBR = F.wsp<bf16>(WS_WBR + li * SZ_WBR1);
        { pg8::Gemm g{UA, WBR, Mrows, D, RW_W, UA_W}; pg8::StaticOrder S; S.init(Mrows, D, F.G, F.bid); EpiMerge<0> E{GT, GATE_IN, RA};
          GEMM_CALL(EpiMerge<0>, pg8::StaticOrder, L, g, S, E); }
        VM_WAIT(); __syncthreads();
        { pg8::Gemm g{F.wsp<bf16>(WS_RB + RB_YHY), WBR + (size_t)D * RW_W, Mrows, D, HY_W, HY_W}; pg8::StaticOrder S; S.init(Mrows, D, F.G, F.bid); EpiMerge<1> E{GT + D, GATE_IN, RA};
          GEMM_CALL(EpiMerge<1>, pg8::StaticOrder, L, g, S, E); }
        VM_WAIT(); __syncthreads();
        { pg8::Gemm g{UA + UA_NA, WBR + (size_t)D * (RW_W + HY_W), Mrows, D, NA_W, UA_W}; pg8::StaticOrder S; S.init(Mrows, D, F.G, F.bid); EpiMerge<1> E{GT + 2 * D, GATE_IN, RA};
          GEMM_CALL(EpiMerge<1>, pg8::StaticOrder, L, g, S, E); }
    } } SEAM(pb + 8);
    if (IN(pb + 9)) { for (int rep_ = 0; rep_ < (PROBE_ID == (pb + 9) ? PROBE_REPS : 1); ++rep_) { const int dry = rep_ > 0; (void)dry; F.fresh(); if (rep_) { VM_WAIT(); __syncthreads(); }
        pg8::Gemm g{RA, F.wsp<bf16>(WS_WOUT + li * SZ_WOUT1), Mrows, D, D, D}; pg8::StaticOrder S; S.init(Mrows, D, F.G, F.bid);
        EpiRes E{li == 0 ? F.in[I_X] : F.out, F.out, li == 0 ? F.in[I_CTX] : F.wsp<float>(WS_CTXRES), F.wsp<float>(WS_CTXRES), F.mods(li, 0), 2 * D, (dry && li > 0) ? 0.f : 1.f};
        GEMM_CALL(EpiRes, pg8::StaticOrder, L, g, S, E);
    } } SEAM(pb + 9);
    if (IN(pb + 10)) { for (int rep_ = 0; rep_ < (PROBE_ID == (pb + 10) ? PROBE_REPS : 1); ++rep_) { const int dry = rep_ > 0; (void)dry; F.fresh(); if (rep_) { VM_WAIT(); __syncthreads(); } p8_norm2(F, li, dry); if (last) { __syncthreads(); moe_weight_transposes(F); } } } SEAM(pb + 10);
    if (!last) {
        if (IN(pb + 11) && IN(pb + 12)) {}
        if (IN(pb + 12)) { for (int rep_ = 0; rep_ < (PROBE_ID == (pb + 12) ? PROBE_REPS : 1); ++rep_) { const int dry = rep_ > 0; (void)dry; F.fresh(); if (rep_) { VM_WAIT(); __syncthreads(); }
            pg8::Gemm g{RA, F.wsp<bf16>(WS_WFF13), MT, 2 * FF, D, D}; pg8::StaticOrder S; S.init(MT, 2 * FF, F.G, F.bid);
            EpiSwiGLU E{F.wsp<bf16>(WS_R1), FF, 2 * FF / 256};
            GEMM_CALL(EpiSwiGLU, pg8::StaticOrder, L, g, S, E);
        } } SEAM(pb + 12);
        if (IN(pb + 13)) { for (int rep_ = 0; rep_ < (PROBE_ID == (pb + 13) ? PROBE_REPS : 1); ++rep_) { const int dry = rep_ > 0; (void)dry; F.fresh(); if (rep_) { VM_WAIT(); __syncthreads(); }
            pg8::Gemm g{F.wsp<bf16>(WS_R1), F.wsp<bf16>(WS_WFF2), MT, D, FF, FF}; pg8::StaticOrder S; S.init(MT, D, F.G, F.bid);
            EpiRes E{F.out, F.out, F.wsp<float>(WS_CTXRES), F.wsp<float>(WS_CTXRES), F.mods(li, 0), 5 * D, dry ? 0.f : 1.f};
            GEMM_CALL(EpiRes, pg8::StaticOrder, L, g, S, E);
        } } SEAM(pb + 13);
    } else {
        if (IN(pb + 11)) { for (int rep_ = 0; rep_ < (PROBE_ID == (pb + 11) ? PROBE_REPS : 1); ++rep_) { const int dry = rep_ > 0; (void)dry; F.fresh(); if (rep_) { VM_WAIT(); __syncthreads(); } p8b_gather(F); } } SEAM(pb + 11);
        const unsigned* cnt = (const unsigned*)(F.ws + WS_CTL) + CW_MOECNT;
        if (IN(pb + 12)) { for (int rep_ = 0; rep_ < (PROBE_ID == (pb + 12) ? PROBE_REPS : 1); ++rep_) { const int dry = rep_ > 0; (void)dry; F.fresh(); if (rep_) { VM_WAIT(); __syncthreads(); }
            pg8::Gemm g{RA, F.wsp<bf16>(WS_WM13), MOE_ROWS, 2 * FFE, D, D}; pg8::MoeOrder S; S.init(cnt, 2 * FFE / 256, F.G, F.bid);
            EpiSwiGLU E{F.wsp<bf16>(WS_R1), FFE, 2 * FFE / 256};
            GEMM_CALL(EpiSwiGLU, pg8::MoeOrder, L, g, S, E);
        } } SEAM(pb + 12);
        if (IN(pb + 13)) { for (int rep_ = 0; rep_ < (PROBE_ID == (pb + 13) ? PROBE_REPS : 1); ++rep_) { const int dry = rep_ > 0; (void)dry; F.fresh(); if (rep_) { VM_WAIT(); __syncthreads(); }
            pg8::Gemm g{F.wsp<bf16>(WS_R1), F.wsp<bf16>(WS_WM2), MOE_ROWS, D, FFE, FFE}; pg8::MoeOrder S; S.init(cnt, D / 256, F.G, F.bid);
            EpiMoeY E{RA};
            GEMM_CALL(EpiMoeY, pg8::MoeOrder, L, g, S, E);
        } } SEAM(pb + 13);
        if (IN(pb + 14)) { for (int rep_ = 0; rep_ < (PROBE_ID == (pb + 14) ? PROBE_REPS : 1); ++rep_) { const int dry = rep_ > 0; (void)dry; F.fresh(); if (rep_) { VM_WAIT(); __syncthreads(); } p11_moe_combine(F, li, dry); } }
    }
}
#undef IN
#undef SEAM
__global__ void __launch_bounds__(NTHREADS, 2) fwd_kernel(Args args) {
    extern __shared__ __attribute__((aligned(16))) unsigned char lds_raw[];
    Frame F;
    F.lds = (LAS unsigned char*)lds_raw;
    F.tid = threadIdx.x; F.lane = F.tid & 63; F.wave = __builtin_amdgcn_readfirstlane(F.tid >> 6);
    F.G = gridDim.x; F.bid = blockIdx.x;
    F.in = (const CAS cfp*)__builtin_amdgcn_kernarg_segment_ptr(); F.out = args.out; F.ws = args.ws;
    volatile LAS unsigned* MISC = (volatile LAS unsigned*)(F.lds + LDS_CTL_OFF);
    if (F.tid < 64) MISC[F.tid] = 0u;
    __syncthreads();
    const int lo = args.ph_lo, hi = args.ph_hi;
    XcdBarrier bar; bar.bar = (unsigned*)(F.ws + WS_CTL) + CW_BAR; bar.x = 0; bar.st = nullptr;
    if (hi - lo > 1) bar = xcd_barrier_post((unsigned*)(F.ws + WS_CTL) + CW_BAR, MISC + 8);
    if (lo <= 0 && 0 < hi) { for (int rep_ = 0; rep_ < (PROBE_ID == 0 ? PROBE_REPS : 1); ++rep_) { F.fresh(); if (rep_) { VM_WAIT(); __syncthreads(); } p0_prologue(F); } }
    if (lo <= 0 && 1 < hi) xcd_barrier(bar);
    layer_body<0>(F, lo, hi, bar);
    layer_body<1>(F, lo, hi, bar);
}

extern "C" void kernel_launch(void* const* d_in, const int* in_sizes, int n_in, void* d_out, int out_size, void* d_ws, size_t ws_size, hipStream_t stream) {
    static int grid = 0;
    if (grid == 0) {
        if (n_in != N_IN || out_size != NL * D || ws_size < WS_END) { fprintf(stderr, "kernel_launch: shape/workspace mismatch (n_in %d, out %d, ws %zu, need %zu); nothing launched\n", n_in, out_size, ws_size, (size_t)WS_END); grid = -1; return; }
        int dev = 0, cus = 0, per_cu = 0;
        if (hipGetDevice(&dev) != hipSuccess || hipDeviceGetAttribute(&cus, hipDeviceAttributeMultiprocessorCount, dev) != hipSuccess) { grid = -1; return; }
        if (hipFuncSetAttribute((const void*)fwd_kernel, hipFuncAttributeMaxDynamicSharedMemorySize, LDS_BYTES) != hipSuccess) { fprintf(stderr, "kernel_launch: hipFuncSetAttribute failed\n"); grid = -1; return; }
        if (hipOccupancyMaxActiveBlocksPerMultiprocessor(&per_cu, (const void*)fwd_kernel, NTHREADS, LDS_BYTES) != hipSuccess || per_cu < 1) fprintf(stderr, "kernel_launch: occupancy query says %d\n", per_cu);
        (void)hipGetLastError();
        grid = cus;
    }
    if (grid < 0) return;
    if (hipMemsetAsync((char*)d_ws + WS_CTL, 0, CTL_ZERO_BYTES, stream) != hipSuccess) return;
    Args a{};
    for (int i = 0; i < N_IN; ++i) a.in[i] = (const float*)d_in[i];
    a.out = (float*)d_out; a.ws = (unsigned char*)d_ws;
#if MK_ONE_LAUNCH
    a.ph_lo = 0; a.ph_hi = N_PHASES;
    hipLaunchKernelGGL(fwd_kernel, dim3(grid), dim3(NTHREADS), LDS_BYTES, stream, a);
#else
    for (int p = 0; p < N_PHASES; ++p) {
        if (p == 1 + 11) continue;
        a.ph_lo = p; a.ph_hi = p + 1;
        hipLaunchKernelGGL(fwd_kernel, dim3(grid), dim3(NTHREADS), LDS_BYTES, stream, a);
    }
#endif
}
```

```cpp
#include <hip/hip_runtime.h>
#include <cstdio>
#include <cstdint>

#ifndef MK_ONE_LAUNCH
#define MK_ONE_LAUNCH 1
#endif
#ifndef PROBE_ID
#define PROBE_ID (-1)
#endif
#ifndef PROBE_REPS
#define PROBE_REPS 2
#endif
#ifndef PROBE_SUB
#define PROBE_SUB 0
#endif
#ifndef USE_NAIVE_GEMM
#define USE_NAIVE_GEMM 0
#endif

namespace pg8 {
#define PG8_LAS __attribute__((address_space(3)))
typedef unsigned short bf16_t;
typedef short bf16x8 __attribute__((ext_vector_type(8)));
typedef float f32x4 __attribute__((ext_vector_type(4)));
typedef unsigned u32x4 __attribute__((ext_vector_type(4)));
constexpr int BM = 256, BK = 64, HALF = 128, HTB = HALF * BK * 2  , STAGE_BYTES = 8 * HTB, NXCD = 8, WGM = 8;

__host__ __device__ __forceinline__ int lds_byte(int r, int c) { const int st = (r >> 4) * 2 + (c >> 5), rr = r & 15, cc = c & 31, ob = rr * 64 + cc * 2; return st * 1024 + (ob ^ (((ob >> 9) & 1) << 5)); }
__host__ __device__ __forceinline__ void stage_rc(int b, int& R, int& C) { const int st = b / 1024, sb = b % 1024, swz = sb ^ (((sb >> 9) & 1) << 5); R = (st >> 1) * 16 + swz / 64; C = (st & 1) * 32 + (swz % 64) / 2; }
__host__ __device__ __forceinline__ int perm32(int rho) { const int n = rho >> 4, i = rho & 15; return 8 * (i >> 2) + 4 * n + (i & 3); }

struct Unit { int pm, pn; };
struct Gemm { const bf16_t* A; const bf16_t* Bt; int M, N, K, lda; };

struct StaticOrder {
    int nM, nN, nwg, G, c;
    __host__ __device__ void init(int M, int N, int G_, int c_) { nM = M / BM; nN = N / BM; nwg = nM * nN; G = G_; c = c_; }
    __host__ __device__ bool next(int i, Unit& u) const {
        const long L = (long)i * G + c; if (L >= nwg) return false;
        int wgid = (int)L; { const int q = nwg / NXCD, r = nwg % NXCD, xcd = wgid % NXCD, off = wgid / NXCD; wgid = (xcd < r ? xcd * (q + 1) : r * (q + 1) + (xcd - r) * q) + off; }
        const int nig = WGM * nN, gid = wgid / nig, fm = gid * WGM, gsz = (nM - fm) < WGM ? (nM - fm) : WGM;
        u.pm = fm + ((wgid % nig) % gsz); u.pn = (wgid % nig) / gsz; return true;
    }
    __device__ __forceinline__ void a_ready(const Unit&) const {}
    __device__ __forceinline__ void done(const Unit&) const {}
};
struct MoeOrder {
    int nM, nN, nwg, G, c; int toff[9];
    __device__ void init(const unsigned* cnt, int nN_, int G_, int c_) {
        int t = 0;
#pragma unroll
        for (int e = 0; e < 8; ++e) { toff[e] = t; t += (int)((__builtin_amdgcn_readfirstlane(cnt[64 * e]) + 255u) >> 8); }
        toff[8] = t; nM = t; nN = nN_; nwg = nM * nN; G = G_; c = c_;
    }
    __device__ bool next(int i, Unit& u) const {
        const long L = (long)i * G + c; if (L >= nwg) return false;
        int wgid = (int)L; { const int q = nwg / NXCD, r = nwg % NXCD, xcd = wgid % NXCD, off = wgid / NXCD; wgid = (xcd < r ? xcd * (q + 1) : r * (q + 1) + (xcd - r) * q) + off; }
        const int nig = WGM * nN, gid = wgid / nig, fm = gid * WGM, gsz = (nM - fm) < WGM ? (nM - fm) : WGM;
        const int pm = fm + ((wgid % nig) % gsz), pn = (wgid % nig) / gsz;
        int e = 0;
#pragma unroll
        for (int k = 1; k < 8; ++k) e += (pm >= toff[k]) ? 1 : 0;
        u.pm = pm; u.pn = e * nN + pn; return true;
    }
    __device__ __forceinline__ void a_ready(const Unit&) const {}
    __device__ __forceinline__ void done(const Unit&) const {}
};

__device__ __forceinline__ unsigned cvt_pk_bf16(float lo, float hi) { unsigned r; asm volatile("v_cvt_pk_bf16_f32 %0, %1, %2" : "=v"(r) : "v"(lo), "v"(hi)); return r; }

typedef int i32x4_t __attribute__((ext_vector_type(4)));
typedef int i32x8_t __attribute__((ext_vector_type(8)));
template <class Epi, class Sched, bool ALIGN_EPI = false, bool SP2 = false, bool F8 = false>
__device__ __forceinline__ void gemm_phase(PG8_LAS unsigned char* lds, const Gemm g, const Sched& S, const Epi& E) {
    int tid_ = threadIdx.x; asm volatile("" : "+v"(tid_));
    const int tid = tid_, wid = __builtin_amdgcn_readfirstlane(tid >> 6), lane = tid & 63, wr = wid >> 2, wc = wid & 3, fr = lane & 15, fq = lane >> 4;
    constexpr int ES = F8 ? 1 : 2;
    const int K = g.K, nt = K * ES / (BK * 2), LDA = g.lda;
    unsigned voffA[2], voffB[2];
#pragma unroll
    for (int i = 0; i < 2; ++i) { int R, C; stage_rc(tid * 16 + i * 8192, R, C); const int Rb = Epi::PERM ? ((R & ~31) + perm32(R & 31)) : R;
        voffA[i] = (unsigned)(R * LDA * ES + C * 2); voffB[i] = (unsigned)(Rb * K * ES + C * 2); }
    const size_t kstep = (size_t)(BK * 2);
    const size_t hstepA = (size_t)HALF * LDA * ES, hstepB = (size_t)HALF * K * ES;
    const size_t tstepA = 2 * hstepA, tstepB = 2 * hstepB;
    const unsigned ldsw = (unsigned)wid * 1024u;
    const int aoff = lds_byte(wr * 64 + fr, fq * 8), boff = lds_byte(wc * 32 + fr, fq * 8);
#define PG8_SA(b, h) (((b) * 2 + (h)) * HTB)
#define PG8_SB(b, h) ((4 + (b) * 2 + (h)) * HTB)
#define PG8_STAGE(bufoff, gbase, voff) do { _Pragma("unroll") for (int _i = 0; _i < 2; ++_i) \
        __builtin_amdgcn_global_load_lds((const unsigned*)((const char*)(gbase) + (voff)[_i]), (PG8_LAS unsigned*)(lds + (bufoff) + ldsw + _i * 8192), 16, 0, 0); } while (0)
#define PG8_LDA(dst, b, h) do { _Pragma("unroll") for (int m = 0; m < 4; ++m) _Pragma("unroll") for (int k = 0; k < 2; ++k) dst[m][k] = *(const PG8_LAS bf16x8*)(lds + PG8_SA(b, h) + aoff + m * 2048 + k * 1024); } while (0)
#define PG8_LDB(dst, b, h) do { _Pragma("unroll") for (int n = 0; n < 2; ++n) _Pragma("unroll") for (int k = 0; k < 2; ++k) dst[n][k] = *(const PG8_LAS bf16x8*)(lds + PG8_SB(b, h) + boff + n * 2048 + k * 1024); } while (0)
#define PG8_CAT8(x_, y_) __builtin_shufflevector(__builtin_bit_cast(i32x4_t, (x_)), __builtin_bit_cast(i32x4_t, (y_)), 0, 1, 2, 3, 4, 5, 6, 7)
#define PG8_MMA(ai, bj, At, Bt) do { __builtin_amdgcn_s_setprio(1); \
        if constexpr (F8) { _Pragma("unroll") for (int m = 0; m < 4; ++m) _Pragma("unroll") for (int n = 0; n < 2; ++n) \
            { const i32x8_t b8_ = PG8_CAT8(Bt[n][0], Bt[n][1]), a8_ = PG8_CAT8(At[m][0], At[m][1]); \
              asm volatile("v_mfma_f32_16x16x128_f8f6f4 %0, %1, %2, %0" : "+v"(acc[ai][bj][m][n]) : "v"(b8_), "v"(a8_)); } } \
        else { _Pragma("unroll") for (int m = 0; m < 4; ++m) _Pragma("unroll") for (int n = 0; n < 2; ++n) _Pragma("unroll") for (int k = 0; k < 2; ++k) \
            acc[ai][bj][m][n] = __builtin_amdgcn_mfma_f32_16x16x32_bf16(Bt[n][k], At[m][k], acc[ai][bj][m][n], 0, 0, 0); } \
        __builtin_amdgcn_s_setprio(0); } while (0)
#define PG8_WAIT_V(n) asm volatile("s_waitcnt vmcnt(" #n ")" ::: "memory")
#define PG8_WAIT_L(n) asm volatile("s_waitcnt lgkmcnt(" #n ")" ::: "memory")
#define PG8_BAR __builtin_amdgcn_s_barrier()
#define PG8_SCHED __builtin_amdgcn_sched_barrier(0)
    Unit cur, nxt; int ui = 0;
    if (!S.next(0, cur)) return;
    f32x4 acc[2][2][4][2];
#pragma unroll
    for (int a = 0; a < 2; ++a)
#pragma unroll
        for (int b = 0; b < 2; ++b)
#pragma unroll
            for (int m = 0; m < 4; ++m)
#pragma unroll
                for (int n = 0; n < 2; ++n) acc[a][b][m][n] = (f32x4){0.f, 0.f, 0.f, 0.f};
    bf16x8 At[4][2], B0[2][2], B1[2][2];
    const char* cA = (const char*)g.A + (size_t)cur.pm * tstepA; const char* cB = (const char*)g.Bt + (size_t)cur.pn * tstepB;
    S.a_ready(cur);
    if constexpr (SP2) {
        PG8_STAGE(PG8_SB(0, 0), cB, voffB); PG8_STAGE(PG8_SB(0, 1), cB + hstepB, voffB); PG8_STAGE(PG8_SA(0, 0), cA, voffA); PG8_STAGE(PG8_SA(0, 1), cA + hstepA, voffA);
        if (wr == 1) PG8_BAR;
        PG8_WAIT_V(2); PG8_BAR;
        PG8_STAGE(PG8_SB(1, 0), cB + kstep, voffB); PG8_STAGE(PG8_SA(1, 0), cA + kstep, voffA); PG8_STAGE(PG8_SB(1, 1), cB + hstepB + kstep, voffB);
        PG8_WAIT_V(6); PG8_BAR;
    } else {
        PG8_STAGE(PG8_SB(0, 0), cB, voffB); PG8_STAGE(PG8_SA(0, 0), cA, voffA); PG8_STAGE(PG8_SB(0, 1), cB + hstepB, voffB); PG8_STAGE(PG8_SA(0, 1), cA + hstepA, voffA);
        if (wr == 1) PG8_BAR;
        PG8_WAIT_V(4); PG8_BAR;
        PG8_STAGE(PG8_SB(1, 0), cB + kstep, voffB); PG8_STAGE(PG8_SA(1, 0), cA + kstep, voffA); PG8_STAGE(PG8_SB(1, 1), cB + hstepB + kstep, voffB);
        PG8_WAIT_V(6); PG8_BAR;
    }
    for (;;) {
        const bool has_next = S.next(ui + 1, nxt);
        const char* nA = has_next ? (const char*)g.A + (size_t)nxt.pm * tstepA : cA; const char* nB = has_next ? (const char*)g.Bt + (size_t)nxt.pn * tstepB : cB;
#pragma unroll 1
        for (int t = 0; t < nt; t += 2) {
            const bool last = (t == nt - 2);
            const char* a1 = cA + (size_t)(t + 1) * kstep;
            const char* a2 = last ? nA : cA + (size_t)(t + 2) * kstep; const char* b2 = last ? nB : cB + (size_t)(t + 2) * kstep;
            const char* a3 = a2 + kstep; const char* b3 = b2 + kstep;
            if (last && has_next) S.a_ready(nxt);
            if constexpr (SP2) {
            PG8_LDB(B0, 0, 0); PG8_LDB(B1, 0, 1); PG8_SCHED; PG8_LDA(At, 0, 0); PG8_STAGE(PG8_SA(1, 1), a1 + hstepA, voffA);
            PG8_WAIT_V(8); PG8_WAIT_L(0); PG8_BAR; PG8_MMA(0, 0, At, B0); PG8_MMA(0, 1, At, B1); PG8_BAR; PG8_SCHED;
            PG8_LDA(At, 0, 1); PG8_STAGE(PG8_SB(0, 0), b2, voffB); PG8_STAGE(PG8_SB(0, 1), b2 + hstepB, voffB); PG8_STAGE(PG8_SA(0, 0), a2, voffA);
            PG8_WAIT_V(8); PG8_WAIT_L(0); PG8_BAR; PG8_MMA(1, 0, At, B0); PG8_MMA(1, 1, At, B1); PG8_BAR; PG8_SCHED;
            PG8_LDB(B0, 1, 0); PG8_LDB(B1, 1, 1); PG8_SCHED; PG8_LDA(At, 1, 0); PG8_STAGE(PG8_SA(0, 1), a2 + hstepA, voffA);
            PG8_WAIT_V(8); PG8_WAIT_L(0); PG8_BAR; PG8_MMA(0, 0, At, B0); PG8_MMA(0, 1, At, B1); PG8_BAR; PG8_SCHED;
            PG8_LDA(At, 1, 1); PG8_STAGE(PG8_SB(1, 0), b3, voffB); PG8_STAGE(PG8_SB(1, 1), b3 + hstepB, voffB); PG8_STAGE(PG8_SA(1, 0), a3, voffA);
            PG8_WAIT_V(8); PG8_WAIT_L(0); PG8_BAR; PG8_MMA(1, 0, At, B0); PG8_MMA(1, 1, At, B1); PG8_BAR; PG8_SCHED;
            } else {
            PG8_LDB(B0, 0, 0); PG8_SCHED; PG8_LDA(At, 0, 0); PG8_STAGE(PG8_SA(1, 1), a1 + hstepA, voffA);
            PG8_WAIT_L(8); PG8_BAR; PG8_WAIT_L(0); PG8_MMA(0, 0, At, B0); PG8_BAR; PG8_SCHED;
            PG8_LDB(B1, 0, 1); PG8_STAGE(PG8_SB(0, 0), b2, voffB);
            PG8_BAR; PG8_WAIT_L(0); PG8_MMA(0, 1, At, B1); PG8_BAR;
            PG8_LDA(At, 0, 1); PG8_STAGE(PG8_SA(0, 0), a2, voffA);
            PG8_BAR; PG8_WAIT_L(0); PG8_MMA(1, 0, At, B0); PG8_BAR; PG8_SCHED;
            PG8_STAGE(PG8_SB(0, 1), b2 + hstepB, voffB);
            PG8_WAIT_V(6); PG8_BAR; PG8_MMA(1, 1, At, B1); PG8_BAR;
            PG8_LDB(B0, 1, 0); PG8_SCHED; PG8_LDA(At, 1, 0); PG8_STAGE(PG8_SA(0, 1), a2 + hstepA, voffA);
            PG8_WAIT_L(8); PG8_BAR; PG8_WAIT_L(0); PG8_MMA(0, 0, At, B0); PG8_BAR; PG8_SCHED;
            PG8_LDB(B1, 1, 1); PG8_STAGE(PG8_SB(1, 0), b3, voffB);
            PG8_BAR; PG8_WAIT_L(0); PG8_MMA(0, 1, At, B1); PG8_BAR;
            PG8_LDA(At, 1, 1); PG8_STAGE(PG8_SA(1, 0), a3, voffA);
            PG8_BAR; PG8_WAIT_L(0); PG8_MMA(1, 0, At, B0); PG8_BAR; PG8_SCHED;
            PG8_STAGE(PG8_SB(1, 1), b3 + hstepB, voffB);
            PG8_WAIT_V(6); PG8_BAR; PG8_MMA(1, 1, At, B1); PG8_BAR;
            }
        }
        if constexpr (F8) asm volatile("s_nop 15\n\ts_nop 15" ::: "memory");
        if constexpr (ALIGN_EPI) { if (wr == 0) PG8_BAR; }
        if constexpr (F8) { int t2 = threadIdx.x; asm volatile("" : "+v"(t2));
            const int wid2 = __builtin_amdgcn_readfirstlane(t2 >> 6), lane2 = t2 & 63; E(acc, cur, wid2 >> 2, wid2 & 3, lane2 & 15, lane2 >> 4); }
        else E(acc, cur, wr, wc, fr, fq);
        S.done(cur);
        if (!has_next) break;
#pragma unroll
        for (int a = 0; a < 2; ++a)
#pragma unroll
            for (int b = 0; b < 2; ++b)
#pragma unroll
                for (int m = 0; m < 4; ++m)
#pragma unroll
                    for (int n = 0; n < 2; ++n) acc[a][b][m][n] = (f32x4){0.f, 0.f, 0.f, 0.f};
        cur = nxt; cA = nA; cB = nB; ++ui;
        if constexpr (ALIGN_EPI) { if (wr == 1) PG8_BAR; }
    }
    PG8_WAIT_V(0);
    if constexpr (!ALIGN_EPI) { if (wr == 0) PG8_BAR; }
    PG8_BAR;
#undef PG8_SA
#undef PG8_SB
#undef PG8_STAGE
#undef PG8_LDA
#undef PG8_LDB
#undef PG8_MMA
#undef PG8_CAT8
#undef PG8_WAIT_V
#undef PG8_WAIT_L
#undef PG8_BAR
#undef PG8_SCHED
}

template <class Epi, class Sched>
__device__ __forceinline__ void gemm_naive(PG8_LAS unsigned char* lds, const Gemm g, const Sched& S, const Epi& E) {
    const int tid = threadIdx.x, wid = __builtin_amdgcn_readfirstlane(tid >> 6), lane = tid & 63, wr = wid >> 2, wc = wid & 3, fr = lane & 15, fq = lane >> 4;
    PG8_LAS float* As = (PG8_LAS float*)lds; PG8_LAS float* Bs = As + 256 * 33;
    Unit u;
    for (int ui = 0; S.next(ui, u); ++ui) {
        f32x4 acc[2][2][4][2];
#pragma unroll
        for (int a = 0; a < 2; ++a)
#pragma unroll
            for (int b = 0; b < 2; ++b)
#pragma unroll
                for (int m = 0; m < 4; ++m)
#pragma unroll
                    for (int n = 0; n < 2; ++n) acc[a][b][m][n] = (f32x4){0.f, 0.f, 0.f, 0.f};
        for (int k0 = 0; k0 < g.K; k0 += 32) {
            __syncthreads();
            for (int i = tid; i < 256 * 32; i += 512) { const int r = i >> 5, c = i & 31;
                As[r * 33 + c] = __uint_as_float(((unsigned)g.A[(size_t)(u.pm * 256 + r) * g.lda + k0 + c]) << 16);
                Bs[r * 33 + c] = __uint_as_float(((unsigned)g.Bt[(size_t)(u.pn * 256 + r) * g.K + k0 + c]) << 16); }
            __syncthreads();
            for (int kk = 0; kk < 32; ++kk) {
                float a[2][4], b[2][2][4];
#pragma unroll
                for (int ai = 0; ai < 2; ++ai)
#pragma unroll
                    for (int m = 0; m < 4; ++m) a[ai][m] = As[(128 * ai + 64 * wr + 16 * m + fr) * 33 + kk];
#pragma unroll
                for (int bj = 0; bj < 2; ++bj)
#pragma unroll
                    for (int n = 0; n < 2; ++n)
#pragma unroll
                        for (int j = 0; j < 4; ++j) { const int cl = Epi::PERM ? (128 * bj + 32 * wc + 8 * fq + 4 * n + j) : (128 * bj + 32 * wc + 16 * n + 4 * fq + j); b[bj][n][j] = Bs[cl * 33 + kk]; }
#pragma unroll
                for (int ai = 0; ai < 2; ++ai)
#pragma unroll
                    for (int bj = 0; bj < 2; ++bj)
#pragma unroll
                        for (int m = 0; m < 4; ++m)
#pragma unroll
                            for (int n = 0; n < 2; ++n)
#pragma unroll
                                for (int j = 0; j < 4; ++j) acc[ai][bj][m][n][j] += a[ai][m] * b[bj][n][j];
            }
        }
        E(acc, u, wr, wc, fr, fq);
    }
    __syncthreads();
}
}

constexpr int D = 1024, NB = 8, SEQ = 2048, LC = 256, NLAYER = 2;
constexpr int NL = NB * SEQ;
constexpr int NC = NB * LC;
constexpr int MT = NL + NC;
constexpr int GRID_W = 64;
constexpr int RW_W = 384, RW_IN = 1536, HY_W = 256, HY_IN = 768, NA_W = 384, NA_IN = 1152, GATE_IN = 3072, P_IN = 6528;
constexpr int UA_W = 3584;
constexpr int UA_HY = 1536, UA_NA = 2304;
constexpr int WIN_ROWS = UA_W + GATE_IN;
constexpr int FF = 2816, FFE = 3584, NE = 8;
constexpr int MOE_ROWS = 2 * NL + NE * 256;
constexpr int NFEAT = 8;
constexpr float NORM_EPS = 1e-6f, RW_GN_EPS = 64e-5f;

enum { I_X = 0, I_C, I_CTX, I_CCTX, I_ADAW, I_ADAB, I_N1G, I_N2G, I_WIN, I_RWSHIFT, I_RWW0, I_RWW2, I_RWA0, I_RWA2, I_RWG2, I_RWKK, I_RWKA, I_RWRK, I_RWGNG, I_RWGNB,
       I_HYCW, I_HYCB, I_HYW1, I_HYB1, I_HYW2, I_HYB2, I_HYW3, I_HYFREQ, I_HYSKIP, I_NAQG, I_NAKG, I_NARPB, I_WBRRW, I_WBRHY, I_WBRNA, I_WOUT, I_FFW1, I_FFW3, I_FFW2,
       I_MOER, I_MOEW1, I_MOEW3, I_MOEW2, N_IN };

constexpr size_t al256(size_t x) { return (x + 255) & ~(size_t)255; }
constexpr size_t WS_CTL = 0, CTL_ZERO_BYTES = 1u << 20;
constexpr size_t CTL_MODS_OFF = 65536;
static_assert(CTL_MODS_OFF + (size_t)NLAYER * 9 * 6144 * 4 <= CTL_ZERO_BYTES, "mods inside memset region");
constexpr int CW_BAR = 4096;
constexpr int CW_MOECNT = 8192;
constexpr size_t WS_WIN = CTL_ZERO_BYTES;
constexpr size_t SZ_WIN1 = (size_t)WIN_ROWS * D * 2;
constexpr size_t WS_WBR = WS_WIN + 2 * SZ_WIN1;
constexpr size_t SZ_WBR1 = (size_t)D * 1024 * 2;
constexpr size_t WS_WOUT = WS_WBR + 2 * SZ_WBR1;
constexpr size_t SZ_WOUT1 = (size_t)D * D * 2;
constexpr size_t WS_WFF13 = WS_WOUT + 2 * SZ_WOUT1;
constexpr size_t WS_WFF2 = WS_WFF13 + (size_t)2 * FF * D * 2;
constexpr size_t WS_WM13 = WS_WFF2 + (size_t)D * FF * 2;
constexpr size_t WS_WM2 = WS_WM13 + (size_t)NE * 2 * FFE * D * 2;
constexpr size_t WS_CTXRES = WS_WM2 + (size_t)NE * D * FFE * 2;
constexpr size_t WS_FILT = WS_CTXRES + (size_t)NC * D * 4;
constexpr size_t WS_FILTC = WS_FILT + (size_t)2 * 2 * 256 * 4096 * 2;
constexpr size_t WS_H2BUF = WS_FILTC + (size_t)2 * 256 * 512 * 2;
constexpr size_t WS_MISC = WS_H2BUF + (size_t)2 * 2 * 2048 * 64 * 4;
constexpr size_t MISC_SEL = 0;
constexpr size_t MISC_ROWTOK = MISC_SEL + (size_t)NL * 32;
constexpr size_t MISC_ROWWGT = MISC_ROWTOK + (size_t)MOE_ROWS * 4;
constexpr int RWT_W2 = 0, RWT_A2 = 2 * 384 * 64, RWT_G2 = 4 * 384 * 64, RWT_PER_LAYER = 4 * 384 * 64 + 384 * 128;
constexpr size_t MISC_RWT = al256(MISC_ROWWGT + (size_t)MOE_ROWS * 4);
constexpr size_t MISC_ROPE = MISC_RWT + (size_t)2 * (4 * 384 * 64 + 384 * 128) * 2;
constexpr size_t WS_RA = al256(WS_MISC + MISC_ROPE + 64 * 16 * 2 * 4);
constexpr size_t SZ_RA = (size_t)MT * D * 2;
constexpr size_t WS_RB = WS_RA + SZ_RA;
constexpr size_t RB_YHY = (size_t)2 * MT * RW_W * 2;
static_assert(RB_YHY + (size_t)MT * HY_W * 2 <= SZ_RA, "RB map");
constexpr size_t WS_R1 = WS_RB + SZ_RA;
constexpr size_t SZ_UA = (size_t)MT * UA_W * 2;
constexpr size_t R1_FEAT = SZ_UA;
constexpr size_t R1_G = SZ_UA;
constexpr size_t SZ_R1 = (size_t)MOE_ROWS * FFE * 2;
static_assert(SZ_UA + (size_t)MT * NFEAT * RW_W * 2 <= SZ_R1 && SZ_UA + (size_t)MT * GATE_IN * 2 <= SZ_R1 && (size_t)MT * FF * 2 <= SZ_R1, "R1 map");
static_assert((size_t)MOE_ROWS * D * 2 <= 2 * SZ_RA, "A_sorted fits RA+RB");
constexpr size_t R1_H2U = 0;
constexpr size_t WS_END = WS_R1 + SZ_R1;

constexpr int LDS_BYTES = 147456;
constexpr int LDS_CTL_OFF = LDS_BYTES - 256;
constexpr int NWAVES = 8, NTHREADS = 512;

#define GAS __attribute__((address_space(1)))
#define LAS __attribute__((address_space(3)))
typedef unsigned short bf16;
typedef unsigned v4u __attribute__((ext_vector_type(4)));
typedef unsigned v2u __attribute__((ext_vector_type(2)));
typedef float f32x4 __attribute__((ext_vector_type(4)));
typedef float f32x2 __attribute__((ext_vector_type(2)));
__device__ __forceinline__ unsigned f2bf(float f) { unsigned u = __builtin_bit_cast(unsigned, f); return (u + 0x7fffu + ((u >> 16) & 1u)) >> 16; }
__device__ __forceinline__ unsigned pk2(float lo, float hi) { return f2bf(lo) | (f2bf(hi) << 16); }
__device__ __forceinline__ float bf2f(bf16 v) { return __uint_as_float(((unsigned)v) << 16); }
__device__ __forceinline__ float bflo(unsigned w) { return __uint_as_float(w << 16); }
__device__ __forceinline__ float bfhi(unsigned w) { return __uint_as_float(w & 0xffff0000u); }
__device__ __forceinline__ void unpack8(const v4u w, float (&x)[8]) { x[0] = bflo(w.x); x[1] = bfhi(w.x); x[2] = bflo(w.y); x[3] = bfhi(w.y); x[4] = bflo(w.z); x[5] = bfhi(w.z); x[6] = bflo(w.w); x[7] = bfhi(w.w); }
__device__ __forceinline__ v4u pack8(const float (&x)[8]) { v4u w; w.x = pk2(x[0], x[1]); w.y = pk2(x[2], x[3]); w.z = pk2(x[4], x[5]); w.w = pk2(x[6], x[7]); return w; }
__device__ __forceinline__ float sigmoidf_(float x) { return 1.0f / (1.0f + __expf(-x)); }
__device__ __forceinline__ float siluf_(float x) { return x / (1.0f + __expf(-x)); }
__device__ __forceinline__ unsigned pk4_fp8(float a, float b, float c, float d) { int p = __builtin_amdgcn_cvt_pk_fp8_f32(a, b, 0, false); p = __builtin_amdgcn_cvt_pk_fp8_f32(c, d, p, true); return (unsigned)p; }
__device__ __forceinline__ float wave_sum(float v) {
#pragma unroll
    for (int o = 1; o < 64; o <<= 1) v += __shfl_xor(v, o);
    return v;
}
__device__ __forceinline__ float wave_max(float v) {
#pragma unroll
    for (int o = 1; o < 64; o <<= 1) v = fmaxf(v, __shfl_xor(v, o));
    return v;
}
#define LDS_WAIT() asm volatile("s_waitcnt lgkmcnt(0)" ::: "memory")
#define VM_WAIT() asm volatile("s_waitcnt vmcnt(0)" ::: "memory")

#define XB_TMO      128
#define XB_XCNT(j)  (256  + 64 * (j))
#define XB_XSUB(j)  (1280 + 64 * (j))
#define XB_XGEN(j)  (2304 + 64 * (j))
#define XB_TOP      3328
#define XB_TOPGEN   3392
#define XCD_BAR_WORDS 3456
#define XB_SPIN_CAP (1u << 18)
__device__ __forceinline__ unsigned xb_ld(unsigned* p)              { return __hip_atomic_load(p, __ATOMIC_RELAXED, __HIP_MEMORY_SCOPE_AGENT); }
__device__ __forceinline__ unsigned xb_add(unsigned* p, unsigned v) { return __hip_atomic_fetch_add(p, v, __ATOMIC_RELAXED, __HIP_MEMORY_SCOPE_AGENT); }
__device__ __forceinline__ unsigned xb_xcc_id() { return (unsigned)__builtin_amdgcn_s_getreg((3 << 11) | 20) & 0xFu; }
#define XB_SPIN(cond, bar) do { unsigned _sp = 0; while (cond) { __builtin_amdgcn_s_sleep(1); \
    if ((++_sp & 255u) == 0u) { if (xb_ld(&(bar)[XB_TMO])) break; if (_sp > XB_SPIN_CAP) { atomicAdd(&(bar)[XB_TMO], 1u); break; } } } } while (0)
struct XcdBarrier { unsigned* bar; unsigned x; volatile LAS unsigned* st; };
__device__ __forceinline__ XcdBarrier xcd_barrier_post(unsigned* bar, volatile LAS unsigned* st) {
    XcdBarrier b; b.bar = bar; b.x = xb_xcc_id(); b.st = st;
    if (threadIdx.x == 0) (void)xb_add(&bar[XB_XCNT(b.x)], 1u);
    return b;
}
__device__ __forceinline__ void xcd_barrier_complete(unsigned* bar, unsigned x, unsigned& nloc, unsigned& nx) {
    const unsigned G = gridDim.x * gridDim.y * gridDim.z;
    unsigned sum, cnt, mine, sp = 0u;
    for (;;) {
        sum = 0u; cnt = 0u; mine = 0u;
#pragma unroll
        for (unsigned j = 0; j < 16; ++j) { const unsigned c = xb_ld(&bar[XB_XCNT(j)]); sum += c; cnt += (c > 0u) ? 1u : 0u; mine = (j == x) ? c : mine; }
        if (sum == G) break;
        __builtin_amdgcn_s_sleep(1);
        if ((++sp & 255u) == 0u) { if (xb_ld(&bar[XB_TMO])) break; if (sp > XB_SPIN_CAP) { atomicAdd(&bar[XB_TMO], 1u); break; } }
    }
    nloc = mine > 0u ? mine : 1u; nx = cnt > 0u ? cnt : 1u;
}
__device__ __forceinline__ void xcd_barrier(const XcdBarrier& b) {
    asm volatile("s_waitcnt vmcnt(0)" ::: "memory");
    __syncthreads();
    if (threadIdx.x == 0) {
        unsigned* bar = b.bar;
        __builtin_amdgcn_s_waitcnt(0);
        unsigned nloc = b.st[0], nx = b.st[1];
        if (nloc == 0u) { xcd_barrier_complete(bar, b.x, nloc, nx); b.st[0] = nloc; b.st[1] = nx; }
        const unsigned old = xb_add(&bar[XB_XSUB(b.x)], 1u);
        const unsigned gen = old / nloc;
        if (old + 1u == (gen + 1u) * nloc) {
            __builtin_amdgcn_fence(__ATOMIC_RELEASE, "agent");
            asm volatile("s_waitcnt vmcnt(0)" ::: "memory");
            const unsigned og = xb_add(&bar[XB_TOP], 1u);
            const unsigned tg = og / nx;
            if (og + 1u == (tg + 1u) * nx) xb_add(&bar[XB_TOPGEN], 1u);
            else XB_SPIN(xb_ld(&bar[XB_TOPGEN]) == tg, bar);
            __builtin_amdgcn_fence(__ATOMIC_ACQUIRE, "agent");
            xb_add(&bar[XB_XGEN(b.x)], 1u);
            asm volatile("s_waitcnt vmcnt(0)" ::: "memory");
        } else {
            XB_SPIN(xb_ld(&bar[XB_XGEN(b.x)]) == gen, bar);
            __builtin_amdgcn_fence(__ATOMIC_ACQUIRE, "agent");
            asm volatile("s_waitcnt vmcnt(0)" ::: "memory");
        }
    }
    __syncthreads();
}

struct Args { const float* in[N_IN]; float* out; unsigned char* ws; int ph_lo, ph_hi; };
static_assert(sizeof(Args) == N_IN * 8 + 8 + 8 + 8, "Args has no padding");
#define CAS __attribute__((address_space(4)))
typedef const float* cfp;
struct Frame {
    LAS unsigned char* lds;
    int tid, lane, wave, bid, G;
    const CAS cfp* in;
    float* out; unsigned char* ws;
    __device__ __forceinline__ void fresh() { int t = threadIdx.x, b = blockIdx.x, g = gridDim.x; asm volatile("" : "+v"(t), "+s"(b), "+s"(g)); tid = t; lane = t & 63; wave = __builtin_amdgcn_readfirstlane(t >> 6); bid = b; G = g; }
    template <class T> __device__ __forceinline__ T* wsp(size_t off) const { return (T*)(ws + off); }
    __device__ __forceinline__ const float* mods(int li, int r9) const { return (const float*)(ws + CTL_MODS_OFF) + (size_t)(li * 9 + r9) * 6144; }
};

using pg8::Unit; using pg8::cvt_pk_bf16;
template <int ACT  > struct EpiBf16S {
    static constexpr bool PERM = true;
    bf16* O; int ldc;
    __device__ __forceinline__ void operator()(const f32x4 (&acc)[2][2][4][2], const Unit& u, int wr, int wc, int fr, int fq) const {
        const int row0 = u.pm * 256 + wr * 64 + fr, col0 = u.pn * 256 + wc * 32 + 8 * fq;
        if (ACT == 0 && u.pn >= 6 && u.pn <= 8) {
#pragma unroll
            for (int ai = 0; ai < 2; ++ai)
#pragma unroll
                for (int m = 0; m < 4; ++m) { const int blk = u.pm * 256 + ai * 128 + wr * 64, i = m * 16 + fr;
#pragma unroll
                    for (int bj = 0; bj < 2; ++bj) { const int cb = bj * 128 + wc * 32 + 8 * fq;
                        bf16* tp = O + (size_t)(blk + (cb >> 2)) * ldc + u.pn * 256 + i; const f32x4 v0 = acc[ai][bj][m][0], v1 = acc[ai][bj][m][1];
#pragma unroll
                        for (int e = 0; e < 4; ++e) { tp[e * 64] = (bf16)f2bf(v0[e]); tp[ldc + e * 64] = (bf16)f2bf(v1[e]); } } }
            return; }
        if (ACT == 0 && u.pn >= 12) {
#pragma unroll
            for (int ai = 0; ai < 2; ++ai)
#pragma unroll
                for (int m = 0; m < 4; ++m) { const int blk = u.pm * 256 + ai * 128 + wr * 64, i = m * 16 + fr;
#pragma unroll
                    for (int bj = 0; bj < 2; ++bj) { const int cb = (u.pn - 12) * 256 + bj * 128 + wc * 32 + 8 * fq;
                        if (cb < 384) { const f32x4 v0 = acc[ai][bj][m][0], v1 = acc[ai][bj][m][1];
#pragma unroll
                            for (int e = 0; e < 8; ++e) { const int cv = cb + e, q6 = (cv * 10923) >> 16, r6 = cv - 6 * q6; O[(size_t)(blk + q6) * ldc + 3072 + r6 * 64 + i] = (bf16)f2bf(e < 4 ? v0[e & 3] : v1[e & 3]); } } } }
            return; }
#pragma unroll
        for (int ai = 0; ai < 2; ++ai)
#pragma unroll
            for (int m = 0; m < 4; ++m) { bf16* rowp = O + (size_t)(row0 + ai * 128 + m * 16) * ldc + col0;
#pragma unroll
                for (int bj = 0; bj < 2; ++bj) { f32x4 v0 = acc[ai][bj][m][0], v1 = acc[ai][bj][m][1];
                    if (ACT == 1) {
#pragma unroll
                        for (int j = 0; j < 4; ++j) { v0[j] = sigmoidf_(v0[j]); v1[j] = sigmoidf_(v1[j]); } }
                    v4u w; w.x = cvt_pk_bf16(v0[0], v0[1]); w.y = cvt_pk_bf16(v0[2], v0[3]); w.z = cvt_pk_bf16(v1[0], v1[1]); w.w = cvt_pk_bf16(v1[2], v1[3]);
                    *(v4u*)(rowp + bj * 128) = w; } }
    }
};
template <int MODE  > struct EpiMerge {
    static constexpr bool PERM = true;
    const bf16* Gt; int ldg; bf16* Mo;
    __device__ __forceinline__ void operator()(const f32x4 (&acc)[2][2][4][2], const Unit& u, int wr, int wc, int fr, int fq) const {
        const int row0 = u.pm * 256 + wr * 64 + fr, col0 = u.pn * 256 + wc * 32 + 8 * fq;
#pragma unroll
        for (int ai = 0; ai < 2; ++ai)
#pragma unroll
            for (int m = 0; m < 4; ++m) { const size_t r = (size_t)(row0 + ai * 128 + m * 16);
#pragma unroll
                for (int bj = 0; bj < 2; ++bj) { const int c = col0 + bj * 128;
                    const v4u gw = *(const v4u*)(Gt + r * ldg + c);
                    f32x4 v0 = acc[ai][bj][m][0], v1 = acc[ai][bj][m][1];
                    v0[0] *= bflo(gw.x); v0[1] *= bfhi(gw.x); v0[2] *= bflo(gw.y); v0[3] *= bfhi(gw.y);
                    v1[0] *= bflo(gw.z); v1[1] *= bfhi(gw.z); v1[2] *= bflo(gw.w); v1[3] *= bfhi(gw.w);
                    bf16* mp = Mo + r * D + c;
                    if (MODE == 1) { const v4u mw = *(const v4u*)mp;
                        v0[0] += bflo(mw.x); v0[1] += bfhi(mw.x); v0[2] += bflo(mw.y); v0[3] += bfhi(mw.y);
                        v1[0] += bflo(mw.z); v1[1] += bfhi(mw.z); v1[2] += bflo(mw.w); v1[3] += bfhi(mw.w); }
                    v4u w; w.x = cvt_pk_bf16(v0[0], v0[1]); w.y = cvt_pk_bf16(v0[2], v0[3]); w.z = cvt_pk_bf16(v1[0], v1[1]); w.w = cvt_pk_bf16(v1[2], v1[3]);
                    *(v4u*)mp = w; } }
    }
};
struct EpiRes {
    static constexpr bool PERM = false;
    const float* base_l; float* out_l; const float* base_c; float* out_c; const float* modl; int goff; float sc;
    __device__ __forceinline__ void operator()(const f32x4 (&acc)[2][2][4][2], const Unit& u, int wr, int wc, int fr, int fq) const {
        const bool isl = u.pm < 64; const int pml = isl ? u.pm : u.pm - 64; const int r9 = isl ? (u.pm >> 3) : 8;
        const float* base = isl ? base_l : base_c; float* out = isl ? out_l : out_c; const float* gate = modl + (size_t)r9 * 6144 + goff;
        const int row0 = pml * 256 + wr * 64 + fr, col0 = u.pn * 256 + wc * 32 + 4 * fq;
        f32x4 gv[2][2];
#pragma unroll
        for (int bj = 0; bj < 2; ++bj)
#pragma unroll
            for (int n = 0; n < 2; ++n) gv[bj][n] = *(const f32x4*)(gate + col0 + bj * 128 + n * 16);
#pragma unroll
        for (int ai = 0; ai < 2; ++ai)
#pragma unroll
            for (int m = 0; m < 4; ++m) { const size_t off = (size_t)(row0 + ai * 128 + m * 16) * D + col0;
#pragma unroll
                for (int bj = 0; bj < 2; ++bj)
#pragma unroll
                    for (int n = 0; n < 2; ++n) { const f32x4 bs = *(const f32x4*)(base + off + bj * 128 + n * 16);
                        *(f32x4*)(out + off + bj * 128 + n * 16) = bs + gv[bj][n] * acc[ai][bj][m][n] * sc; } }
    }
};
struct EpiSwiGLU {
    static constexpr bool PERM = true;
    bf16* H; int ldh; int ntl; float sc;
    __device__ __forceinline__ void operator()(const f32x4 (&acc)[2][2][4][2], const Unit& u, int wr, int wc, int fr, int fq) const {
        const int row0 = u.pm * 256 + wr * 64 + fr, col0 = (u.pn % ntl) * 128 + wc * 32 + 8 * fq;
#pragma unroll
        for (int ai = 0; ai < 2; ++ai)
#pragma unroll
            for (int m = 0; m < 4; ++m) { bf16* rowp = H + (size_t)(row0 + ai * 128 + m * 16) * ldh + col0;
                f32x4 h0, h1;
#pragma unroll
                for (int j = 0; j < 4; ++j) { h0[j] = siluf_(acc[ai][0][m][0][j] * sc) * (acc[ai][1][m][0][j] * sc); h1[j] = siluf_(acc[ai][0][m][1][j] * sc) * (acc[ai][1][m][1][j] * sc); }
                v4u w; w.x = cvt_pk_bf16(h0[0], h0[1]); w.y = cvt_pk_bf16(h0[2], h0[3]); w.z = cvt_pk_bf16(h1[0], h1[1]); w.w = cvt_pk_bf16(h1[2], h1[3]);
                *(v4u*)rowp = w; }
    }
};
struct EpiMoeY {
    static constexpr bool PERM = true;
    bf16* O;
    __device__ __forceinline__ void operator()(const f32x4 (&acc)[2][2][4][2], const Unit& u, int wr, int wc, int fr, int fq) const {
        const int row0 = u.pm * 256 + wr * 64 + fr, col0 = (u.pn & 3) * 256 + wc * 32 + 8 * fq;
#pragma unroll
        for (int ai = 0; ai < 2; ++ai)
#pragma unroll
            for (int m = 0; m < 4; ++m) { bf16* rowp = O + (size_t)(row0 + ai * 128 + m * 16) * D + col0;
#pragma unroll
                for (int bj = 0; bj < 2; ++bj) { const f32x4 v0 = acc[ai][bj][m][0], v1 = acc[ai][bj][m][1];
                    v4u w; w.x = cvt_pk_bf16(v0[0], v0[1]); w.y = cvt_pk_bf16(v0[2], v0[3]); w.z = cvt_pk_bf16(v1[0], v1[1]); w.w = cvt_pk_bf16(v1[2], v1[3]);
                    *(v4u*)(rowp + bj * 128) = w; } }
    }
};

#if USE_NAIVE_GEMM
#define GEMM_CALL(EpiT, SchedT, lds, g, S, E) pg8::gemm_naive<EpiT, SchedT>(lds, g, S, E)
#else
#define GEMM_CALL(EpiT, SchedT, lds, g, S, E) pg8::gemm_phase<EpiT, SchedT, true, true>(lds, g, S, E)
#define GEMM_CALL_F8(EpiT, SchedT, lds, g, S, E) pg8::gemm_phase<EpiT, SchedT, true, true, true>(lds, g, S, E)
#endif

__device__ __forceinline__ void tr_item(const float* W, int ldw, int col0, int ncols, int K, bf16* WT, int mode, int row_off, LAS float* scr, int item, int lane) {
    const int nblk = ncols / 32, kb = item / nblk, nb = item % nblk, k0 = 64 * kb, n0 = 32 * nb;
    float tv[32];
#pragma unroll
    for (int i = 0; i < 32; ++i) { const int kk = 2 * i + (lane >> 5); tv[i] = W[(size_t)(k0 + kk) * ldw + col0 + n0 + (lane & 31)]; }
#pragma unroll
    for (int i = 0; i < 32; ++i) { const int kk = 2 * i + (lane >> 5); scr[kk * 33 + (lane & 31)] = tv[i]; }
    LDS_WAIT(); asm volatile("" ::: "memory");
    const int c = lane & 7;
#pragma unroll
    for (int j = 0; j < 4; ++j) { const int n = (lane >> 3) + 8 * j; const LAS float* s = scr + (8 * c) * 33 + n;
        v4u o; o.x = pk2(s[0 * 33], s[1 * 33]); o.y = pk2(s[2 * 33], s[3 * 33]); o.z = pk2(s[4 * 33], s[5 * 33]); o.w = pk2(s[6 * 33], s[7 * 33]);
        const int nn = n0 + n; const int drow = mode == 0 ? row_off + nn : row_off + (nn >> 7) * 256 + (nn & 127);
        *(v4u*)(WT + (size_t)drow * K + k0 + 8 * c) = o; }
    LDS_WAIT(); asm volatile("" ::: "memory");
}
struct TrDesc { const float* W; int ldw, col0, ncols, K; bf16* WT; int mode, row_off; };
__device__ __forceinline__ void tr_desc_small(const Frame& F, int idx, TrDesc& d) {
    if (idx < 12) { const int li = idx / 6, k = idx % 6;
        if (k == 0) d = TrDesc{F.in[I_WIN] + (size_t)li * D * P_IN, P_IN, 0, 3456, D, F.wsp<bf16>(WS_WIN + li * SZ_WIN1), 0, 0};
        else if (k == 1) d = TrDesc{F.in[I_WIN] + (size_t)li * D * P_IN, P_IN, 3456, GATE_IN, D, F.wsp<bf16>(WS_WIN + li * SZ_WIN1), 0, UA_W};
        else if (k == 2) d = TrDesc{F.in[I_WBRRW] + (size_t)li * RW_W * D, D, 0, D, RW_W, F.wsp<bf16>(WS_WBR + li * SZ_WBR1), 0, 0};
        else if (k == 3) d = TrDesc{F.in[I_WBRHY] + (size_t)li * HY_W * D, D, 0, D, HY_W, F.wsp<bf16>(WS_WBR + li * SZ_WBR1 + (size_t)D * RW_W * 2), 0, 0};
        else if (k == 4) d = TrDesc{F.in[I_WBRNA] + (size_t)li * NA_W * D, D, 0, D, NA_W, F.wsp<bf16>(WS_WBR + li * SZ_WBR1 + (size_t)D * (RW_W + HY_W) * 2), 0, 0};
        else d = TrDesc{F.in[I_WOUT] + (size_t)li * D * D, D, 0, D, D, F.wsp<bf16>(WS_WOUT + li * SZ_WOUT1), 0, 0};
    } else if (idx == 12) d = TrDesc{F.in[I_FFW1], FF, 0, FF, D, F.wsp<bf16>(WS_WFF13), 1, 0};
    else if (idx == 13) d = TrDesc{F.in[I_FFW3], FF, 0, FF, D, F.wsp<bf16>(WS_WFF13), 1, 128};
    else d = TrDesc{F.in[I_FFW2], D, 0, D, FF, F.wsp<bf16>(WS_WFF2), 0, 0};
}
__device__ __forceinline__ void tr_load(const TrDesc& d, int item, int lane, float (&tv)[32]) {
    const int nblk = d.ncols / 32, kb = item / nblk, nb = item % nblk, k0 = 64 * kb, n0 = 32 * nb;
#pragma unroll
    for (int i = 0; i < 32; ++i) { const int kk = 2 * i + (lane >> 5); tv[i] = d.W[(size_t)(k0 + kk) * d.ldw + d.col0 + n0 + (lane & 31)]; }
}
__device__ __forceinline__ void tr_store(const TrDesc& d, int item, int lane, const float (&tv)[32], LAS float* scr) {
    const int nblk = d.ncols / 32, kb = item / nblk, nb = item % nblk, k0 = 64 * kb, n0 = 32 * nb;
#pragma unroll
    for (int i = 0; i < 32; ++i) { const int kk = 2 * i + (lane >> 5); scr[kk * 33 + (lane & 31)] = tv[i]; }
    LDS_WAIT(); asm volatile("" ::: "memory");
    const int c = lane & 7;
#pragma unroll
    for (int j = 0; j < 4; ++j) { const int n = (lane >> 3) + 8 * j; const LAS float* s = scr + (8 * c) * 33 + n;
        const int nn = n0 + n; const int drow = (d.mode & 3) == 0 ? d.row_off + nn : d.row_off + (nn >> 7) * 256 + (nn & 127);
        if (d.mode & 4) { const v2u o8 = {pk4_fp8(32.f * s[0 * 33], 32.f * s[1 * 33], 32.f * s[2 * 33], 32.f * s[3 * 33]), pk4_fp8(32.f * s[4 * 33], 32.f * s[5 * 33], 32.f * s[6 * 33], 32.f * s[7 * 33])};
            *(v2u*)((unsigned char*)d.WT + (size_t)drow * d.K + k0 + 8 * c) = o8; }
        else { v4u o; o.x = pk2(s[0 * 33], s[1 * 33]); o.y = pk2(s[2 * 33], s[3 * 33]); o.z = pk2(s[4 * 33], s[5 * 33]); o.w = pk2(s[6 * 33], s[7 * 33]);
            *(v4u*)(d.WT + (size_t)drow * d.K + k0 + 8 * c) = o; } }
    LDS_WAIT(); asm volatile("" ::: "memory");
}
__device__ __forceinline__ void moe_desc(const Frame& F, int mi, TrDesc& d) { const int e = mi / 3, w = mi % 3;
    if (w == 0) d = TrDesc{F.in[I_MOEW1] + (size_t)e * D * FFE, FFE, 0, FFE, D, F.wsp<bf16>(WS_WM13), 1 | 4, e * 2 * FFE};
    else if (w == 1) d = TrDesc{F.in[I_MOEW3] + (size_t)e * D * FFE, FFE, 0, FFE, D, F.wsp<bf16>(WS_WM13), 1 | 4, e * 2 * FFE + 128};
    else d = TrDesc{F.in[I_MOEW2] + (size_t)e * FFE * D, D, 0, D, FFE, F.wsp<bf16>(WS_WM2), 0, e * D}; }
__device__ __forceinline__ void moe_weight_transposes(Frame& F) {
    const int gw = F.bid * NWAVES + F.wave, NGW = F.G * NWAVES;
    LAS float* scr = (LAS float*)(F.lds + F.wave * 16384);
    constexpr int MOE_ITEMS = 1792, NIT = 24 * MOE_ITEMS;
    int it = gw; if (it >= NIT) return;
    TrDesc dc; moe_desc(F, it / MOE_ITEMS, dc); float tvc[32]; tr_load(dc, it % MOE_ITEMS, F.lane, tvc);
#pragma unroll 1
    for (;;) {
        const int itn = it + NGW; const bool hn = itn < NIT; TrDesc dn = dc; float tvn[32];
        if (hn) { moe_desc(F, itn / MOE_ITEMS, dn); tr_load(dn, itn % MOE_ITEMS, F.lane, tvn); }
        tr_store(dc, it % MOE_ITEMS, F.lane, tvc, scr);
        if (!hn) break;
        dc = dn; it = itn;
#pragma unroll
        for (int i = 0; i < 32; ++i) tvc[i] = tvn[i];
    }
}
__device__ __forceinline__ void p0_prologue(Frame& F) {
    const int gw = F.bid * NWAVES + F.wave, NGW = F.G * NWAVES;
    for (int i = F.bid * NTHREADS + F.tid; i < 2 * 128 * D / 8; i += F.G * NTHREADS) { const int li = i / (128 * D / 8), r = i % (128 * D / 8);
        *(v4u*)(F.wsp<bf16>(WS_WIN + li * SZ_WIN1) + (size_t)3456 * D + (size_t)r * 8) = (v4u){0u, 0u, 0u, 0u}; }
    for (int i = F.bid * NTHREADS + F.tid; i < 2 * RWT_PER_LAYER; i += F.G * NTHREADS) { const int li = i / RWT_PER_LAYER, idx = i % RWT_PER_LAYER; float v;
        if (idx < 4 * 384 * 64) { const int m = idx / (384 * 64), rem = idx % (384 * 64), nn = rem >> 6, k = rem & 63;
            v = m < 2 ? F.in[I_RWW2][((size_t)(li * 2 + m) * 64 + k) * RW_W + nn] : F.in[I_RWA2][((size_t)(li * 2 + (m - 2)) * 64 + k) * RW_W + nn]; }
        else { const int rem = idx - 4 * 384 * 64, nn = rem >> 7, k = rem & 127; v = F.in[I_RWG2][((size_t)li * 128 + k) * RW_W + nn]; }
        F.wsp<bf16>(WS_MISC + MISC_RWT)[i] = (bf16)f2bf(v); }
    if (F.bid == 0) { for (int i = F.tid; i < 1024; i += NTHREADS) { const int pos = i >> 4, fi = i & 15; float sn, cs; sincosf((float)pos * powf(10000.0f, -(float)fi / 16.0f), &sn, &cs);
        float* rt = F.wsp<float>(WS_MISC + MISC_ROPE) + 2 * i; rt[0] = cs; rt[1] = sn; } }
    {
        LAS float* zs = (LAS float*)F.lds;
        LAS float* h1s = zs + 64 * 36;
        const int pl = F.tid >> 3, sub = F.tid & 7;
#pragma unroll 1
        for (int job = F.bid; job < 72; job += F.G) { const int li = job / 36, q = job % 36, seg = q >= 32 ? 1 : 0, p = (seg ? q - 32 : q) * 64 + pl, n = seg ? 256 : 2048;
            __syncthreads();
            if (sub == 0) zs[pl * 36] = (float)p / (float)(n - 1);
#pragma unroll
            for (int e = 0; e < 4; ++e) { const int i = 1 + sub * 4 + e, fi = (i - 1) & 15; const float f = 1e-4f + (float)fi * ((15.0f - 1e-4f) / 15.0f); const float ang = (6.283185307179586f / (float)n) * (float)p * f;
                zs[pl * 36 + i] = i <= 16 ? cosf(ang) : -sinf(ang); }
            __syncthreads();
            const float* w1 = F.in[I_HYW1] + li * 33 * 64 + sub * 8; const float* b1 = F.in[I_HYB1] + li * 64 + sub * 8; const float* fr = F.in[I_HYFREQ] + li * 64 + sub * 8;
            float a[8];
#pragma unroll
            for (int e = 0; e < 8; ++e) a[e] = b1[e];
#pragma unroll 3
            for (int i = 0; i < 33; ++i) { const float z = zs[pl * 36 + i]; const f32x4 wa = *(const f32x4*)(w1 + i * 64), wb = *(const f32x4*)(w1 + i * 64 + 4);
                a[0] += z * wa.x; a[1] += z * wa.y; a[2] += z * wa.z; a[3] += z * wa.w; a[4] += z * wb.x; a[5] += z * wb.y; a[6] += z * wb.z; a[7] += z * wb.w; }
#pragma unroll
            for (int e = 0; e < 8; ++e) h1s[pl * 68 + sub * 8 + e] = sinf(fr[e] * a[e]);
            __syncthreads();
            const float* w2 = F.in[I_HYW2] + li * 64 * 64 + sub * 8; const float* b2 = F.in[I_HYB2] + li * 64 + sub * 8;
#pragma unroll
            for (int e = 0; e < 8; ++e) a[e] = b2[e];
#pragma unroll 4
            for (int i = 0; i < 64; ++i) { const float z = h1s[pl * 68 + i]; const f32x4 wa = *(const f32x4*)(w2 + i * 64), wb = *(const f32x4*)(w2 + i * 64 + 4);
                a[0] += z * wa.x; a[1] += z * wa.y; a[2] += z * wa.z; a[3] += z * wa.w; a[4] += z * wb.x; a[5] += z * wb.y; a[6] += z * wb.z; a[7] += z * wb.w; }
            float* o = F.wsp<float>(WS_H2BUF) + ((size_t)(li * 2 + seg) * 2048 + p) * 64 + sub * 8;
            *(f32x4*)o = (f32x4){sinf(fr[0] * a[0]), sinf(fr[1] * a[1]), sinf(fr[2] * a[2]), sinf(fr[3] * a[3])}; *(f32x4*)(o + 4) = (f32x4){sinf(fr[4] * a[4]), sinf(fr[5] * a[5]), sinf(fr[6] * a[6]), sinf(fr[7] * a[7])};
        }
    }
    __syncthreads();
    if (F.bid < 2 * 96) {
        LAS float* act = (LAS float*)F.lds;
        LAS float* part = act + 9 * 1024;
        for (int i = F.tid; i < 9 * 1024; i += NTHREADS) { const int r = i >> 10, k = i & 1023; const float v = r < 8 ? F.in[I_C][r * D + k] : F.in[I_CCTX][k]; act[i] = siluf_(v); }
        __syncthreads();
#pragma unroll 1
        for (int job = F.bid; job < 2 * 96; job += F.G) { const int li = job / 96, cb = job % 96; const int c = F.tid & 63, kg = F.tid >> 6, col = cb * 64 + c;
            float a[9];
#pragma unroll
            for (int r = 0; r < 9; ++r) a[r] = 0.f;
            const float* wp = F.in[I_ADAW] + ((size_t)li * D + kg * 128) * 6144 + col;
#pragma unroll 1
            for (int k0 = 0; k0 < 128; k0 += 16) { float w[16];
#pragma unroll
                for (int u = 0; u < 16; ++u) w[u] = wp[(size_t)(k0 + u) * 6144];
#pragma unroll
                for (int u = 0; u < 16; ++u)
#pragma unroll
                    for (int r = 0; r < 9; ++r) a[r] += act[r * 1024 + kg * 128 + k0 + u] * w[u]; }
#pragma unroll
            for (int r = 0; r < 9; ++r) part[(kg * 9 + r) * 64 + c] = a[r];
            __syncthreads();
            for (int i = F.tid; i < 9 * 64; i += NTHREADS) { const int r = i >> 6, cc = i & 63; float s = F.in[I_ADAB][li * 6144 + cb * 64 + cc];
#pragma unroll
                for (int g = 0; g < 8; ++g) s += part[(g * 9 + r) * 64 + cc];
                ((float*)(F.ws + CTL_MODS_OFF))[(size_t)(li * 9 + r) * 6144 + cb * 64 + cc] = s; }
            __syncthreads();
        }
    }
    __syncthreads();
    {
        LAS float* scr = (LAS float*)(F.lds + F.wave * 16384);
        for (int mi = 0; mi < 15; ++mi) { TrDesc d; tr_desc_small(F, mi, d); const int items = (d.K / 64) * (d.ncols / 32);
            for (int it = gw; it < items; it += NGW) tr_item(d.W, d.ldw, d.col0, d.ncols, d.K, d.WT, d.mode, d.row_off, scr, it, F.lane); }
    }
}

__device__ __forceinline__ void norm_row(const float* xrow, const float* g, const float* shift, const float* scale, int lane, f32x4 (&v)[4]) {
    const f32x4* xr = (const f32x4*)xrow + lane; float s = 0.f;
#pragma unroll
    for (int j = 0; j < 4; ++j) { v[j] = xr[64 * j]; s += (v[j].x * v[j].x + v[j].y * v[j].y) + (v[j].z * v[j].z + v[j].w * v[j].w); }
    const float rs = 1.0f / sqrtf(wave_sum(s) * (1.f / D) + NORM_EPS);
#pragma unroll
    for (int j = 0; j < 4; ++j) { const f32x4 gg = ((const f32x4*)g)[lane + 64 * j], sh = ((const f32x4*)shift)[lane + 64 * j], sc = ((const f32x4*)scale)[lane + 64 * j];
        v[j] = (v[j] * rs * gg) * (sc + 1.0f) + sh; }
}
__device__ __forceinline__ void store_row_bf16(bf16* orow, int lane, const f32x4 (&v)[4]) {
    v2u* o8 = (v2u*)orow + lane;
#pragma unroll
    for (int j = 0; j < 4; ++j) { v2u w; w.x = pk2(v[j].x, v[j].y); w.y = pk2(v[j].z, v[j].w); o8[64 * j] = w; }
}
__device__ __forceinline__ void hy_filter_job(Frame& F, int layer, int seg, int o, int cg) {
    const int n = seg ? 256 : 2048;
    const float* w3 = F.in[I_HYW3] + (size_t)layer * 64 * 1024;
    const float* h2b = F.wsp<float>(WS_H2BUF) + (size_t)(layer * 2 + seg) * 2048 * 64;
    LAS float* raw = (LAS float*)F.lds;
    LAS float* red = raw + 2048 * 16;
    LAS float* wl = red + 64;
    const float mind = -3.0701134573253945f, maxd = -15.350567286626972f;
    float asum[8];
#pragma unroll
    for (int c = 0; c < 8; ++c) asum[c] = 0.f;
    __syncthreads();
    for (int i = F.tid; i < 1024; i += NTHREADS) { const int q = i >> 6, k = i & 63; wl[i] = w3[(size_t)k * 1024 + o * 512 + (q >> 3) * 256 + cg * 8 + (q & 7)]; }
    __syncthreads();
#pragma unroll 1
    for (int p = F.tid; p < n; p += NTHREADS) {
        f32x4 h[16];
#pragma unroll
        for (int i = 0; i < 16; ++i) h[i] = ((const f32x4*)(h2b + (size_t)p * 64))[i];
        const float tt = (float)p / (float)(n - 1);
#pragma unroll 1
        for (int q = 0; q < 16; ++q) { const int dir = q >> 3, c = q & 7, ch = cg * 8 + c, col = o * 512 + dir * 256 + ch; float a = 0.f;
            (void)col;
#pragma unroll
            for (int i = 0; i < 16; ++i) { const f32x4 w4 = *(const LAS f32x4*)(wl + q * 64 + 4 * i); a += h[i].x * w4.x; a += h[i].y * w4.y; a += h[i].z * w4.z; a += h[i].w * w4.w; }
            const float delta = fabsf(mind + (maxd - mind) * ((float)ch / 255.0f));
            a *= __expf(-tt * delta);
            raw[p * 16 + q] = a;
            const float aa = (dir == 0 || p >= 1) ? fabsf(a) : 0.f;
#pragma unroll
            for (int k = 0; k < 8; ++k) asum[k] += (k == c) ? aa : 0.f; }
    }
#pragma unroll
    for (int c = 0; c < 8; ++c) asum[c] = wave_sum(asum[c]);
    if (F.lane == 0) {
#pragma unroll
        for (int c = 0; c < 8; ++c) red[F.wave * 8 + c] = asum[c]; }
    __syncthreads();
    float inv[8];
#pragma unroll
    for (int c = 0; c < 8; ++c) { float l1 = 0.f;
#pragma unroll
        for (int w = 0; w < 8; ++w) l1 += red[w * 8 + c];
        inv[c] = 1.0f / l1; }
    bf16* dst = seg ? F.wsp<bf16>(WS_FILTC) + (size_t)(o * 256 + cg * 8) * 512 : F.wsp<bf16>(WS_FILT) + (size_t)((layer * 2 + o) * 256 + cg * 8) * 4096;
    const int stride = 2 * n;
#pragma unroll 1
    for (int i = F.tid; i < 8 * n; i += NTHREADS) { const int c = i / n, p = i - c * n; float ic = 0.f;
#pragma unroll
        for (int k = 0; k < 8; ++k) ic = (k == c) ? inv[k] : ic;
        dst[(size_t)c * stride + n + p] = (bf16)f2bf(raw[p * 16 + c] * ic);
        if (p >= 1) dst[(size_t)c * stride + n - p] = (bf16)f2bf(raw[p * 16 + 8 + c] * ic); }
    if (F.tid < 8) dst[(size_t)F.tid * stride] = 0;
}
__device__ __forceinline__ void p1_norm1(Frame& F, int li) {
    const int gw = F.bid * NWAVES + F.wave, NGW = F.G * NWAVES;
    bf16* A1 = F.wsp<bf16>(WS_RA);
    const float* xl = li == 0 ? F.in[I_X] : F.out; const float* xc = li == 0 ? F.in[I_CTX] : F.wsp<float>(WS_CTXRES);
    const float* g = F.in[I_N1G] + li * D;
    for (int row = gw; row < MT; row += NGW) { const bool isl = row < NL; const int r9 = isl ? row >> 11 : 8;
        const float* xr = isl ? xl + (size_t)row * D : xc + (size_t)(row - NL) * D; const float* md = F.mods(li, r9);
        f32x4 v[4]; norm_row(xr, g, md + 0 * D, md + 1 * D, F.lane, v); store_row_bf16(A1 + (size_t)row * D, F.lane, v); }
    if (li == 0) {
        __syncthreads();
        for (int job = F.bid; job < 192; job += F.G) {
            { const int seg = job >= 128 ? 1 : 0, j2 = job - 128 * seg; hy_filter_job(F, seg ? 0 : j2 >> 6, seg, (j2 >> 5) & 1, j2 & 31); }
            __syncthreads(); }
    }
}

__device__ __forceinline__ void rw_scan_chain(Frame& F, int li, int chain) {
    const int b = chain / 12, h = (chain % 12) >> 1, d = chain & 1, lane = F.lane;
    const bf16* FEAT = F.wsp<bf16>(WS_R1 + R1_FEAT); float* Y = F.wsp<float>(WS_RB);
    LAS float* bc = (LAS float*)(F.lds + F.wave * 2048);
    const float k_k = F.in[I_RWKK][li * RW_W + h * 64 + lane], k_a = F.in[I_RWKA][li * RW_W + h * 64 + lane];
    float S[64];
#pragma unroll
    for (int k = 0; k < 64; ++k) S[k] = 0.f;
    const int fe = 3 + d, fi = 5 + d;
    for (int seg = 0; seg < 2; ++seg) { const int n = seg ? SEQ : LC; const int base = seg ? b * SEQ : NL + b * LC;
        int t = d ? n - 1 : 0;
        const bf16* fp = FEAT + (size_t)(base + t) * NFEAT * RW_W + h * 64 + lane;
        bf16 nr = fp[0], nk = fp[RW_W], nv = fp[2 * RW_W], ne = fp[fe * RW_W], ni = fp[fi * RW_W];
        for (int step = 0; step < n; ++step) {
            const float r = bf2f(nr), k = bf2f(nk), v = bf2f(nv), e = bf2f(ne), ic = bf2f(ni);
            const int row = base + t;
            if (step + 1 < n) { t = d ? t - 1 : t + 1; fp = FEAT + (size_t)(base + t) * NFEAT * RW_W + h * 64 + lane; nr = fp[0]; nk = fp[RW_W]; nv = fp[2 * RW_W]; ne = fp[fe * RW_W]; ni = fp[fi * RW_W]; }
            float kkv = k * k_k; const float ss = wave_sum(kkv * kkv); kkv = kkv / fmaxf(sqrtf(ss), 1e-12f);
            bc[0 * 64 + lane] = __expf(-e); bc[1 * 64 + lane] = k * (1.0f + (ic - 1.0f) * k_a); bc[2 * 64 + lane] = -kkv; bc[3 * 64 + lane] = kkv * ic; bc[4 * 64 + lane] = r;
            LDS_WAIT(); asm volatile("" ::: "memory");
            float sa = 0.f;
#pragma unroll
            for (int k4 = 0; k4 < 16; ++k4) { const f32x4 a4 = ((const LAS f32x4*)(bc + 2 * 64))[k4]; sa += S[4 * k4] * a4.x + S[4 * k4 + 1] * a4.y + S[4 * k4 + 2] * a4.z + S[4 * k4 + 3] * a4.w; }
            float y = 0.f;
#pragma unroll
            for (int k4 = 0; k4 < 16; ++k4) { const f32x4 w4 = ((const LAS f32x4*)(bc + 0 * 64))[k4], kd4 = ((const LAS f32x4*)(bc + 1 * 64))[k4], b4 = ((const LAS f32x4*)(bc + 3 * 64))[k4], r4 = ((const LAS f32x4*)(bc + 4 * 64))[k4];
                S[4 * k4 + 0] = S[4 * k4 + 0] * w4.x + sa * b4.x + v * kd4.x; y += S[4 * k4 + 0] * r4.x;
                S[4 * k4 + 1] = S[4 * k4 + 1] * w4.y + sa * b4.y + v * kd4.y; y += S[4 * k4 + 1] * r4.y;
                S[4 * k4 + 2] = S[4 * k4 + 2] * w4.z + sa * b4.z + v * kd4.z; y += S[4 * k4 + 2] * r4.z;
                S[4 * k4 + 3] = S[4 * k4 + 3] * w4.w + sa * b4.w + v * kd4.w; y += S[4 * k4 + 3] * r4.w; }
            __hip_atomic_fetch_add(Y + (size_t)row * RW_W + h * 64 + lane, y, __ATOMIC_RELAXED, __HIP_MEMORY_SCOPE_AGENT);
            asm volatile("" ::: "memory");
        }
    }
}

__device__ __forceinline__ float hy_short(const bf16* U, const float* cw, float cb, int rowbase, int t, int n, int chcol) {
    const float u0 = t > 0 ? bf2f(U[(size_t)(rowbase + t - 1) * UA_W + UA_HY + chcol]) : 0.f;
    const float u1 = bf2f(U[(size_t)(rowbase + t) * UA_W + UA_HY + chcol]);
    const float u2 = t < n - 1 ? bf2f(U[(size_t)(rowbase + t + 1) * UA_W + UA_HY + chcol]) : 0.f;
    return cb + cw[0] * u0 + cw[HY_IN] * u1 + cw[2 * HY_IN] * u2;
}
__device__ __forceinline__ void hy_job(Frame& F, int li, int seg, int b, int cg) {
    const int n = seg ? LC : SEQ, rowbase = seg ? NL + b * LC : b * SEQ;
    bf16* U = F.wsp<bf16>(WS_R1);
    LAS bf16* zA = (LAS bf16*)F.lds; LAS bf16* zB = zA + 2048 * 8; LAS bf16* Fl = zB + 2048 * 8;
    const float* cw = F.in[I_HYCW] + (size_t)li * 3 * HY_IN; const float* cbv = F.in[I_HYCB] + (size_t)li * HY_IN;
    __syncthreads();
    for (int idx = F.tid; idx < n * 8; idx += NTHREADS) { const int t = idx >> 3, c = idx & 7, ch = cg * 8 + c;
        zA[idx] = (bf16)f2bf(hy_short(U, cw + ch, cbv[ch], rowbase, t, n, ch)); }
    LAS bf16* zin = zA; LAS bf16* zout = zB;
    for (int o = 0; o < 2; ++o) {
        const bf16* fsrc = seg ? F.wsp<bf16>(WS_FILTC) + (size_t)(o * 256 + cg * 8) * 512 : F.wsp<bf16>(WS_FILT) + (size_t)((li * 2 + o) * 256 + cg * 8) * 4096;
        __syncthreads();
        for (int idx = F.tid; idx < 8 * 2 * n / 8; idx += NTHREADS) ((LAS v4u*)Fl)[idx] = ((const v4u*)fsrc)[idx];
        __syncthreads();
        const int c = F.tid & 7, tq = F.tid >> 3, ch = cg * 8 + c;
        const LAS bf16* fl = Fl + c * 2 * n;
        const float skip = F.in[I_HYSKIP][(li * 2 + o) * HY_W + ch];
        const int xcol = (o + 1) * HY_W + ch;
        for (int blk = 0; blk < n / 512 + (n < 512 ? 1 : 0); ++blk) { const int t0 = (blk * 64 + tq) * 8;
            if (t0 < n) {
                float acc[8];
#pragma unroll
                for (int j = 0; j < 8; ++j) acc[j] = 0.f;
                for (int s8 = 0; s8 < n; s8 += 8) {
                    float fw[15], zz[8];
                    const int fb = t0 - s8 - 7 + n;
#pragma unroll
                    for (int i = 0; i < 15; ++i) fw[i] = bf2f(fl[fb + i]);
#pragma unroll
                    for (int q = 0; q < 8; ++q) zz[q] = bf2f(zin[(s8 + q) * 8 + c]);
#pragma unroll
                    for (int j = 0; j < 8; ++j)
#pragma unroll
                        for (int q = 0; q < 8; ++q) acc[j] += fw[j - q + 7] * zz[q];
                }
#pragma unroll
                for (int j = 0; j < 8; ++j) { const int t = t0 + j; const float xo = hy_short(U, cw + xcol, cbv[xcol], rowbase, t, n, xcol);
                    const float zo = bf2f(zin[t * 8 + c]); const float zn = xo * (acc[j] + skip * zo);
                    if (o == 0) zout[t * 8 + c] = (bf16)f2bf(zn); else U[(size_t)(rowbase + t) * UA_W + UA_HY + ch] = (bf16)f2bf(zn); }
            } }
        LAS bf16* tmp = zin; zin = zout; zout = tmp;
    }
    __syncthreads();
#undef HY_STAGE_RAW
#undef HY_CONV
}

__device__ __forceinline__ void na_job(Frame& F, int li, int kind, int b, int h, int blk) {
    bf16* U = F.wsp<bf16>(WS_R1);
    LAS float* qs = (LAS float*)F.lds; LAS float* ks = qs + 64 * 65; LAS float* Sc = ks + 64 * 65;
    constexpr int SP = 388;
    const int nloc = kind == 0 ? 128 : 0, ntot = nloc + 256, nch = kind == 0 ? 12 : 4;
    const int qrow0 = kind == 0 ? b * SEQ + blk * 64 : NL + b * LC + blk * 64;
    const int gi = blk, r0 = min(max(gi - 4, 0), 24);
    const int qi = F.tid >> 3, sub = F.tid & 7, d0 = sub * 8;
    const int c0 = min(max(qi - 8, 0), 48);
    const float* qg = F.in[I_NAQG] + li * 64; const float* kg = F.in[I_NAKG] + li * 64;
    const float* rpb = F.in[I_NARPB] + (size_t)(li * 6 + h) * 15 * 31;
    __syncthreads();
    { const v4u w = *(const v4u*)(U + (size_t)(qrow0 + qi) * UA_W + UA_NA + h * 64 + d0);
      float x[8] = {bflo(w.x), bfhi(w.x), bflo(w.y), bfhi(w.y), bflo(w.z), bfhi(w.z), bflo(w.w), bfhi(w.w)}; float ss = 0.f;
#pragma unroll
      for (int e = 0; e < 8; ++e) ss += x[e] * x[e];
      ss += __shfl_xor(ss, 1); ss += __shfl_xor(ss, 2); ss += __shfl_xor(ss, 4);
      const float sc = 0.125f / sqrtf(ss * (1.f / 64.f) + NORM_EPS);
#pragma unroll
      for (int e = 0; e < 8; ++e) qs[qi * 65 + d0 + e] = x[e] * sc * qg[d0 + e]; }
    for (int ch = 0; ch < nch; ++ch) {
        const bool loc = kind == 0 && ch < 8; const int cc = kind == 0 ? ch - 8 : ch;
        const int krow0 = loc ? b * SEQ + (r0 + ch) * 64 : NL + b * LC + cc * 64;
        __syncthreads();
        { const v4u w = *(const v4u*)(U + (size_t)(krow0 + qi) * UA_W + UA_NA + NA_W + h * 64 + d0);
          float x[8] = {bflo(w.x), bfhi(w.x), bflo(w.y), bfhi(w.y), bflo(w.z), bfhi(w.z), bflo(w.w), bfhi(w.w)}; float ss = 0.f;
#pragma unroll
          for (int e = 0; e < 8; ++e) ss += x[e] * x[e];
          ss += __shfl_xor(ss, 1); ss += __shfl_xor(ss, 2); ss += __shfl_xor(ss, 4);
          const float sc = 1.0f / sqrtf(ss * (1.f / 64.f) + NORM_EPS);
#pragma unroll
          for (int e = 0; e < 8; ++e) ks[qi * 65 + d0 + e] = x[e] * sc * kg[d0 + e]; }
        __syncthreads();
        if (loc) {
#pragma unroll 1
            for (int e = 0; e < 2; ++e) { const int kc = c0 + sub * 2 + e; float s = 0.f;
#pragma unroll 8
                for (int dd = 0; dd < 64; ++dd) s += qs[qi * 65 + dd] * ks[kc * 65 + dd];
                const int dr = (r0 + ch) - gi + 7, dc = min(max(kc - qi + 15, 0), 30);
                Sc[qi * SP + ch * 16 + sub * 2 + e] = s + rpb[dr * 31 + dc]; }
        } else {
#pragma unroll 1
            for (int e = 0; e < 8; ++e) { const int kj = sub * 8 + e; float s = 0.f;
#pragma unroll 8
                for (int dd = 0; dd < 64; ++dd) s += qs[qi * 65 + dd] * ks[kj * 65 + dd];
                Sc[qi * SP + nloc + cc * 64 + kj] = s; }
        }
    }
    __syncthreads();
    { float mx = -3.0e38f;
      for (int idx = sub; idx < ntot; idx += 8) mx = fmaxf(mx, Sc[qi * SP + idx]);
      mx = fmaxf(mx, __shfl_xor(mx, 1)); mx = fmaxf(mx, __shfl_xor(mx, 2)); mx = fmaxf(mx, __shfl_xor(mx, 4));
      float sm = 0.f;
      for (int idx = sub; idx < ntot; idx += 8) { const float p = __expf(Sc[qi * SP + idx] - mx); Sc[qi * SP + idx] = p; sm += p; }
      sm += __shfl_xor(sm, 1); sm += __shfl_xor(sm, 2); sm += __shfl_xor(sm, 4);
      const float inv = 1.0f / sm;
      for (int idx = sub; idx < ntot; idx += 8) Sc[qi * SP + idx] *= inv; }
    float acc[8];
#pragma unroll
    for (int e = 0; e < 8; ++e) acc[e] = 0.f;
    for (int ch = 0; ch < nch; ++ch) {
        const bool loc = kind == 0 && ch < 8; const int cc = kind == 0 ? ch - 8 : ch;
        const int krow0 = loc ? b * SEQ + (r0 + ch) * 64 : NL + b * LC + cc * 64;
        __syncthreads();
        { const v4u w = *(const v4u*)(U + (size_t)(krow0 + qi) * UA_W + UA_NA + 2 * NA_W + h * 64 + d0);
          ks[qi * 65 + d0 + 0] = bflo(w.x); ks[qi * 65 + d0 + 1] = bfhi(w.x); ks[qi * 65 + d0 + 2] = bflo(w.y); ks[qi * 65 + d0 + 3] = bfhi(w.y);
          ks[qi * 65 + d0 + 4] = bflo(w.z); ks[qi * 65 + d0 + 5] = bfhi(w.z); ks[qi * 65 + d0 + 6] = bflo(w.w); ks[qi * 65 + d0 + 7] = bfhi(w.w); }
        __syncthreads();
        if (loc) {
#pragma unroll 4
            for (int e = 0; e < 16; ++e) { const float p = Sc[qi * SP + ch * 16 + e]; const int kc = c0 + e;
#pragma unroll
                for (int dd = 0; dd < 8; ++dd) acc[dd] += p * ks[kc * 65 + d0 + dd]; } }
        else {
#pragma unroll 4
            for (int kj = 0; kj < 64; ++kj) { const float p = Sc[qi * SP + nloc + cc * 64 + kj];
#pragma unroll
                for (int dd = 0; dd < 8; ++dd) acc[dd] += p * ks[kj * 65 + d0 + dd]; } }
    }
    v4u w; w.x = pk2(acc[0], acc[1]); w.y = pk2(acc[2], acc[3]); w.z = pk2(acc[4], acc[5]); w.w = pk2(acc[6], acc[7]);
    *(v4u*)(U + (size_t)(qrow0 + qi) * UA_W + UA_NA + h * 64 + d0) = w;
    __syncthreads();
}
__device__ __forceinline__ void p5_rw_readout(Frame& F, int li, int row_lo, int row_hi) {
    const int gw = F.wave, NGW = NWAVES, lane = F.lane;
    const bf16* FEAT = F.wsp<bf16>(WS_R1 + R1_FEAT); const bf16* Y = F.wsp<bf16>(WS_RB); bf16* U = F.wsp<bf16>(WS_R1);
    const int nrows = row_hi;
    if (lane >= 48) return;
    const int j0 = 8 * lane;
    float gg[8], gb[8], ka[8], rk[8];
#pragma unroll
    for (int e = 0; e < 8; ++e) { gg[e] = F.in[I_RWGNG][li * RW_W + j0 + e]; gb[e] = F.in[I_RWGNB][li * RW_W + j0 + e]; ka[e] = F.in[I_RWKA][li * RW_W + j0 + e]; rk[e] = F.in[I_RWRK][li * RW_W + j0 + e]; }
#pragma unroll 1
    for (int row0 = row_lo + gw; row0 < nrows; row0 += 2 * NGW) {
        v4u wy0[2], wy1[2], wr[2], wk[2], wv[2], wi0[2], wi1[2], wg[2];
#pragma unroll
        for (int u = 0; u < 2; ++u) { const int row = min(row0 + u * NGW, nrows - 1);
            wy0[u] = *(const v4u*)(Y + (size_t)row * RW_W + j0); wy1[u] = *(const v4u*)(Y + ((size_t)MT + row) * RW_W + j0);
            const bf16* fp = FEAT + (size_t)row * NFEAT * RW_W + j0;
            wr[u] = *(const v4u*)fp; wk[u] = *(const v4u*)(fp + RW_W); wv[u] = *(const v4u*)(fp + 2 * RW_W); wi0[u] = *(const v4u*)(fp + 5 * RW_W); wi1[u] = *(const v4u*)(fp + 6 * RW_W); wg[u] = *(const v4u*)(fp + 7 * RW_W); }
#pragma unroll
        for (int u = 0; u < 2; ++u) { const int row = row0 + u * NGW;
            float y0[8], y1[8], r[8], k[8], v[8], i0[8], i1[8], g[8];
            unpack8(wy0[u], y0); unpack8(wy1[u], y1); unpack8(wr[u], r); unpack8(wk[u], k); unpack8(wv[u], v); unpack8(wi0[u], i0); unpack8(wi1[u], i1); unpack8(wg[u], g);
            float sm = 0.f;
#pragma unroll
            for (int e = 0; e < 8; ++e) { y0[e] += y1[e]; sm += y0[e]; }
            sm += __shfl_xor(sm, 1); sm += __shfl_xor(sm, 2); sm += __shfl_xor(sm, 4);
            const float mu = sm * (1.f / 64.f); float sq = 0.f, bs = 0.f;
#pragma unroll
            for (int e = 0; e < 8; ++e) { y0[e] -= mu; sq += y0[e] * y0[e]; bs += r[e] * (k[e] * (2.0f + (i0[e] + i1[e] - 2.0f) * ka[e])) * rk[e]; }
            sq += __shfl_xor(sq, 1); sq += __shfl_xor(sq, 2); sq += __shfl_xor(sq, 4);
            bs += __shfl_xor(bs, 1); bs += __shfl_xor(bs, 2); bs += __shfl_xor(bs, 4);
            const float rs = 1.0f / sqrtf(sq * (1.f / 64.f) + RW_GN_EPS);
            float o[8];
#pragma unroll
            for (int e = 0; e < 8; ++e) o[e] = (y0[e] * rs * gg[e] + gb[e] + bs * v[e]) * g[e];
            if (row < nrows) *(v4u*)(U + (size_t)row * UA_W + j0) = pack8(o); }
    }
}

__device__ __forceinline__ void p8_norm2(Frame& F, int li, int dry) {
    const int gw = F.bid * NWAVES + F.wave, NGW = F.G * NWAVES, lane = F.lane;
    const float* g = F.in[I_N2G] + li * D;
    if (li == 0) {
        bf16* H2 = F.wsp<bf16>(WS_RA);
        for (int row = gw; row < MT; row += NGW) { const bool isl = row < NL; const int r9 = isl ? row >> 11 : 8;
            const float* xr = isl ? F.out + (size_t)row * D : F.wsp<float>(WS_CTXRES) + (size_t)(row - NL) * D; const float* md = F.mods(li, r9);
            f32x4 v[4]; norm_row(xr, g, md + 3 * D, md + 4 * D, lane, v); store_row_bf16(H2 + (size_t)row * D, lane, v); }
    } else {
        bf16* H2 = F.wsp<bf16>(WS_R1 + R1_H2U);
        int* rowtok = (int*)(F.ws + WS_MISC + MISC_ROWTOK);
        if (!dry) for (int i = F.bid * NTHREADS + F.tid; i < MOE_ROWS; i += F.G * NTHREADS) rowtok[i] = -1;
        unsigned* cnt = (unsigned*)(F.ws + WS_CTL) + CW_MOECNT;
        const float* router = F.in[I_MOER];
        int* sel = (int*)(F.ws + WS_MISC + MISC_SEL);
        for (int row = gw; row < NL; row += NGW) { const float* md = F.mods(li, row >> 11);
            f32x4 v[4]; norm_row(F.out + (size_t)row * D, g, md + 3 * D, md + 4 * D, lane, v);
            { unsigned* o4 = (unsigned*)((unsigned char*)H2 + (size_t)row * D) + lane;
#pragma unroll
              for (int j = 0; j < 4; ++j) o4[64 * j] = pk4_fp8(v[j].x, v[j].y, v[j].z, v[j].w); }
            float lg[8];
#pragma unroll
            for (int e = 0; e < 8; ++e) lg[e] = 0.f;
#pragma unroll
            for (int j = 0; j < 4; ++j) { const int k0 = 4 * lane + 256 * j;
#pragma unroll
                for (int q = 0; q < 4; ++q) { const f32x4 ra = ((const f32x4*)(router + (size_t)(k0 + q) * 8))[0], rb = ((const f32x4*)(router + (size_t)(k0 + q) * 8))[1]; const float x = v[j][q];
                    lg[0] += x * ra.x; lg[1] += x * ra.y; lg[2] += x * ra.z; lg[3] += x * ra.w; lg[4] += x * rb.x; lg[5] += x * rb.y; lg[6] += x * rb.z; lg[7] += x * rb.w; } }
#pragma unroll
            for (int e = 0; e < 8; ++e) lg[e] = wave_sum(lg[e]);
            int ea = 0; float la = lg[0];
#pragma unroll
            for (int e = 1; e < 8; ++e) if (lg[e] > la) { la = lg[e]; ea = e; }
            int eb = -1; float lb = -3.0e38f;
#pragma unroll
            for (int e = 0; e < 8; ++e) if (e != ea && lg[e] > lb) { lb = lg[e]; eb = e; }
            const float wa = 1.0f / (1.0f + __expf(lb - la)), wb = 1.0f - wa;
            if (lane == 0) { const unsigned inc = dry ? 0u : 1u; const unsigned ra = __hip_atomic_fetch_add(cnt + 64 * ea, inc, __ATOMIC_RELAXED, __HIP_MEMORY_SCOPE_AGENT), rb = __hip_atomic_fetch_add(cnt + 64 * eb, inc, __ATOMIC_RELAXED, __HIP_MEMORY_SCOPE_AGENT);
                if (!dry) {
                int* s = sel + (size_t)row * 8; s[0] = ea; s[1] = (int)ra; s[2] = __float_as_int(wa); s[3] = eb; s[4] = (int)rb; s[5] = __float_as_int(wb); } }
        }
    }
}
__device__ __forceinline__ void p8b_gather(Frame& F) {
    const int gw = F.bid * NWAVES + F.wave, NGW = F.G * NWAVES, lane = F.lane;
    const unsigned* cnt = (const unsigned*)(F.ws + WS_CTL) + CW_MOECNT;
    int off[8]; { int t = 0;
#pragma unroll
        for (int e = 0; e < 8; ++e) { off[e] = t * 256; t += (int)((__builtin_amdgcn_readfirstlane(cnt[64 * e]) + 255u) >> 8); } }
    const bf16* H2 = F.wsp<bf16>(WS_R1 + R1_H2U); bf16* AS = F.wsp<bf16>(WS_RA);
    int* rowtok = (int*)(F.ws + WS_MISC + MISC_ROWTOK); float* rowwgt = (float*)(F.ws + WS_MISC + MISC_ROWWGT);
    const int* sel = (const int*)(F.ws + WS_MISC + MISC_SEL);
    for (int row = gw; row < NL; row += NGW) { const int* s = sel + (size_t)row * 8;
        const int ea = s[0], ra = s[1], eb = s[3], rb = s[4];
        int oa = 0, ob = 0;
#pragma unroll
        for (int e = 0; e < 8; ++e) { oa = (e == ea) ? off[e] : oa; ob = (e == eb) ? off[e] : ob; }
        const int pa = oa + ra, pb = ob + rb;
        const v4u* src = (const v4u*)((const unsigned char*)H2 + (size_t)row * D); v4u* da = (v4u*)((unsigned char*)AS + (size_t)pa * D); v4u* db = (v4u*)((unsigned char*)AS + (size_t)pb * D);
        { const v4u w = src[lane]; da[lane] = w; db[lane] = w; }
        if (lane == 0) { rowtok[pa] = row; rowwgt[pa] = __int_as_float(s[2]); rowtok[pb] = row; rowwgt[pb] = __int_as_float(s[5]); }
    }
}

__device__ __forceinline__ void p11_moe_combine(Frame& F, int li, int dry) {
    const int gw = F.bid * NWAVES + F.wave, NGW = F.G * NWAVES, lane = F.lane;
    const unsigned* cnt = (const unsigned*)(F.ws + WS_CTL) + CW_MOECNT;
    int off[8]; { int t = 0;
#pragma unroll
        for (int e = 0; e < 8; ++e) { off[e] = t * 256; t += (int)((__builtin_amdgcn_readfirstlane(cnt[64 * e]) + 255u) >> 8); } }
    const bf16* YP = F.wsp<bf16>(WS_RA); const int* sel = (const int*)(F.ws + WS_MISC + MISC_SEL);
    for (int row = gw; row < NL; row += NGW) { const int* s = sel + (size_t)row * 8;
        const int ea = s[0], ra = s[1], eb = s[3], rb = s[4]; const float wa = dry ? 0.f : __int_as_float(s[2]), wb = dry ? 0.f : __int_as_float(s[5]);
        int oa = 0, ob = 0;
#pragma unroll
        for (int e = 0; e < 8; ++e) { oa = (e == ea) ? off[e] : oa; ob = (e == eb) ? off[e] : ob; }
        const v2u* ya = (const v2u*)(YP + (size_t)(oa + ra) * D) + lane; const v2u* yb = (const v2u*)(YP + (size_t)(ob + rb) * D) + lane;
        const float* gate = F.mods(li, row >> 11) + 5 * D; f32x4* op = (f32x4*)(F.out + (size_t)row * D) + lane;
#pragma unroll
        for (int j = 0; j < 4; ++j) { const v2u a = ya[64 * j], b = yb[64 * j]; const f32x4 g = ((const f32x4*)gate)[lane + 64 * j]; f32x4 x = op[64 * j];
            x.x += g.x * (wa * bflo(a.x) + wb * bflo(b.x)); x.y += g.y * (wa * bfhi(a.x) + wb * bfhi(b.x));
            x.z += g.z * (wa * bflo(a.y) + wb * bflo(b.y)); x.w += g.w * (wa * bfhi(a.y) + wb * bfhi(b.y));
            op[64 * j] = x; }
    }
}

constexpr int NCHUNK = 36, NCHAIN = 96;
constexpr size_t SCR_GH = WS_WM13;
constexpr size_t SZ_GHSLOT = 2 * 64 * 64 * 4;
constexpr size_t SCR_AW = SCR_GH + (size_t)NCHAIN * NCHUNK * SZ_GHSLOT;
constexpr size_t SZ_AWSLOT = 128 * 64 * 2;
static_assert(SCR_AW + (size_t)NCHAIN * NCHUNK * SZ_AWSLOT <= WS_CTXRES, "RWKV scratch fits in the MoE weight region");
constexpr int LDK = 72;
constexpr int LDF = 68;
constexpr int MATB = 64 * LDK * 2, MATF = 64 * LDF * 4;
typedef short bf16x8_t __attribute__((ext_vector_type(8)));

__device__ __forceinline__ int rw_row(int b, int d, int p) {
    if (p < LC) { const int t = d ? LC - 1 - p : p; return NL + b * LC + t; }
    const int q = p - LC, t = d ? SEQ - 1 - q : q; return b * SEQ + t;
}
__device__ __forceinline__ f32x4 rw_mma(const LAS bf16* A, const LAS bf16* Bt, int lane, f32x4 acc) {
    const int r = lane & 15, q = lane >> 4;
#pragma unroll
    for (int ks = 0; ks < 2; ++ks) { const bf16x8_t a = *(const LAS bf16x8_t*)(A + r * LDK + ks * 32 + q * 8); const bf16x8_t b = *(const LAS bf16x8_t*)(Bt + r * LDK + ks * 32 + q * 8);
        acc = __builtin_amdgcn_mfma_f32_16x16x32_bf16(a, b, acc, 0, 0, 0); }
    return acc;
}

template <int PH>
__device__ __forceinline__ void rw_stage(Frame& F, int li, int b, int h, int d, int c, LAS unsigned char* L, LAS float* ecum,
                                         LAS bf16* m0, LAS bf16* m1, LAS bf16* m2, LAS bf16* t0, LAS bf16* t1, LAS bf16* vt, LAS float* xa, LAS float* gC) {
    const int t = F.tid >> 3, d0 = (F.tid & 7) * 8;
    const int row = rw_row(b, d, c * 64 + t);
    const bf16* fp = F.wsp<bf16>(WS_R1 + R1_FEAT) + (size_t)row * NFEAT * RW_W + h * 64 + d0;
    float r[8], k[8], v[8], e[8], ic[8], kk[8];
    unpack8(*(const v4u*)(fp), r); unpack8(*(const v4u*)(fp + RW_W), k); unpack8(*(const v4u*)(fp + 2 * RW_W), v); unpack8(*(const v4u*)(fp + (3 + d) * RW_W), e); unpack8(*(const v4u*)(fp + (5 + d) * RW_W), ic);
    const float* kkp = F.in[I_RWKK] + li * RW_W + h * 64 + d0; const float* kap = F.in[I_RWKA] + li * RW_W + h * 64 + d0;
    float ss = 0.f;
#pragma unroll
    for (int j = 0; j < 8; ++j) { kk[j] = k[j] * kkp[j]; ss += kk[j] * kk[j]; }
    ss += __shfl_xor(ss, 1); ss += __shfl_xor(ss, 2); ss += __shfl_xor(ss, 4);
    const float inv = 1.0f / fmaxf(sqrtf(ss), 1e-12f);
    float cs[8];
#pragma unroll
    for (int j = 0; j < 8; ++j) { kk[j] *= inv; cs[j] = e[j]; }
#pragma unroll
    for (int off = 8; off < 64; off <<= 1) {
#pragma unroll
        for (int j = 0; j < 8; ++j) { const float u = __shfl_up(cs[j], off); if ((F.tid & 63) >= off) cs[j] += u; } }
    if (((F.tid & 63) >> 3) == 7) {
#pragma unroll
        for (int j = 0; j < 8; ++j) ecum[(F.tid >> 6) * 64 + d0 + j] = cs[j]; }
    __syncthreads();
#pragma unroll
    for (int wq = 0; wq < 7; ++wq) { if (wq < (F.tid >> 6)) { const f32x4 o0 = *(const LAS f32x4*)(ecum + wq * 64 + d0), o1 = *(const LAS f32x4*)(ecum + wq * 64 + d0 + 4);
        cs[0] += o0.x; cs[1] += o0.y; cs[2] += o0.z; cs[3] += o0.w; cs[4] += o1.x; cs[5] += o1.y; cs[6] += o1.z; cs[7] += o1.w; } }
    float at[8], bt[8], kt[8], rt[8];
#pragma unroll
    for (int j = 0; j < 8; ++j) { const float cv = cs[j]; const float g = __expf(-cv), gi = __expf(cv), gp = __expf(e[j] - cv);
        at[j] = -kk[j] * gp; bt[j] = kk[j] * ic[j] * gi; kt[j] = k[j] * (1.0f + (ic[j] - 1.0f) * kap[j]) * gi; rt[j] = r[j] * g;
        if (PH == 0 && t == 63) gC[d0 + j] = g; }
    if (PH == 0) {
        *(LAS v4u*)(m0 + t * LDK + d0) = pack8(at); *(LAS v4u*)(m1 + t * LDK + d0) = pack8(bt); *(LAS v4u*)(m2 + t * LDK + d0) = pack8(kt);
#pragma unroll
        for (int j = 0; j < 8; ++j) { t0[(d0 + j) * LDK + t] = (bf16)f2bf(bt[j]); t1[(d0 + j) * LDK + t] = (bf16)f2bf(kt[j]); vt[(d0 + j) * LDK + t] = (bf16)f2bf(v[j]); xa[(d0 + j) * LDF + t] = at[j]; }
    } else {
        *(LAS v4u*)(m0 + t * LDK + d0) = pack8(bt); *(LAS v4u*)(m1 + t * LDK + d0) = pack8(kt); *(LAS v4u*)(m2 + t * LDK + d0) = pack8(rt);
#pragma unroll
        for (int j = 0; j < 8; ++j) vt[(d0 + j) * LDK + t] = (bf16)f2bf(v[j]);
    }
}

__device__ __forceinline__ void rw_phaseA_job(Frame& F, int li, int chain, int c) {
    const int b = chain / 12, h = (chain % 12) >> 1, d = chain & 1, lane = F.lane, w = F.wave;
    LAS unsigned char* L = F.lds;
    LAS bf16* At = (LAS bf16*)(L + 0 * MATB); LAS bf16* Bt = (LAS bf16*)(L + 1 * MATB); LAS bf16* Kt = (LAS bf16*)(L + 2 * MATB);
    LAS bf16* BtT = (LAS bf16*)(L + 3 * MATB); LAS bf16* KtT = (LAS bf16*)(L + 4 * MATB); LAS bf16* VT = (LAS bf16*)(L + 5 * MATB); LAS bf16* NakT = (LAS bf16*)(L + 6 * MATB);
    LAS bf16* AW = (LAS bf16*)(L + 7 * MATB);
    LAS float* Nab = (LAS float*)(L + 9 * MATB);
    LAS float* X = (LAS float*)(L + 9 * MATB + MATF);
    LAS float* gC = (LAS float*)(L + 9 * MATB + 3 * MATF);
    LAS float* MinvB = gC + 64;
    __syncthreads();
    rw_stage<0>(F, li, b, h, d, c, L, Nab, At, Bt, Kt, BtT, KtT, VT, X, gC);
    __syncthreads();
    const int tr = w >> 1, tcb = (w & 1) * 2, q = lane >> 4, rr = lane & 15;
    f32x4 nab[2], nak[2];
#pragma unroll
    for (int i = 0; i < 2; ++i) { const f32x4 z = {0.f, 0.f, 0.f, 0.f}; nab[i] = rw_mma(Bt + tr * 16 * LDK, At + (tcb + i) * 16 * LDK, lane, z); nak[i] = rw_mma(Kt + tr * 16 * LDK, At + (tcb + i) * 16 * LDK, lane, z); }
    __syncthreads();
#pragma unroll
    for (int i = 0; i < 2; ++i)
#pragma unroll
        for (int g = 0; g < 4; ++g) { const int s = tr * 16 + q * 4 + g, t = (tcb + i) * 16 + rr; const bool keep = s < t;
            Nab[s * LDF + t] = keep ? nab[i][g] : 0.f; NakT[t * LDK + s] = (bf16)f2bf(keep ? nak[i][g] : 0.f); }
    __syncthreads();
#pragma unroll
    for (int i = 0; i < 2; ++i) { const f32x4 z = {0.f, 0.f, 0.f, 0.f}; const f32x4 o = rw_mma(VT + tr * 16 * LDK, NakT + (tcb + i) * 16 * LDK, lane, z);
#pragma unroll
        for (int g = 0; g < 4; ++g) X[(64 + tr * 16 + q * 4 + g) * LDF + (tcb + i) * 16 + rr] = o[g]; }
    if (F.tid < 64) { const int blk = F.tid >> 4, i = F.tid & 15; float m[16];
#pragma unroll
        for (int t = 0; t < 16; ++t) { float a = (t == i) ? 1.f : 0.f;
#pragma unroll
            for (int s = 0; s < 16; ++s) if (s < t) a += m[s] * Nab[(16 * blk + s) * LDF + 16 * blk + t];
            m[t] = a; }
#pragma unroll
        for (int t = 0; t < 16; ++t) MinvB[(blk * 16 + i) * 16 + t] = m[t]; }
    __syncthreads();
#define RW_QB(v_, c_) __builtin_bit_cast(float, __builtin_amdgcn_update_dpp(0, __builtin_bit_cast(int, (v_)), (c_), 0xf, 0xf, false))
    { const int row = F.tid >> 2, cq = (F.tid & 3) * 4; bf16* gslot = (bf16*)(F.ws + SCR_AW + (size_t)(chain * NCHUNK + c) * SZ_AWSLOT);
      float xall[64];
#pragma unroll
      for (int jb = 0; jb < 4; ++jb) {
          f32x4 x4 = *(const LAS f32x4*)(X + row * LDF + 16 * jb + cq);
          if (jb > 0) { f32x4 acc = {0.f, 0.f, 0.f, 0.f};
#pragma unroll
              for (int s = 0; s < 16 * jb; ++s) { const f32x4 n4 = *(const LAS f32x4*)(Nab + s * LDF + 16 * jb + cq); acc += xall[s] * n4; }
              x4 += acc; }
          float xr[16];
#pragma unroll
          for (int e = 0; e < 4; ++e) { const float xe = x4[e];
              xr[e] = RW_QB(xe, 0x00); xr[4 + e] = RW_QB(xe, 0x55); xr[8 + e] = RW_QB(xe, 0xAA); xr[12 + e] = RW_QB(xe, 0xFF); }
          f32x4 o = {0.f, 0.f, 0.f, 0.f};
#pragma unroll
          for (int s = 0; s < 16; ++s) { const f32x4 m4 = *(const LAS f32x4*)(MinvB + (jb * 16 + s) * 16 + cq); o += xr[s] * m4; }
#pragma unroll
          for (int e = 0; e < 4; ++e) { const float oe = o[e]; xall[16 * jb + e] = RW_QB(oe, 0x00); xall[16 * jb + 4 + e] = RW_QB(oe, 0x55); xall[16 * jb + 8 + e] = RW_QB(oe, 0xAA); xall[16 * jb + 12 + e] = RW_QB(oe, 0xFF); }
          const v2u pw = {pk2(o[0], o[1]), pk2(o[2], o[3])};
          *(LAS v2u*)(AW + row * LDK + 16 * jb + cq) = pw; *(v2u*)(gslot + row * 64 + 16 * jb + cq) = pw;
      } }
#undef RW_QB
    __syncthreads();
    { float* gh = (float*)(F.ws + SCR_GH + (size_t)(chain * NCHUNK + c) * SZ_GHSLOT);
#pragma unroll
      for (int i = 0; i < 2; ++i) { const f32x4 z = {0.f, 0.f, 0.f, 0.f};
          const f32x4 gg = rw_mma(AW + tr * 16 * LDK, BtT + (tcb + i) * 16 * LDK, lane, z);
          f32x4 hh = rw_mma(AW + (64 + tr * 16) * LDK, BtT + (tcb + i) * 16 * LDK, lane, z); hh = rw_mma(VT + tr * 16 * LDK, KtT + (tcb + i) * 16 * LDK, lane, hh);
          const int kc = (tcb + i) * 16 + rr; const float gk = gC[kc];
#pragma unroll
          for (int g = 0; g < 4; ++g) { const int j = tr * 16 + q * 4 + g; gh[j * 64 + kc] = gg[g] * gk + (j == kc ? gk : 0.f); gh[4096 + j * 64 + kc] = hh[g] * gk; } } }
}

__device__ __forceinline__ void rw_phaseB_chain(Frame& F, int chain, int dry) {
    LAS float* Ss = (LAS float*)F.lds;
    LAS float* Gs = Ss + 64 * LDF;
    const int v = F.tid >> 3, k0 = (F.tid & 7) * 8;
    const unsigned char* base = F.ws + SCR_GH + (size_t)chain * NCHUNK * SZ_GHSLOT;
    f32x4 sp0 = {0.f, 0.f, 0.f, 0.f}, sp1 = sp0;
    __syncthreads();
    *(LAS f32x4*)(Ss + v * LDF + k0) = sp0; *(LAS f32x4*)(Ss + v * LDF + k0 + 4) = sp1;
    f32x4 g0[2], g1[2], h0[2], h1[2];
#pragma unroll
    for (int p = 0; p < 2; ++p) { const float* gh = (const float*)(base + (size_t)p * SZ_GHSLOT);
        g0[p] = *(const f32x4*)(gh + v * 64 + k0); g1[p] = *(const f32x4*)(gh + v * 64 + k0 + 4); h0[p] = *(const f32x4*)(gh + 4096 + v * 64 + k0); h1[p] = *(const f32x4*)(gh + 4096 + v * 64 + k0 + 4); }
#pragma unroll 1
    for (int c2 = 0; c2 < NCHUNK; c2 += 2) {
#pragma unroll
        for (int p = 0; p < 2; ++p) { const int c = c2 + p;
            const f32x4 gc0 = g0[p], gc1 = g1[p]; f32x4 a0 = h0[p], a1 = h1[p];
            asm volatile("" ::: "memory");
            __syncthreads();
            *(LAS f32x4*)(Gs + v * LDF + k0) = gc0; *(LAS f32x4*)(Gs + v * LDF + k0 + 4) = gc1;
            *(LAS f32x4*)(Ss + v * LDF + k0) = sp0; *(LAS f32x4*)(Ss + v * LDF + k0 + 4) = sp1;
            if (c >= 1 && !dry) { float x[8] = {sp0.x, sp0.y, sp0.z, sp0.w, sp1.x, sp1.y, sp1.z, sp1.w}; *(v4u*)((bf16*)(base + (size_t)(c - 1) * SZ_GHSLOT) + v * 64 + k0) = pack8(x); }
            if (c + 2 < NCHUNK) { const float* gh = (const float*)(base + (size_t)(c + 2) * SZ_GHSLOT);
                g0[p] = *(const f32x4*)(gh + v * 64 + k0); g1[p] = *(const f32x4*)(gh + v * 64 + k0 + 4); h0[p] = *(const f32x4*)(gh + 4096 + v * 64 + k0); h1[p] = *(const f32x4*)(gh + 4096 + v * 64 + k0 + 4); }
            __syncthreads();
#pragma unroll 8
            for (int j = 0; j < 64; ++j) { const float s = Ss[v * LDF + j]; const f32x4 ga = *(const LAS f32x4*)(Gs + j * LDF + k0), gb = *(const LAS f32x4*)(Gs + j * LDF + k0 + 4); a0 += s * ga; a1 += s * gb; }
            sp0 = a0; sp1 = a1; }
    }
    __syncthreads();
}

__device__ __forceinline__ void rw_phaseC_job(Frame& F, int li, int chain, int c, int dry) {
    const int b = chain / 12, h = (chain % 12) >> 1, d = chain & 1, lane = F.lane, w = F.wave;
    LAS unsigned char* L = F.lds;
    LAS bf16* Bt = (LAS bf16*)(L + 0 * MATB); LAS bf16* Kt = (LAS bf16*)(L + 1 * MATB); LAS bf16* Rt = (LAS bf16*)(L + 2 * MATB); LAS bf16* VT = (LAS bf16*)(L + 3 * MATB);
    LAS bf16* NrbT = (LAS bf16*)(L + 4 * MATB); LAS bf16* NrkT = (LAS bf16*)(L + 5 * MATB); LAS bf16* QT = (LAS bf16*)(L + 6 * MATB); LAS bf16* AW = (LAS bf16*)(L + 7 * MATB);
    LAS float* ecum = (LAS float*)(L + 9 * MATB); LAS bf16* Sb = (LAS bf16*)(L + 9 * MATB + MATF); LAS float* Yt = (LAS float*)(L + 10 * MATB + MATF);
    __syncthreads();
    rw_stage<1>(F, li, b, h, d, c, L, ecum, Bt, Kt, Rt, nullptr, nullptr, VT, nullptr, nullptr);
    { const bf16* gslot = (const bf16*)(F.ws + SCR_AW + (size_t)(chain * NCHUNK + c) * SZ_AWSLOT);
      const int row = F.tid >> 2, c0 = (F.tid & 3) * 16;
      *(LAS v4u*)(AW + row * LDK + c0) = *(const v4u*)(gslot + row * 64 + c0); *(LAS v4u*)(AW + row * LDK + c0 + 8) = *(const v4u*)(gslot + row * 64 + c0 + 8);
      const bf16* sg = (const bf16*)(F.ws + SCR_GH + (size_t)(chain * NCHUNK + (c > 0 ? c - 1 : 0)) * SZ_GHSLOT);
      const int v = F.tid >> 3, k0 = (F.tid & 7) * 8; v4u sw = *(const v4u*)(sg + v * 64 + k0); if (c == 0) sw = (v4u){0u, 0u, 0u, 0u}; *(LAS v4u*)(Sb + v * LDK + k0) = sw; }
    __syncthreads();
    const int tr = w >> 1, tcb = (w & 1) * 2, q = lane >> 4, rr = lane & 15;
#pragma unroll
    for (int i = 0; i < 2; ++i) { const f32x4 z = {0.f, 0.f, 0.f, 0.f}; const f32x4 nb = rw_mma(Bt + tr * 16 * LDK, Rt + (tcb + i) * 16 * LDK, lane, z), nk = rw_mma(Kt + tr * 16 * LDK, Rt + (tcb + i) * 16 * LDK, lane, z);
#pragma unroll
        for (int g = 0; g < 4; ++g) { const int s = tr * 16 + q * 4 + g, t = (tcb + i) * 16 + rr; const bool keep = s <= t;
            NrbT[t * LDK + s] = (bf16)f2bf(keep ? nb[g] : 0.f); NrkT[t * LDK + s] = (bf16)f2bf(keep ? nk[g] : 0.f); } }
    __syncthreads();
#pragma unroll
    for (int i = 0; i < 2; ++i) { const f32x4 z = {0.f, 0.f, 0.f, 0.f}; const f32x4 o = rw_mma(AW + tr * 16 * LDK, NrbT + (tcb + i) * 16 * LDK, lane, z);
#pragma unroll
        for (int g = 0; g < 4; ++g) { const int k = tr * 16 + q * 4 + g, t = (tcb + i) * 16 + rr; QT[t * LDK + k] = (bf16)f2bf(o[g] + bf2f(Rt[t * LDK + k])); } }
    __syncthreads();
#pragma unroll
    for (int i = 0; i < 2; ++i) { f32x4 o = {0.f, 0.f, 0.f, 0.f};
        o = rw_mma(Sb + tr * 16 * LDK, QT + (tcb + i) * 16 * LDK, lane, o); o = rw_mma(AW + (64 + tr * 16) * LDK, NrbT + (tcb + i) * 16 * LDK, lane, o); o = rw_mma(VT + tr * 16 * LDK, NrkT + (tcb + i) * 16 * LDK, lane, o);
#pragma unroll
        for (int g = 0; g < 4; ++g) Yt[((tcb + i) * 16 + rr) * LDF + tr * 16 + q * 4 + g] = o[g]; }
    __syncthreads();
    { const int t = F.tid >> 3, d0 = (F.tid & 7) * 8; const int row = rw_row(b, d, c * 64 + t); bf16* yp = F.wsp<bf16>(WS_RB) + ((size_t)d * MT + row) * RW_W + h * 64 + d0;
      float x[8];
#pragma unroll
      for (int j = 0; j < 8; ++j) x[j] = Yt[t * LDF + d0 + j];
      *(v4u*)yp = pack8(x); (void)dry; }
}


constexpr int P3_AS = 392;
constexpr int P3_WAVE_LDS = 16 * P3_AS * 2;
constexpr int P3_ROWS = 72;
__device__ __forceinline__ void p3_job(Frame& F, int li, int job) {
    const int lane = F.lane, r = lane & 15, g = lane >> 4;
    const int row0 = job * P3_ROWS;
    const bf16* U = F.wsp<bf16>(WS_R1); bf16* FEAT = F.wsp<bf16>(WS_R1 + R1_FEAT);
    LAS bf16* Ain = (LAS bf16*)F.lds;
    const float* mu0 = F.in[I_RWSHIFT] + (size_t)li * 2 * RW_IN; const float* mu1 = mu0 + RW_IN;
    const float* rope = F.wsp<float>(WS_MISC + MISC_ROPE);
    __syncthreads();
    for (int i = F.tid; i < 8 * P3_AS / 8; i += NTHREADS) *(LAS v4u*)(Ain + 72 * P3_AS + 8 * i) = (v4u){0u, 0u, 0u, 0u};
#pragma unroll 1
    for (int it = 0; it < 3; ++it) {
        const int idx = F.tid + NTHREADS * it, slot = idx % 192, run = idx / 192;
        int c1, c2, kindv;
        int fsel = 0, ocol1 = 0, half = 0, p = 0;
        if (slot < 96) { const int tensor = slot / 48, hd = (slot % 48) >> 3, sub = slot & 7; half = sub >> 2; p = (sub & 3) * 4; c1 = tensor * RW_W + hd * 64 + half * 32 + p; c2 = c1 + 16; kindv = 0; fsel = tensor; ocol1 = hd * 64 + half * 32 + p; }
        else if (slot < 144) { c1 = 2 * RW_W + (slot - 96) * 8; c2 = c1 + 4; kindv = 1; fsel = 2; ocol1 = (slot - 96) * 8; }
        else { c1 = 3 * RW_W + (slot - 144) * 8; c2 = c1 + 4; kindv = 2; ocol1 = (slot - 144) * 8; }
        float m0a[4], m0b[4], m1a[4], m1b[4];
#pragma unroll
        for (int e = 0; e < 4; ++e) { m0a[e] = mu0[c1 + e]; m0b[e] = mu0[c2 + e]; m1a[e] = mu1[c1 + e]; m1b[e] = mu1[c2 + e]; }
        v2u ra[11], rb[11];
#pragma unroll
        for (int i = 0; i < 11; ++i) { const int rw = min(max(row0 + 9 * run - 1 + i, 0), MT - 1); const bf16* up = U + (size_t)rw * UA_W; ra[i] = *(const v2u*)(up + c1); rb[i] = *(const v2u*)(up + c2); }
#pragma unroll
        for (int t9 = 0; t9 < 9; ++t9) { const int tt = 9 * run + t9, row = row0 + tt;
            const bool isl = row < NL; const int t = isl ? (row & (SEQ - 1)) : ((row - NL) & (LC - 1)); const int n = isl ? SEQ : LC;
            const bool hp = t > 0, hn = t < n - 1;
            float xa[4], xb[4];
            { const v2u pa = ra[t9], ca = ra[t9 + 1], na = ra[t9 + 2], pb2 = rb[t9], cb = rb[t9 + 1], nb = rb[t9 + 2];
              const float pav[4] = {bflo(pa.x), bfhi(pa.x), bflo(pa.y), bfhi(pa.y)}, cav[4] = {bflo(ca.x), bfhi(ca.x), bflo(ca.y), bfhi(ca.y)}, nav[4] = {bflo(na.x), bfhi(na.x), bflo(na.y), bfhi(na.y)};
              const float pbv[4] = {bflo(pb2.x), bfhi(pb2.x), bflo(pb2.y), bfhi(pb2.y)}, cbv[4] = {bflo(cb.x), bfhi(cb.x), bflo(cb.y), bfhi(cb.y)}, nbv[4] = {bflo(nb.x), bfhi(nb.x), bflo(nb.y), bfhi(nb.y)};
#pragma unroll
              for (int e = 0; e < 4; ++e) { const float pva = hp ? pav[e] : 0.f, nva = hn ? nav[e] : 0.f, pvb = hp ? pbv[e] : 0.f, nvb = hn ? nbv[e] : 0.f;
                  xa[e] = cav[e] + m0a[e] * (pva - cav[e]) + m1a[e] * (nva - cav[e]); xb[e] = cbv[e] + m0b[e] * (pvb - cbv[e]) + m1b[e] * (nvb - cbv[e]); } }
            if (kindv == 0) {
                float o1[4], o2[4];
                if (isl) { const int pos = half == 0 ? (t >> 6) : (t & 63); const float* rp = rope + (pos * 16 + p) * 2;
#pragma unroll
                    for (int e = 0; e < 4; ++e) { const float cs = rp[2 * e], sn = rp[2 * e + 1]; o1[e] = xa[e] * cs - xb[e] * sn; o2[e] = xa[e] * sn + xb[e] * cs; } }
                else {
#pragma unroll
                    for (int e = 0; e < 4; ++e) { o1[e] = xa[e]; o2[e] = xb[e]; } }
                bf16* fo = FEAT + ((size_t)row * NFEAT + fsel) * RW_W + ocol1;
                *(v2u*)fo = (v2u){pk2(o1[0], o1[1]), pk2(o1[2], o1[3])}; *(v2u*)(fo + 16) = (v2u){pk2(o2[0], o2[1]), pk2(o2[2], o2[3])};
            } else if (kindv == 1) {
                bf16* fo = FEAT + ((size_t)row * NFEAT + 2) * RW_W + ocol1;
                *(v4u*)fo = (v4u){pk2(xa[0], xa[1]), pk2(xa[2], xa[3]), pk2(xb[0], xb[1]), pk2(xb[2], xb[3])};
            } else {
                const int lc = ocol1;
#pragma unroll
                for (int e = 0; e < 4; ++e) { if (lc < 128) { xa[e] = tanhf(xa[e]); xb[e] = tanhf(xb[e]); } else if (lc >= 256) { xa[e] = sigmoidf_(xa[e]); xb[e] = sigmoidf_(xb[e]); } }
                *(LAS v4u*)(Ain + tt * P3_AS + lc) = (v4u){pk2(xa[0], xa[1]), pk2(xa[2], xa[3]), pk2(xb[0], xb[1]), pk2(xb[2], xb[3])};
            }
        }
    }
    __syncthreads();
    const bf16* RWT = F.wsp<bf16>(WS_MISC + MISC_RWT) + (size_t)li * RWT_PER_LAYER;
#pragma unroll 1
    for (int q3 = 0; q3 < 3; ++q3) { const int nt = 3 * F.wave + q3, nc = nt * 16 + r;
        v4u wc[12];
#pragma unroll
        for (int pr = 0; pr < 4; ++pr) { const bf16* wt = RWT + (size_t)pr * 384 * 64 + (size_t)nc * 64 + 8 * g; wc[2 * pr] = *(const v4u*)wt; wc[2 * pr + 1] = *(const v4u*)(wt + 32); }
        { const bf16* wt = RWT + RWT_G2 + (size_t)nc * 128 + 8 * g;
#pragma unroll
          for (int ks = 0; ks < 4; ++ks) wc[8 + ks] = *(const v4u*)(wt + 32 * ks); }
        const int nc0 = nt * 16 + 4 * g;
        const f32x4 w00 = *(const f32x4*)(F.in[I_RWW0] + (li * 2 + 0) * RW_W + nc0), w01 = *(const f32x4*)(F.in[I_RWW0] + (li * 2 + 1) * RW_W + nc0);
        const f32x4 a00 = *(const f32x4*)(F.in[I_RWA0] + (li * 2 + 0) * RW_W + nc0), a01 = *(const f32x4*)(F.in[I_RWA0] + (li * 2 + 1) * RW_W + nc0);
#pragma unroll 1
        for (int mt = 0; mt < 5; ++mt) {
            f32x4 acc[5];
#pragma unroll
            for (int pr = 0; pr < 5; ++pr) acc[pr] = (f32x4){0.f, 0.f, 0.f, 0.f};
            const LAS bf16* ap = Ain + (mt * 16 + r) * P3_AS + 8 * g;
#pragma unroll
            for (int pr = 0; pr < 4; ++pr)
#pragma unroll
                for (int ks = 0; ks < 2; ++ks) acc[pr] = __builtin_amdgcn_mfma_f32_16x16x32_bf16(__builtin_bit_cast(bf16x8_t, wc[2 * pr + ks]), *(const LAS bf16x8_t*)(ap + 32 * (2 * pr + ks)), acc[pr], 0, 0, 0);
#pragma unroll
            for (int ks = 0; ks < 4; ++ks) acc[4] = __builtin_amdgcn_mfma_f32_16x16x32_bf16(__builtin_bit_cast(bf16x8_t, wc[8 + ks]), *(const LAS bf16x8_t*)(ap + 32 * (8 + ks)), acc[4], 0, 0, 0);
            const int tt = mt * 16 + r;
            if (tt < P3_ROWS) { bf16* fo = FEAT + (size_t)(row0 + tt) * NFEAT * RW_W + nc0; float o[4];
#pragma unroll
                for (int e = 0; e < 4; ++e) o[e] = 0.6065306597126334f * sigmoidf_(acc[0][e] + w00[e]);
                *(v2u*)(fo + 3 * RW_W) = (v2u){pk2(o[0], o[1]), pk2(o[2], o[3])};
#pragma unroll
                for (int e = 0; e < 4; ++e) o[e] = 0.6065306597126334f * sigmoidf_(acc[1][e] + w01[e]);
                *(v2u*)(fo + 4 * RW_W) = (v2u){pk2(o[0], o[1]), pk2(o[2], o[3])};
#pragma unroll
                for (int e = 0; e < 4; ++e) o[e] = sigmoidf_(acc[2][e] + a00[e]);
                *(v2u*)(fo + 5 * RW_W) = (v2u){pk2(o[0], o[1]), pk2(o[2], o[3])};
#pragma unroll
                for (int e = 0; e < 4; ++e) o[e] = sigmoidf_(acc[3][e] + a01[e]);
                *(v2u*)(fo + 6 * RW_W) = (v2u){pk2(o[0], o[1]), pk2(o[2], o[3])};
                *(v2u*)(fo + 7 * RW_W) = (v2u){pk2(acc[4][0], acc[4][1]), pk2(acc[4][2], acc[4][3])}; }
        }
    }
}
__device__ __forceinline__ void p3_rw_features(Frame& F, int li) {
#pragma unroll 1
    for (int job = F.bid; job < MT / P3_ROWS; job += F.G) p3_job(F, li, job);
    __syncthreads();
}

typedef float f32x16 __attribute__((ext_vector_type(16)));
constexpr int HY_ZS = 72;
__device__ __forceinline__ void hy_job_mfma(Frame& F, int li, int seg, int c, int dry) {
    const int n = seg ? LC : SEQ, nI = n >> 6, lane = F.lane, b = F.wave;
    bf16* U = F.wsp<bf16>(WS_R1);
    LAS unsigned char* L = F.lds;
    const int cstride = 2 * n + 16;
    LAS bf16* frev8 = (LAS bf16*)L;
    constexpr int FREV_BYTES = 8 * (2 * SEQ + 16) * 2;
    constexpr int Z_BYTES = 8 * 32 * HY_ZS * 2;
    LAS bf16* zin = (LAS bf16*)(L + FREV_BYTES); LAS bf16* zout = (LAS bf16*)(L + FREV_BYTES + Z_BYTES);
    LAS bf16* xg = (LAS bf16*)L;
    static_assert(FREV_BYTES + 2 * Z_BYTES <= LDS_CTL_OFF, "hyena LDS map");
    const float* cw = F.in[I_HYCW] + (size_t)li * 3 * HY_IN; const float* cbv = F.in[I_HYCB] + (size_t)li * HY_IN;
    __syncthreads();
#define HY_STAGE_RAW(dst_, col_, tid_) do { const int s_ = (col_) >> 8, c_ = (col_) & 255; _Pragma("unroll 1") for (int v0_ = (tid_); v0_ < 8 * nI * 8; v0_ += 4 * NTHREADS) { v4u rv_[4]; \
        _Pragma("unroll") for (int k_ = 0; k_ < 4; ++k_) { const int vec_ = v0_ + k_ * NTHREADS; rv_[k_] = (v4u){0u, 0u, 0u, 0u}; if (vec_ < 8 * nI * 8) { const int bb_ = vec_ / (nI * 8), I_ = (vec_ >> 3) % nI, p_ = vec_ & 7; \
            rv_[k_] = *(const v4u*)(U + (size_t)((seg ? NL + bb_ * LC : bb_ * SEQ) + 64 * I_ + (c_ >> 2)) * UA_W + UA_HY + s_ * 256 + (c_ & 3) * 64 + 8 * p_); } } \
        _Pragma("unroll") for (int k_ = 0; k_ < 4; ++k_) { const int vec_ = v0_ + k_ * NTHREADS; if (vec_ < 8 * nI * 8) { const int bb_ = vec_ / (nI * 8), I_ = (vec_ >> 3) % nI, p_ = vec_ & 7; *(LAS v4u*)((dst_) + (bb_ * nI + I_) * HY_ZS + 8 * p_) = rv_[k_]; } } } } while (0)
#define HY_CONV(raw_, bb_, t_, col_) (cbv[col_] + cw[col_] * ((t_) > 0 ? bf2f((raw_)[((bb_) * nI + (((t_) - 1) >> 6)) * HY_ZS + (((t_) - 1) & 63)]) : 0.f) \
        + cw[HY_IN + (col_)] * bf2f((raw_)[((bb_) * nI + ((t_) >> 6)) * HY_ZS + ((t_) & 63)]) + cw[2 * HY_IN + (col_)] * ((t_) < n - 1 ? bf2f((raw_)[((bb_) * nI + (((t_) + 1) >> 6)) * HY_ZS + (((t_) + 1) & 63)]) : 0.f))
    HY_STAGE_RAW(zout, c, F.tid);
    __syncthreads();
#pragma unroll 1
    for (int idx = F.tid; idx < 8 * n; idx += NTHREADS) { const int bb = idx / n, t = idx - bb * n;
        zin[(bb * nI + (t >> 6)) * HY_ZS + (t & 63)] = (bf16)f2bf(HY_CONV(zout, bb, t, c)); }
#pragma unroll 1
    for (int o = 0; o < 2; ++o) {
        const bf16* fsrc = seg ? F.wsp<bf16>(WS_FILTC) + (size_t)(o * 256 + c) * 512 : F.wsp<bf16>(WS_FILT) + (size_t)((li * 2 + o) * 256 + c) * 4096;
        __syncthreads();
        int tid_o = F.tid; asm volatile("" : "+v"(tid_o));
#pragma unroll 1
        for (int m = tid_o; m < 2 * n / 8; m += NTHREADS) { float x[8];
#pragma unroll
            for (int e = 0; e < 8; ++e) { const int y = 8 * m + e; x[e] = y == 0 ? 0.f : bf2f(fsrc[2 * n - y]); }
            *(LAS v4u*)(frev8 + 8 * m) = pack8(x); }
        __syncthreads();
        if (b >= 1) { const int rho = b, q = rho >> 1; const bool odd = rho & 1; LAS bf16* dst = frev8 + rho * cstride;
#pragma unroll 1
            for (int m = (tid_o & 63); m < 2 * n / 8; m += 64) { const v4u lo = *(const LAS v4u*)(frev8 + 8 * m); v4u hi = {0u, 0u, 0u, 0u}; if (m + 1 < 2 * n / 8) hi = *(const LAS v4u*)(frev8 + 8 * m + 8);
                unsigned a0, a1, a2, a3, a4;
                if (q == 0) { a0 = lo.x; a1 = lo.y; a2 = lo.z; a3 = lo.w; a4 = hi.x; } else if (q == 1) { a0 = lo.y; a1 = lo.z; a2 = lo.w; a3 = hi.x; a4 = hi.y; }
                else if (q == 2) { a0 = lo.z; a1 = lo.w; a2 = hi.x; a3 = hi.y; a4 = hi.z; } else { a0 = lo.w; a1 = hi.x; a2 = hi.y; a3 = hi.z; a4 = hi.w; }
                v4u ov; if (odd) { ov.x = (a0 >> 16) | (a1 << 16); ov.y = (a1 >> 16) | (a2 << 16); ov.z = (a2 >> 16) | (a3 << 16); ov.w = (a3 >> 16) | (a4 << 16); } else { ov.x = a0; ov.y = a1; ov.z = a2; ov.w = a3; }
                *(LAS v4u*)(dst + 8 * m) = ov; } }
        __syncthreads();
        f32x16 acc0, acc1;
#pragma unroll
        for (int r = 0; r < 16; ++r) { acc0[r] = 0.f; acc1[r] = 0.f; }
        { const int I = tid_o & 31, hh = (tid_o >> 5) & 1;
#pragma unroll 1
          for (int Dd = -(nI - 1); Dd <= nI - 1; ++Dd) { const int J = I - Dd; const bool valid = (I < nI) && (J >= 0) && (J < nI);
              const LAS bf16* zrow = zin + (b * nI + (valid ? J : 0)) * HY_ZS + 8 * hh;
              const int ybase = n - 64 * Dd - I + 8 * hh;
#pragma unroll
              for (int ks = 0; ks < 4; ++ks) {
                  v4u bw = *(const LAS v4u*)(zrow + 16 * ks); if (!valid) bw = (v4u){0u, 0u, 0u, 0u};
                  const int y0 = ybase + 16 * ks, y1 = y0 - 32;
                  const v4u aw0 = *(const LAS v4u*)(frev8 + (y0 & 7) * cstride + (y0 & ~7)); const v4u aw1 = *(const LAS v4u*)(frev8 + (y1 & 7) * cstride + (y1 & ~7));
                  acc0 = __builtin_amdgcn_mfma_f32_32x32x16_bf16(__builtin_bit_cast(bf16x8_t, aw0), __builtin_bit_cast(bf16x8_t, bw), acc0, 0, 0, 0);
                  acc1 = __builtin_amdgcn_mfma_f32_32x32x16_bf16(__builtin_bit_cast(bf16x8_t, aw1), __builtin_bit_cast(bf16x8_t, bw), acc1, 0, 0, 0);
              } } }
        __syncthreads();
        const int xcol = (o + 1) * HY_W + c;
        HY_STAGE_RAW(xg, xcol, tid_o);
        __syncthreads();
        { const int I = tid_o & 31, hh = (tid_o >> 5) & 1; const float skip = F.in[I_HYSKIP][(li * 2 + o) * HY_W + c]; const int rowbase = seg ? NL + b * LC : b * SEQ;
          if (I < nI) {
#pragma unroll
              for (int ti = 0; ti < 2; ++ti)
#pragma unroll
                  for (int r = 0; r < 16; ++r) { const int i = 32 * ti + (r & 3) + 8 * (r >> 2) + 4 * hh; const int idx = (b * nI + I) * HY_ZS + i;
                      const float a = ti == 0 ? acc0[r] : acc1[r]; const int tq = 64 * I + i; const float zn = HY_CONV(xg, b, tq, xcol) * (a + skip * bf2f(zin[idx]));
                      if (o == 0) zout[idx] = (bf16)f2bf(zn); else { if (dry) U[(size_t)(rowbase + 64 * I + i) * UA_W + 3456 + (c & 127)] = (bf16)f2bf(zn); else F.wsp<bf16>(WS_RB + RB_YHY)[(size_t)(rowbase + 64 * I + i) * HY_W + c] = (bf16)f2bf(zn); } } } }
        LAS bf16* tmp = zin; zin = zout; zout = tmp;
    }
    __syncthreads();
#undef HY_STAGE_RAW
#undef HY_CONV
}


constexpr int NA_KS = 72;
constexpr int NA_BUF = 2 * 64 * NA_KS * 2 + 256;
template <int kind>
__device__ __forceinline__ void na_job(Frame& F, int li, int b, int h, int gi, int dry) {
    const int lane = F.lane, r = lane & 15, g = lane >> 4, w = F.wave, qg = w & 3, kh = w >> 2;
    bf16* U = F.wsp<bf16>(WS_R1);
    LAS unsigned char* L = F.lds;
    LAS float* rpbs = (LAS float*)(L + 4 * NA_BUF);
    LAS float* comb = (LAS float*)(L + 4 * NA_BUF + 2048);
    const int r0 = min(max(gi - 4, 0), 24);
    const int qrow0 = (kind == 0 ? b * SEQ + gi * 64 : NL + b * LC + gi * 64) + qg * 16;
    const int nloc = kind == 0 ? 8 : 0, nsteps = nloc + 4;
    __syncthreads();
    { const float* rp = F.in[I_NARPB] + (size_t)(li * 6 + h) * 465; if (F.tid < 465) rpbs[F.tid] = rp[F.tid]; }
    bf16x8_t aq[2];
    { const bf16* qp = U + (size_t)(qrow0 + r) * UA_W + UA_NA + h * 64 + 8 * g; float x0[8], x1[8]; unpack8(*(const v4u*)qp, x0); unpack8(*(const v4u*)(qp + 32), x1);
      float ss = 0.f;
#pragma unroll
      for (int e = 0; e < 8; ++e) ss += x0[e] * x0[e] + x1[e] * x1[e];
      ss += __shfl_xor(ss, 16); ss += __shfl_xor(ss, 32);
      const float rq = 0.125f / sqrtf(ss * (1.f / 64.f) + NORM_EPS);
      const float* qg_ = F.in[I_NAQG] + li * 64 + 8 * g; const float* kg_ = F.in[I_NAKG] + li * 64 + 8 * g;
#pragma unroll
      for (int e = 0; e < 8; ++e) { x0[e] *= rq * qg_[e] * kg_[e]; x1[e] *= rq * qg_[32 + e] * kg_[32 + e]; }
      aq[0] = __builtin_bit_cast(bf16x8_t, pack8(x0)); aq[1] = __builtin_bit_cast(bf16x8_t, pack8(x1)); }
    const int qj = qg * 16 + r, c0q = min(max(qj - 8, 0), 48);
    const int wlo = min(max(qg * 16 - 8, 0), 48), whi = min(max(qg * 16 + 15 - 8, 0), 48) + 15;
    const bool half_live = !(32 * kh > whi || 32 * kh + 31 < wlo);
    float lsum = 0.f;
    f32x4 O[4];
#pragma unroll
    for (int dt = 0; dt < 4; ++dt) O[dt] = (f32x4){0.f, 0.f, 0.f, 0.f};
    const int sx = F.tid >> 3, sp = F.tid & 7;
    const int cvs = h * 64 + sx, q6s = (cvs * 10923) >> 16, vsoff = q6s * UA_W + 3072 + (cvs - 6 * q6s) * 64 + 8 * sp;
    const int nst2 = nsteps >> 1;
#define NA_KROW0(rw_) (((rw_) < nloc) ? (b * SEQ + (r0 + (rw_)) * 64) : (NL + b * LC + 64 * ((rw_) - nloc)))
    v4u kA[2], vA[2], kB[2], vB[2];
#define NA_GLOAD(s_, K_, V_) do { _Pragma("unroll") for (int u_ = 0; u_ < 2; ++u_) { const int kb_ = NA_KROW0(2 * (s_) + u_); \
        K_[u_] = *(const v4u*)(U + (size_t)(kb_ + sx) * UA_W + UA_NA + NA_W + h * 64 + 8 * sp); V_[u_] = *(const v4u*)(U + (size_t)kb_ * UA_W + vsoff); } } while (0)
#define NA_LSTORE(buf_, K_, V_) do { _Pragma("unroll") for (int u_ = 0; u_ < 2; ++u_) { LAS unsigned char* B_ = L + (buf_) * (2 * NA_BUF) + u_ * NA_BUF; float y_[8]; unpack8(K_[u_], y_); float ss_ = 0.f; \
        _Pragma("unroll") for (int e = 0; e < 8; ++e) ss_ += y_[e] * y_[e]; \
        ss_ += __shfl_xor(ss_, 1); ss_ += __shfl_xor(ss_, 2); ss_ += __shfl_xor(ss_, 4); \
        *(LAS v4u*)((LAS bf16*)B_ + sx * NA_KS + 8 * sp) = K_[u_]; *(LAS v4u*)((LAS bf16*)(B_ + 64 * NA_KS * 2) + sx * NA_KS + 8 * sp) = V_[u_]; \
        if (sp == 0) ((LAS float*)(B_ + 2 * 64 * NA_KS * 2))[sx] = 1.0f / sqrtf(ss_ * (1.f / 64.f) + NORM_EPS); } } while (0)
    NA_GLOAD(0, kA, vA); NA_LSTORE(0, kA, vA);
    { const int s1 = 1 < nst2 ? 1 : 0; NA_GLOAD(s1, kA, vA); }
    __syncthreads();
#pragma unroll 1
    for (int s = 0; s < nst2; ++s) {
        { const int s2 = s + 2 < nst2 ? s + 2 : nst2 - 1; NA_GLOAD(s2, kB, vB); }
#pragma unroll
        for (int u = 0; u < 2; ++u) { const int rw = 2 * s + u; const bool loc = rw < nloc;
          if (!loc || half_live) {
            LAS unsigned char* B_ = L + (s & 1) * (2 * NA_BUF) + u * NA_BUF; const LAS bf16* Ks = (const LAS bf16*)B_; const LAS bf16* Vt = (const LAS bf16*)(B_ + 64 * NA_KS * 2); const LAS float* rks = (const LAS float*)(B_ + 2 * 64 * NA_KS * 2);
            float p[8];
#pragma unroll
            for (int kt = 0; kt < 2; ++kt) { const int key0 = 32 * kh + 16 * kt;
                const bf16x8_t k0 = *(const LAS bf16x8_t*)(Ks + (key0 + r) * NA_KS + 8 * g), k1 = *(const LAS bf16x8_t*)(Ks + (key0 + r) * NA_KS + 32 + 8 * g);
                const f32x4 rk = *(const LAS f32x4*)(rks + key0 + 4 * g);
                f32x4 acc = {0.f, 0.f, 0.f, 0.f};
                acc = __builtin_amdgcn_mfma_f32_16x16x32_bf16(k0, aq[0], acc, 0, 0, 0);
                acc = __builtin_amdgcn_mfma_f32_16x16x32_bf16(k1, aq[1], acc, 0, 0, 0);
#pragma unroll
                for (int e = 0; e < 4; ++e) { float v = acc[e] * rk[e]; bool ok = true;
                    if (loc) { const int kcol = key0 + 4 * g + e; ok = kcol >= c0q && kcol < c0q + 16; const int dr = r0 + rw - gi + 7, dc = min(max(kcol - qj + 15, 0), 30); v += rpbs[dr * 31 + dc]; }
                    const float pe = ok ? __expf(v) : 0.f; lsum += pe; p[4 * kt + e] = pe; } }
            const v4u pw = {pg8::cvt_pk_bf16(p[0], p[1]), pg8::cvt_pk_bf16(p[2], p[3]), pg8::cvt_pk_bf16(p[4], p[5]), pg8::cvt_pk_bf16(p[6], p[7])}; const bf16x8_t pb = __builtin_bit_cast(bf16x8_t, pw);
#pragma unroll
            for (int dt = 0; dt < 4; ++dt) { const v2u va = *(const LAS v2u*)(Vt + (16 * dt + r) * NA_KS + 32 * kh + 4 * g), vb = *(const LAS v2u*)(Vt + (16 * dt + r) * NA_KS + 32 * kh + 16 + 4 * g);
                const v4u vw = {va.x, va.y, vb.x, vb.y};
                O[dt] = __builtin_amdgcn_mfma_f32_16x16x32_bf16(__builtin_bit_cast(bf16x8_t, vw), pb, O[dt], 0, 0, 0); }
          } }
        NA_LSTORE((s + 1) & 1, kA, vA);
#pragma unroll
        for (int u = 0; u < 2; ++u) { kA[u] = kB[u]; vA[u] = vB[u]; }
        __syncthreads();
    }
#undef NA_KROW0
#undef NA_GLOAD
#undef NA_LSTORE
    if (kh == 1) { LAS float* cp = comb + (qg * 64 + lane) * 17;
#pragma unroll
        for (int dt = 0; dt < 4; ++dt)
#pragma unroll
            for (int e = 0; e < 4; ++e) cp[4 * dt + e] = O[dt][e];
        cp[16] = lsum; }
    __syncthreads();
    if (kh == 0) { const LAS float* cp = comb + (qg * 64 + lane) * 17;
#pragma unroll
        for (int dt = 0; dt < 4; ++dt)
#pragma unroll
            for (int e = 0; e < 4; ++e) O[dt][e] += cp[4 * dt + e];
        lsum += cp[16];
        lsum += __shfl_xor(lsum, 16); lsum += __shfl_xor(lsum, 32);
        const float inv = 1.0f / lsum;
        bf16* op = U + (size_t)(qrow0 + r) * UA_W + (dry ? 3456 + (h & 1) * 64 : UA_NA + h * 64) + 4 * g;
#pragma unroll
        for (int dt = 0; dt < 4; ++dt) *(v2u*)(op + 16 * dt) = (v2u){pk2(O[dt][0] * inv, O[dt][1] * inv), pk2(O[dt][2] * inv, O[dt][3] * inv)}; }
}

__device__ __forceinline__ void na2_job(Frame& F, int li, int b, int h, int gp, int dry) {
    const int lane = F.lane, r = lane & 15, g = lane >> 4, w = F.wave, qg = w & 3, qi = w >> 2;
    bf16* U = F.wsp<bf16>(WS_R1);
    LAS unsigned char* L = F.lds;
    LAS float* rpbs = (LAS float*)(L + 4 * NA_BUF) + 16;
    const int gi = 2 * gp + qi, r0 = min(max(gi - 4, 0), 24), R0 = min(max(2 * gp - 4, 0), 24);
    const int qrow0 = b * SEQ + gi * 64 + qg * 16;
    __syncthreads();
    { const float* rp = F.in[I_NARPB] + (size_t)(li * 6 + h) * 465; if (F.tid < 497) rpbs[F.tid - 16] = (F.tid >= 16 && F.tid < 481) ? rp[F.tid - 16] : 0.f; }
    bf16x8_t aq[2];
    { const bf16* qp = U + (size_t)(qrow0 + r) * UA_W + UA_NA + h * 64 + 8 * g; float x0[8], x1[8]; unpack8(*(const v4u*)qp, x0); unpack8(*(const v4u*)(qp + 32), x1);
      float ss = 0.f;
#pragma unroll
      for (int e = 0; e < 8; ++e) ss += x0[e] * x0[e] + x1[e] * x1[e];
      ss += __shfl_xor(ss, 16); ss += __shfl_xor(ss, 32);
      const float rq = 0.125f / sqrtf(ss * (1.f / 64.f) + NORM_EPS);
      const float* qg_ = F.in[I_NAQG] + li * 64 + 8 * g; const float* kg_ = F.in[I_NAKG] + li * 64 + 8 * g;
#pragma unroll
      for (int e = 0; e < 8; ++e) { x0[e] *= rq * qg_[e] * kg_[e]; x1[e] *= rq * qg_[32 + e] * kg_[32 + e]; }
      aq[0] = __builtin_bit_cast(bf16x8_t, pack8(x0)); aq[1] = __builtin_bit_cast(bf16x8_t, pack8(x1)); }
    const int qj = qg * 16 + r, c0q = min(max(qj - 8, 0), 48);
    const int ks = qg == 0 ? 0 : (qg == 1 ? 8 : (qg == 2 ? 24 : 32));
    float lsum = 0.f;
    f32x4 O[4];
#pragma unroll
    for (int dt = 0; dt < 4; ++dt) O[dt] = (f32x4){0.f, 0.f, 0.f, 0.f};
    const int sx = F.tid >> 3, sp = F.tid & 7;
    const int cvs = h * 64 + sx, q6s = (cvs * 10923) >> 16, vsoff = q6s * UA_W + 3072 + (cvs - 6 * q6s) * 64 + 8 * sp;
    constexpr int NBLK = 13, NST = 7;
#define NA2_KROW0(bk_) (((bk_) < 9) ? (b * SEQ + min(R0 + (bk_), 31) * 64) : (NL + b * LC + 64 * ((bk_) - 9)))
    v4u kA[2], vA[2], kB[2], vB[2];
#define NA2_GLOAD(s_, K_, V_) do { _Pragma("unroll") for (int u_ = 0; u_ < 2; ++u_) { const int bk_ = min(2 * (s_) + u_, NBLK - 1); const int kb_ = NA2_KROW0(bk_); \
        K_[u_] = *(const v4u*)(U + (size_t)(kb_ + sx) * UA_W + UA_NA + NA_W + h * 64 + 8 * sp); V_[u_] = *(const v4u*)(U + (size_t)kb_ * UA_W + vsoff); } } while (0)
#define NA2_LSTORE(buf_, K_, V_) do { _Pragma("unroll") for (int u_ = 0; u_ < 2; ++u_) { LAS unsigned char* B_ = L + (buf_) * (2 * NA_BUF) + u_ * NA_BUF; float y_[8]; unpack8(K_[u_], y_); float ss_ = 0.f; \
        _Pragma("unroll") for (int e = 0; e < 8; ++e) ss_ += y_[e] * y_[e]; \
        ss_ += __shfl_xor(ss_, 1); ss_ += __shfl_xor(ss_, 2); ss_ += __shfl_xor(ss_, 4); \
        *(LAS v4u*)((LAS bf16*)B_ + sx * NA_KS + 8 * sp) = K_[u_]; *(LAS v4u*)((LAS bf16*)(B_ + 64 * NA_KS * 2) + sx * NA_KS + 8 * sp) = V_[u_]; \
        if (sp == 0) ((LAS float*)(B_ + 2 * 64 * NA_KS * 2))[sx] = 1.0f / sqrtf(ss_ * (1.f / 64.f) + NORM_EPS); } } while (0)
#define NA2_PASS(kb_, HASB_, BS_) do { float p[8]; \
        _Pragma("unroll") for (int kt = 0; kt < 2; ++kt) { const int key0 = (kb_) + 16 * kt; \
            const bf16x8_t k0 = *(const LAS bf16x8_t*)(Ks + (key0 + r) * NA_KS + 8 * g), k1 = *(const LAS bf16x8_t*)(Ks + (key0 + r) * NA_KS + 32 + 8 * g); \
            const f32x4 rk = *(const LAS f32x4*)(rks + key0 + 4 * g); \
            f32x4 acc = {0.f, 0.f, 0.f, 0.f}; \
            acc = __builtin_amdgcn_mfma_f32_16x16x32_bf16(k0, aq[0], acc, 0, 0, 0); \
            acc = __builtin_amdgcn_mfma_f32_16x16x32_bf16(k1, aq[1], acc, 0, 0, 0); \
            _Pragma("unroll") for (int e = 0; e < 4; ++e) { const float pe = __expf(HASB_ ? fmaf(acc[e], rk[e], (BS_)[4 * kt + e]) : acc[e] * rk[e]); lsum += pe; p[4 * kt + e] = pe; } } \
        const v4u pw = {pg8::cvt_pk_bf16(p[0], p[1]), pg8::cvt_pk_bf16(p[2], p[3]), pg8::cvt_pk_bf16(p[4], p[5]), pg8::cvt_pk_bf16(p[6], p[7])}; const bf16x8_t pb = __builtin_bit_cast(bf16x8_t, pw); \
        _Pragma("unroll") for (int dt = 0; dt < 4; ++dt) { const v2u va = *(const LAS v2u*)(Vt + (16 * dt + r) * NA_KS + (kb_) + 4 * g), vb = *(const LAS v2u*)(Vt + (16 * dt + r) * NA_KS + (kb_) + 16 + 4 * g); \
            const v4u vw = {va.x, va.y, vb.x, vb.y}; \
            O[dt] = __builtin_amdgcn_mfma_f32_16x16x32_bf16(__builtin_bit_cast(bf16x8_t, vw), pb, O[dt], 0, 0, 0); } } while (0)
    NA2_GLOAD(0, kA, vA); NA2_LSTORE(0, kA, vA);
    NA2_GLOAD(1, kA, vA);
    __syncthreads();
    float mk[8];
#pragma unroll
    for (int j = 0; j < 8; ++j) { const int kcol = ks + 16 * (j >> 2) + 4 * g + (j & 3); mk[j] = (kcol >= c0q && kcol < c0q + 16) ? 0.f : -1.0e30f; }
    const int bcol = ks + 4 * g - qj + 15;
#pragma unroll 1
    for (int s = 0; s < NST; ++s) {
        { const int s2 = s + 2 < NST ? s + 2 : NST - 1; NA2_GLOAD(s2, kB, vB); }
#pragma unroll
        for (int u = 0; u < 2; ++u) { const int bk = 2 * s + u;
          if (bk < NBLK) {
            LAS unsigned char* B_ = L + (s & 1) * (2 * NA_BUF) + u * NA_BUF; const LAS bf16* Ks = (const LAS bf16*)B_; const LAS bf16* Vt = (const LAS bf16*)(B_ + 64 * NA_KS * 2); const LAS float* rks = (const LAS float*)(B_ + 2 * 64 * NA_KS * 2);
            if (bk < 9) { const int krow = R0 + bk;
                if (krow >= r0 && krow < r0 + 8) { const LAS float* bp = rpbs + (krow - gi + 7) * 31 + bcol; float bs[8];
#pragma unroll
                    for (int j = 0; j < 8; ++j) bs[j] = bp[16 * (j >> 2) + (j & 3)] + mk[j];
                    NA2_PASS(ks, true, bs); } }
            else { NA2_PASS(0, false, mk); NA2_PASS(32, false, mk); }
          } }
        NA2_LSTORE((s + 1) & 1, kA, vA);
#pragma unroll
        for (int u = 0; u < 2; ++u) { kA[u] = kB[u]; vA[u] = vB[u]; }
        __syncthreads();
    }
#undef NA2_PASS
#undef NA2_KROW0
#undef NA2_GLOAD
#undef NA2_LSTORE
    lsum += __shfl_xor(lsum, 16); lsum += __shfl_xor(lsum, 32);
    const float inv = 1.0f / lsum;
    bf16* op = U + (size_t)(qrow0 + r) * UA_W + (dry ? 3456 + (h & 1) * 64 : UA_NA + h * 64) + 4 * g;
#pragma unroll
    for (int dt = 0; dt < 4; ++dt) *(v2u*)(op + 16 * dt) = (v2u){pk2(O[dt][0] * inv, O[dt][1] * inv), pk2(O[dt][2] * inv, O[dt][3] * inv)};
}

constexpr int CW_HYQ = 9216, CW_ROQ = 9216 + 64;
__device__ __forceinline__ void p4_hy_na(Frame& F, int li, int dry) {
    unsigned* qh = (unsigned*)(F.ws + WS_CTL) + CW_HYQ + li + 4 * dry;
    volatile LAS unsigned* slot = (volatile LAS unsigned*)(F.lds + LDS_CTL_OFF) + 16;
    const int nhl = (dry && (PROBE_SUB == 2 || PROBE_SUB == 3)) ? 0 : 256, nhc = (dry && (PROBE_SUB == 2 || PROBE_SUB == 3)) ? 0 : (li == 0 ? 256 : 0);
    const int nnl = (dry && (PROBE_SUB == 1 || PROBE_SUB == 3)) ? 0 : 768, nnc = (dry && (PROBE_SUB == 1 || PROBE_SUB == 3)) ? 0 : (li == 0 ? 192 : 0);
#pragma unroll 1
    for (;;) {
        __syncthreads();
        if (F.tid == 0) *slot = __hip_atomic_fetch_add(qh, 1u, __ATOMIC_RELAXED, __HIP_MEMORY_SCOPE_AGENT);
        __syncthreads();
        int job = (int)*slot;
        if (job >= nhl + nnl + nhc + nnc) break;
        if (job < nhl) { hy_job_mfma(F, li, 0, job, dry); continue; } job -= nhl;
        if (job < nnl) { const int bb = job / 96, q = job % 96; na2_job(F, li, bb, q >> 4, q & 15, dry); continue; } job -= nnl;
        if (job < nhc) { hy_job_mfma(F, li, 1, job, dry); continue; } job -= nhc;
        { const int bb = job / 24, q = job % 24; na_job<1>(F, li, bb, q >> 2, q & 3, dry); }
    }
    __syncthreads();
}

constexpr int PPL = 14;
constexpr int N_PHASES = 1 + PPL * NLAYER + 1;
#define IN(k) (lo <= (k) && (k) < hi)
#define SEAM(k) do { if (IN(k) && IN((k) + 1)) xcd_barrier(bar); } while (0)
template <int li> __device__ __forceinline__ void layer_body(Frame& F, const int lo, const int hi, const XcdBarrier& bar) {
    LAS unsigned char* L = F.lds;
    constexpr int pb = 1 + PPL * li;
    constexpr bool last = li == NLAYER - 1;
    constexpr int Mrows = last ? NL : MT;
    bf16* const RA = F.wsp<bf16>(WS_RA); bf16* const UA = F.wsp<bf16>(WS_R1); bf16* const GT = F.wsp<bf16>(WS_WM13);
    const bf16* const WIN = F.wsp<bf16>(WS_WIN + li * SZ_WIN1);
    if (IN(pb + 0)) { for (int rep_ = 0; rep_ < (PROBE_ID == (pb + 0) ? PROBE_REPS : 1); ++rep_) { const int dry = rep_ > 0; (void)dry; F.fresh(); if (rep_) { VM_WAIT(); __syncthreads(); } p1_norm1(F, li); } } SEAM(pb + 0);
    if (IN(pb + 1)) { for (int rep_ = 0; rep_ < (PROBE_ID == (pb + 1) ? PROBE_REPS : 1); ++rep_) { const int dry = rep_ > 0; (void)dry; F.fresh(); if (rep_) { VM_WAIT(); __syncthreads(); }
        pg8::Gemm g{RA, WIN, MT, UA_W, D, D}; pg8::StaticOrder S; S.init(MT, UA_W, F.G, F.bid);
        EpiBf16S<0> E{UA, UA_W};
        GEMM_CALL(EpiBf16S<0>, pg8::StaticOrder, L, g, S, E);
    } } SEAM(pb + 1);
    if (IN(pb + 2)) { for (int rep_ = 0; rep_ < (PROBE_ID == (pb + 2) ? PROBE_REPS : 1); ++rep_) { const int dry = rep_ > 0; (void)dry; F.fresh(); if (rep_) { VM_WAIT(); __syncthreads(); } p3_rw_features(F, li); } } SEAM(pb + 2);
    if (IN(pb + 3)) { for (int rep_ = 0; rep_ < (PROBE_ID == (pb + 3) ? PROBE_REPS : 1); ++rep_) { const int dry = rep_ > 0; (void)dry; F.fresh(); if (rep_) { VM_WAIT(); __syncthreads(); }
#pragma unroll 1
        for (int job = F.bid; job < NCHAIN * NCHUNK; job += F.G) rw_phaseA_job(F, li, job / NCHUNK, job % NCHUNK);
    } } SEAM(pb + 3);
    if (IN(pb + 4)) { for (int rep_ = 0; rep_ < (PROBE_ID == (pb + 4) ? PROBE_REPS : 1); ++rep_) { const int dry = rep_ > 0; (void)dry; F.fresh(); if (rep_) { VM_WAIT(); __syncthreads(); }
        if (F.bid < NCHAIN && !(dry && (PROBE_SUB == 1 || PROBE_SUB == 2))) rw_phaseB_chain(F, F.bid, dry);
        p4_hy_na(F, li, dry);
    } } SEAM(pb + 4);
    if (IN(pb + 5)) { for (int rep_ = 0; rep_ < (PROBE_ID == (pb + 5) ? PROBE_REPS : 1); ++rep_) { const int dry = rep_ > 0; (void)dry; F.fresh(); if (rep_) { VM_WAIT(); __syncthreads(); }
#pragma unroll 1
        for (int job = F.bid; job < NCHAIN * NCHUNK; job += F.G) rw_phaseC_job(F, li, job / NCHUNK, job % NCHUNK, dry);
    } } SEAM(pb + 5);
    if (IN(pb + 6)) { for (int rep_ = 0; rep_ < (PROBE_ID == (pb + 6) ? PROBE_REPS : 1); ++rep_) { const int dry = rep_ > 0; (void)dry; F.fresh(); if (rep_) { VM_WAIT(); __syncthreads(); }
        { pg8::Gemm g{RA, WIN + (size_t)UA_W * D, Mrows, GATE_IN, D, D}; pg8::StaticOrder S; S.init(Mrows, GATE_IN, F.G, F.bid);
          EpiBf16S<1> E{GT, GATE_IN};
          GEMM_CALL(EpiBf16S<1>, pg8::StaticOrder, L, g, S, E); }
        { unsigned* qr = (unsigned*)(F.ws + WS_CTL) + CW_ROQ + li + 4 * dry; volatile LAS unsigned* slot = (volatile LAS unsigned*)(F.lds + LDS_CTL_OFF) + 20;
#pragma unroll 1
          for (;;) { __syncthreads();
              if (F.tid == 0) *slot = __hip_atomic_fetch_add(qr, 1u, __ATOMIC_RELAXED, __HIP_MEMORY_SCOPE_AGENT);
              __syncthreads();
              const int blk = (int)*slot; if (blk >= Mrows / 64) break;
              p5_rw_readout(F, li, blk * 64, blk * 64 + 64); } }
    } } SEAM(pb + 6);
    if (IN(pb + 8)) { for (int rep_ = 0; rep_ < (PROBE_ID == (pb + 8) ? PROBE_REPS : 1); ++rep_) { const int dry = rep_ > 0; (void)dry; F.fresh(); if (rep_) { VM_WAIT(); __syncthreads(); }
        const bf16* WBR = F.wsp<bf16>(WS_WBR + li * SZ_WBR1);
        { pg8::Gemm g{UA, WBR, Mrows, D, RW_W, UA_W}; pg8::StaticOrder S; S.init(Mrows, D, F.G, F.bid); EpiMerge<0> E{GT, GATE_IN, RA};
          GEMM_CALL(EpiMerge<0>, pg8::StaticOrder, L, g, S, E); }
        VM_WAIT(); __syncthreads();
        { pg8::Gemm g{F.wsp<bf16>(WS_RB + RB_YHY), WBR + (size_t)D * RW_W, Mrows, D, HY_W, HY_W}; pg8::StaticOrder S; S.init(Mrows, D, F.G, F.bid); EpiMerge<1> E{GT + D, GATE_IN, RA};
          GEMM_CALL(EpiMerge<1>, pg8::StaticOrder, L, g, S, E); }
        VM_WAIT(); __syncthreads();
        { pg8::Gemm g{UA + UA_NA, WBR + (size_t)D * (RW_W + HY_W), Mrows, D, NA_W, UA_W}; pg8::StaticOrder S; S.init(Mrows, D, F.G, F.bid); EpiMerge<1> E{GT + 2 * D, GATE_IN, RA};
          GEMM_CALL(EpiMerge<1>, pg8::StaticOrder, L, g, S, E); }
    } } SEAM(pb + 8);
    if (IN(pb + 9)) { for (int rep_ = 0; rep_ < (PROBE_ID == (pb + 9) ? PROBE_REPS : 1); ++rep_) { const int dry = rep_ > 0; (void)dry; F.fresh(); if (rep_) { VM_WAIT(); __syncthreads(); }
        pg8::Gemm g{RA, F.wsp<bf16>(WS_WOUT + li * SZ_WOUT1), Mrows, D, D, D}; pg8::StaticOrder S; S.init(Mrows, D, F.G, F.bid);
        EpiRes E{li == 0 ? F.in[I_X] : F.out, F.out, li == 0 ? F.in[I_CTX] : F.wsp<float>(WS_CTXRES), F.wsp<float>(WS_CTXRES), F.mods(li, 0), 2 * D, (dry && li > 0) ? 0.f : 1.f};
        GEMM_CALL(EpiRes, pg8::StaticOrder, L, g, S, E);
    } } SEAM(pb + 9);
    if (IN(pb + 10)) { for (int rep_ = 0; rep_ < (PROBE_ID == (pb + 10) ? PROBE_REPS : 1); ++rep_) { const int dry = rep_ > 0; (void)dry; F.fresh(); if (rep_) { VM_WAIT(); __syncthreads(); } p8_norm2(F, li, dry); if (last) { __syncthreads(); moe_weight_transposes(F); } } } SEAM(pb + 10);
    if (!last) {
        if (IN(pb + 11) && IN(pb + 12)) {}
        if (IN(pb + 12)) { for (int rep_ = 0; rep_ < (PROBE_ID == (pb + 12) ? PROBE_REPS : 1); ++rep_) { const int dry = rep_ > 0; (void)dry; F.fresh(); if (rep_) { VM_WAIT(); __syncthreads(); }
            pg8::Gemm g{RA, F.wsp<bf16>(WS_WFF13), MT, 2 * FF, D, D}; pg8::StaticOrder S; S.init(MT, 2 * FF, F.G, F.bid);
            EpiSwiGLU E{F.wsp<bf16>(WS_R1), FF, 2 * FF / 256, 1.0f};
            GEMM_CALL(EpiSwiGLU, pg8::StaticOrder, L, g, S, E);
        } } SEAM(pb + 12);
        if (IN(pb + 13)) { for (int rep_ = 0; rep_ < (PROBE_ID == (pb + 13) ? PROBE_REPS : 1); ++rep_) { const int dry = rep_ > 0; (void)dry; F.fresh(); if (rep_) { VM_WAIT(); __syncthreads(); }
            pg8::Gemm g{F.wsp<bf16>(WS_R1), F.wsp<bf16>(WS_WFF2), MT, D, FF, FF}; pg8::StaticOrder S; S.init(MT, D, F.G, F.bid);
            EpiRes E{F.out, F.out, F.wsp<float>(WS_CTXRES), F.wsp<float>(WS_CTXRES), F.mods(li, 0), 5 * D, dry ? 0.f : 1.f};
            GEMM_CALL(EpiRes, pg8::StaticOrder, L, g, S, E);
        } } SEAM(pb + 13);
    } else {
        if (IN(pb + 11)) { for (int rep_ = 0; rep_ < (PROBE_ID == (pb + 11) ? PROBE_REPS : 1); ++rep_) { const int dry = rep_ > 0; (void)dry; F.fresh(); if (rep_) { VM_WAIT(); __syncthreads(); } p8b_gather(F); } } SEAM(pb + 11);
        const unsigned* cnt = (const unsigned*)(F.ws + WS_CTL) + CW_MOECNT;
        if (IN(pb + 12)) { for (int rep_ = 0; rep_ < (PROBE_ID == (pb + 12) ? PROBE_REPS : 1); ++rep_) { const int dry = rep_ > 0; (void)dry; F.fresh(); if (rep_) { VM_WAIT(); __syncthreads(); }
            pg8::Gemm g{RA, F.wsp<bf16>(WS_WM13), MOE_ROWS, 2 * FFE, D, D}; pg8::MoeOrder S; S.init(cnt, 2 * FFE / 256, F.G, F.bid);
            EpiSwiGLU E{F.wsp<bf16>(WS_R1), FFE, 2 * FFE / 256, 1.0f / 32.0f};
            GEMM_CALL_F8(EpiSwiGLU, pg8::MoeOrder, L, g, S, E);
        } } SEAM(pb + 12);
        if (IN(pb + 13)) { for (int rep_ = 0; rep_ < (PROBE_ID == (pb + 13) ? PROBE_REPS : 1); ++rep_) { const int dry = rep_ > 0; (void)dry; F.fresh(); if (rep_) { VM_WAIT(); __syncthreads(); }
            pg8::Gemm g{F.wsp<bf16>(WS_R1), F.wsp<bf16>(WS_WM2), MOE_ROWS, D, FFE, FFE}; pg8::MoeOrder S; S.init(cnt, D / 256, F.G, F.bid);
            EpiMoeY E{RA};
            GEMM_CALL(EpiMoeY, pg8::MoeOrder, L, g, S, E);
        } } SEAM(pb + 13);
        if (IN(pb + 14)) { for (int rep_ = 0; rep_ < (PROBE_ID == (pb + 14) ? PROBE_REPS : 1); ++rep_) { const int dry = rep_ > 0; (void)dry; F.fresh(); if (rep_) { VM_WAIT(); __syncthreads(); } p11_moe_combine(F, li, dry); } }
    }
}
#undef IN
#undef SEAM
__global__ void __launch_bounds__(NTHREADS, 2) fwd_kernel(Args args) {
    extern __shared__ __attribute__((aligned(16))) unsigned char lds_raw[];
    Frame F;
    F.lds = (LAS unsigned char*)lds_raw;
    F.tid = threadIdx.x; F.lane = F.tid & 63; F.wave = __builtin_amdgcn_readfirstlane(F.tid >> 6);
    F.G = gridDim.x; F.bid = blockIdx.x;
    F.in = (const CAS cfp*)__builtin_amdgcn_kernarg_segment_ptr(); F.out = args.out; F.ws = args.ws;
    volatile LAS unsigned* MISC = (volatile LAS unsigned*)(F.lds + LDS_CTL_OFF);
    if (F.tid < 64) MISC[F.tid] = 0u;
    __syncthreads();
    const int lo = args.ph_lo, hi = args.ph_hi;
    XcdBarrier bar; bar.bar = (unsigned*)(F.ws + WS_CTL) + CW_BAR; bar.x = 0; bar.st = nullptr;
    if (hi - lo > 1) bar = xcd_barrier_post((unsigned*)(F.ws + WS_CTL) + CW_BAR, MISC + 8);
    if (lo <= 0 && 0 < hi) { for (int rep_ = 0; rep_ < (PROBE_ID == 0 ? PROBE_REPS : 1); ++rep_) { F.fresh(); if (rep_) { VM_WAIT(); __syncthreads(); } p0_prologue(F); } }
    if (lo <= 0 && 1 < hi) xcd_barrier(bar);
    layer_body<0>(F, lo, hi, bar);
    layer_body<1>(F, lo, hi, bar);
}

extern "C" void kernel_launch(void* const* d_in, const int* in_sizes, int n_in, void* d_out, int out_size, void* d_ws, size_t ws_size, hipStream_t stream) {
    static int grid = 0;
    if (grid == 0) {
        if (n_in != N_IN || out_size != NL * D || ws_size < WS_END) { fprintf(stderr, "kernel_launch: shape/workspace mismatch (n_in %d, out %d, ws %zu, need %zu); nothing launched\n", n_in, out_size, ws_size, (size_t)WS_END); grid = -1; return; }
        int dev = 0, cus = 0, per_cu = 0;
        if (hipGetDevice(&dev) != hipSuccess || hipDeviceGetAttribute(&cus, hipDeviceAttributeMultiprocessorCount, dev) != hipSuccess) { grid = -1; return; }
        if (hipFuncSetAttribute((const void*)fwd_kernel, hipFuncAttributeMaxDynamicSharedMemorySize, LDS_BYTES) != hipSuccess) { fprintf(stderr, "kernel_launch: hipFuncSetAttribute failed\n"); grid = -1; return; }
        if (hipOccupancyMaxActiveBlocksPerMultiprocessor(&per_cu, (const void*)fwd_kernel, NTHREADS, LDS_BYTES) != hipSuccess || per_cu < 1) fprintf(stderr, "kernel_launch: occupancy query says %d\n", per_cu);
        (void)hipGetLastError();
        grid = cus;
    }
    if (grid < 0) return;
    if (hipMemsetAsync((char*)d_ws + WS_CTL, 0, CTL_ZERO_BYTES, stream) != hipSuccess) return;
    Args a{};
    for (int i = 0; i < N_IN; ++i) a.in[i] = (const float*)d_in[i];
    a.out = (float*)d_out; a.ws = (unsigned char*)d_ws;
#if MK_ONE_LAUNCH
    a.ph_lo = 0; a.ph_hi = N_PHASES;
    hipLaunchKernelGGL(fwd_kernel, dim3(grid), dim3(NTHREADS), LDS_BYTES, stream, a);
#else
    for (int p = 0; p < N_PHASES; ++p) {
        if (p == 1 + 11) continue;
        a.ph_lo = p; a.ph_hi = p + 1;
        hipLaunchKernelGGL(fwd_kernel, dim3(grid), dim3(NTHREADS), LDS_BYTES, stream, a);
    }
#endif
}
```

```cpp
#include <hip/hip_runtime.h>
#include <cstdio>
#include <cstdint>

#ifndef MK_ONE_LAUNCH
#define MK_ONE_LAUNCH 1
#endif
#ifndef PROBE_ID
#define PROBE_ID (-1)
#endif
#ifndef PROBE_REPS
#define PROBE_REPS 2
#endif
#ifndef PROBE_SUB
#define PROBE_SUB 0
#endif
#ifndef USE_NAIVE_GEMM
#define USE_NAIVE_GEMM 0
#endif

namespace pg8 {
#define PG8_LAS __attribute__((address_space(3)))
typedef unsigned short bf16_t;
typedef short bf16x8 __attribute__((ext_vector_type(8)));
typedef float f32x4 __attribute__((ext_vector_type(4)));
typedef unsigned u32x4 __attribute__((ext_vector_type(4)));
constexpr int BM = 256, BK = 64, HALF = 128, HTB = HALF * BK * 2  , STAGE_BYTES = 8 * HTB, NXCD = 8, WGM = 8;

__host__ __device__ __forceinline__ int lds_byte(int r, int c) { const int st = (r >> 4) * 2 + (c >> 5), rr = r & 15, cc = c & 31, ob = rr * 64 + cc * 2; return st * 1024 + (ob ^ (((ob >> 9) & 1) << 5)); }
__host__ __device__ __forceinline__ void stage_rc(int b, int& R, int& C) { const int st = b / 1024, sb = b % 1024, swz = sb ^ (((sb >> 9) & 1) << 5); R = (st >> 1) * 16 + swz / 64; C = (st & 1) * 32 + (swz % 64) / 2; }
__host__ __device__ __forceinline__ int perm32(int rho) { const int n = rho >> 4, i = rho & 15; return 8 * (i >> 2) + 4 * n + (i & 3); }

struct Unit { int pm, pn; };
struct Gemm { const bf16_t* A; const bf16_t* Bt; int M, N, K, lda; };

struct StaticOrder {
    int nM, nN, nwg, G, c;
    __host__ __device__ void init(int M, int N, int G_, int c_) { nM = M / BM; nN = N / BM; nwg = nM * nN; G = G_; c = c_; }
    __host__ __device__ bool next(int i, Unit& u) const {
        const long L = (long)i * G + c; if (L >= nwg) return false;
        int wgid = (int)L; { const int q = nwg / NXCD, r = nwg % NXCD, xcd = wgid % NXCD, off = wgid / NXCD; wgid = (xcd < r ? xcd * (q + 1) : r * (q + 1) + (xcd - r) * q) + off; }
        const int nig = WGM * nN, gid = wgid / nig, fm = gid * WGM, gsz = (nM - fm) < WGM ? (nM - fm) : WGM;
        u.pm = fm + ((wgid % nig) % gsz); u.pn = (wgid % nig) / gsz; return true;
    }
    __device__ __forceinline__ void a_ready(const Unit&) const {}
    __device__ __forceinline__ void done(const Unit&) const {}
};
struct MoeOrder {
    int nM, nN, nwg, G, c; int toff[9];
    __device__ void init(const unsigned* cnt, int nN_, int G_, int c_) {
        int t = 0;
#pragma unroll
        for (int e = 0; e < 8; ++e) { toff[e] = t; t += (int)((__builtin_amdgcn_readfirstlane(cnt[64 * e]) + 255u) >> 8); }
        toff[8] = t; nM = t; nN = nN_; nwg = nM * nN; G = G_; c = c_;
    }
    __device__ bool next(int i, Unit& u) const {
        const long L = (long)i * G + c; if (L >= nwg) return false;
        int wgid = (int)L; { const int q = nwg / NXCD, r = nwg % NXCD, xcd = wgid % NXCD, off = wgid / NXCD; wgid = (xcd < r ? xcd * (q + 1) : r * (q + 1) + (xcd - r) * q) + off; }
        const int nig = WGM * nN, gid = wgid / nig, fm = gid * WGM, gsz = (nM - fm) < WGM ? (nM - fm) : WGM;
        const int pm = fm + ((wgid % nig) % gsz), pn = (wgid % nig) / gsz;
        int e = 0;
#pragma unroll
        for (int k = 1; k < 8; ++k) e += (pm >= toff[k]) ? 1 : 0;
        u.pm = pm; u.pn = e * nN + pn; return true;
    }
    __device__ __forceinline__ void a_ready(const Unit&) const {}
    __device__ __forceinline__ void done(const Unit&) const {}
};

__device__ __forceinline__ unsigned cvt_pk_bf16(float lo, float hi) { unsigned r; asm volatile("v_cvt_pk_bf16_f32 %0, %1, %2" : "=v"(r) : "v"(lo), "v"(hi)); return r; }

typedef int i32x4_t __attribute__((ext_vector_type(4)));
typedef int i32x8_t __attribute__((ext_vector_type(8)));
template <class Epi, class Sched, bool ALIGN_EPI = false, bool SP2 = false, bool F8 = false>
__device__ __forceinline__ void gemm_phase(PG8_LAS unsigned char* lds, const Gemm g, const Sched& S, const Epi& E) {
    int tid_ = threadIdx.x; asm volatile("" : "+v"(tid_));
    const int tid = tid_, wid = __builtin_amdgcn_readfirstlane(tid >> 6), lane = tid & 63, wr = wid >> 2, wc = wid & 3, fr = lane & 15, fq = lane >> 4;
    constexpr int ES = F8 ? 1 : 2;
    const int K = g.K, nt = K * ES / (BK * 2), LDA = g.lda;
    unsigned voffA[2], voffB[2];
#pragma unroll
    for (int i = 0; i < 2; ++i) { int R, C; stage_rc(tid * 16 + i * 8192, R, C); const int Rb = Epi::PERM ? ((R & ~31) + perm32(R & 31)) : R;
        voffA[i] = (unsigned)(R * LDA * ES + C * 2); voffB[i] = (unsigned)(Rb * K * ES + C * 2); }
    const size_t kstep = (size_t)(BK * 2);
    const size_t hstepA = (size_t)HALF * LDA * ES, hstepB = (size_t)HALF * K * ES;
    const size_t tstepA = 2 * hstepA, tstepB = 2 * hstepB;
    const unsigned ldsw = (unsigned)wid * 1024u;
    const int aoff = lds_byte(wr * 64 + fr, fq * 8), boff = lds_byte(wc * 32 + fr, fq * 8);
#define PG8_SA(b, h) (((b) * 2 + (h)) * HTB)
#define PG8_SB(b, h) ((4 + (b) * 2 + (h)) * HTB)
#define PG8_STAGE(bufoff, gbase, voff) do { _Pragma("unroll") for (int _i = 0; _i < 2; ++_i) \
        __builtin_amdgcn_global_load_lds((const unsigned*)((const char*)(gbase) + (voff)[_i]), (PG8_LAS unsigned*)(lds + (bufoff) + ldsw + _i * 8192), 16, 0, 0); } while (0)
#define PG8_LDA(dst, b, h) do { _Pragma("unroll") for (int m = 0; m < 4; ++m) _Pragma("unroll") for (int k = 0; k < 2; ++k) dst[m][k] = *(const PG8_LAS bf16x8*)(lds + PG8_SA(b, h) + aoff + m * 2048 + k * 1024); } while (0)
#define PG8_LDB(dst, b, h) do { _Pragma("unroll") for (int n = 0; n < 2; ++n) _Pragma("unroll") for (int k = 0; k < 2; ++k) dst[n][k] = *(const PG8_LAS bf16x8*)(lds + PG8_SB(b, h) + boff + n * 2048 + k * 1024); } while (0)
#define PG8_CAT8(x_, y_) __builtin_shufflevector(__builtin_bit_cast(i32x4_t, (x_)), __builtin_bit_cast(i32x4_t, (y_)), 0, 1, 2, 3, 4, 5, 6, 7)
#define PG8_MMA(ai, bj, At, Bt) do { __builtin_amdgcn_s_setprio(1); \
        if constexpr (F8) { _Pragma("unroll") for (int m = 0; m < 4; ++m) _Pragma("unroll") for (int n = 0; n < 2; ++n) \
            { const i32x8_t b8_ = PG8_CAT8(Bt[n][0], Bt[n][1]), a8_ = PG8_CAT8(At[m][0], At[m][1]); \
              asm volatile("v_mfma_f32_16x16x128_f8f6f4 %0, %1, %2, %0" : "+v"(acc[ai][bj][m][n]) : "v"(b8_), "v"(a8_)); } } \
        else { _Pragma("unroll") for (int m = 0; m < 4; ++m) _Pragma("unroll") for (int n = 0; n < 2; ++n) _Pragma("unroll") for (int k = 0; k < 2; ++k) \
            acc[ai][bj][m][n] = __builtin_amdgcn_mfma_f32_16x16x32_bf16(Bt[n][k], At[m][k], acc[ai][bj][m][n], 0, 0, 0); } \
        __builtin_amdgcn_s_setprio(0); } while (0)
#define PG8_WAIT_V(n) asm volatile("s_waitcnt vmcnt(" #n ")" ::: "memory")
#define PG8_WAIT_L(n) asm volatile("s_waitcnt lgkmcnt(" #n ")" ::: "memory")
#define PG8_BAR __builtin_amdgcn_s_barrier()
#define PG8_SCHED __builtin_amdgcn_sched_barrier(0)
    Unit cur, nxt; int ui = 0;
    if (!S.next(0, cur)) return;
    f32x4 acc[2][2][4][2];
#pragma unroll
    for (int a = 0; a < 2; ++a)
#pragma unroll
        for (int b = 0; b < 2; ++b)
#pragma unroll
            for (int m = 0; m < 4; ++m)
#pragma unroll
                for (int n = 0; n < 2; ++n) acc[a][b][m][n] = (f32x4){0.f, 0.f, 0.f, 0.f};
    bf16x8 At[4][2], B0[2][2], B1[2][2];
    const char* cA = (const char*)g.A + (size_t)cur.pm * tstepA; const char* cB = (const char*)g.Bt + (size_t)cur.pn * tstepB;
    S.a_ready(cur);
    if constexpr (SP2) {
        PG8_STAGE(PG8_SB(0, 0), cB, voffB); PG8_STAGE(PG8_SB(0, 1), cB + hstepB, voffB); PG8_STAGE(PG8_SA(0, 0), cA, voffA); PG8_STAGE(PG8_SA(0, 1), cA + hstepA, voffA);
        if (wr == 1) PG8_BAR;
        PG8_WAIT_V(2); PG8_BAR;
        PG8_STAGE(PG8_SB(1, 0), cB + kstep, voffB); PG8_STAGE(PG8_SA(1, 0), cA + kstep, voffA); PG8_STAGE(PG8_SB(1, 1), cB + hstepB + kstep, voffB);
        PG8_WAIT_V(6); PG8_BAR;
    } else {
        PG8_STAGE(PG8_SB(0, 0), cB, voffB); PG8_STAGE(PG8_SA(0, 0), cA, voffA); PG8_STAGE(PG8_SB(0, 1), cB + hstepB, voffB); PG8_STAGE(PG8_SA(0, 1), cA + hstepA, voffA);
        if (wr == 1) PG8_BAR;
        PG8_WAIT_V(4); PG8_BAR;
        PG8_STAGE(PG8_SB(1, 0), cB + kstep, voffB); PG8_STAGE(PG8_SA(1, 0), cA + kstep, voffA); PG8_STAGE(PG8_SB(1, 1), cB + hstepB + kstep, voffB);
        PG8_WAIT_V(6); PG8_BAR;
    }
    for (;;) {
        const bool has_next = S.next(ui + 1, nxt);
        const char* nA = has_next ? (const char*)g.A + (size_t)nxt.pm * tstepA : cA; const char* nB = has_next ? (const char*)g.Bt + (size_t)nxt.pn * tstepB : cB;
#pragma unroll 1
        for (int t = 0; t < nt; t += 2) {
            const bool last = (t == nt - 2);
            const char* a1 = cA + (size_t)(t + 1) * kstep;
            const char* a2 = last ? nA : cA + (size_t)(t + 2) * kstep; const char* b2 = last ? nB : cB + (size_t)(t + 2) * kstep;
            const char* a3 = a2 + kstep; const char* b3 = b2 + kstep;
            if (last && has_next) S.a_ready(nxt);
            if constexpr (SP2) {
            PG8_LDB(B0, 0, 0); PG8_LDB(B1, 0, 1); PG8_SCHED; PG8_LDA(At, 0, 0); PG8_STAGE(PG8_SA(1, 1), a1 + hstepA, voffA);
            PG8_WAIT_V(8); PG8_WAIT_L(0); PG8_BAR; PG8_MMA(0, 0, At, B0); PG8_MMA(0, 1, At, B1); PG8_BAR; PG8_SCHED;
            PG8_LDA(At, 0, 1); PG8_STAGE(PG8_SB(0, 0), b2, voffB); PG8_STAGE(PG8_SB(0, 1), b2 + hstepB, voffB); PG8_STAGE(PG8_SA(0, 0), a2, voffA);
            PG8_WAIT_V(8); PG8_WAIT_L(0); PG8_BAR; PG8_MMA(1, 0, At, B0); PG8_MMA(1, 1, At, B1); PG8_BAR; PG8_SCHED;
            PG8_LDB(B0, 1, 0); PG8_LDB(B1, 1, 1); PG8_SCHED; PG8_LDA(At, 1, 0); PG8_STAGE(PG8_SA(0, 1), a2 + hstepA, voffA);
            PG8_WAIT_V(8); PG8_WAIT_L(0); PG8_BAR; PG8_MMA(0, 0, At, B0); PG8_MMA(0, 1, At, B1); PG8_BAR; PG8_SCHED;
            PG8_LDA(At, 1, 1); PG8_STAGE(PG8_SB(1, 0), b3, voffB); PG8_STAGE(PG8_SB(1, 1), b3 + hstepB, voffB); PG8_STAGE(PG8_SA(1, 0), a3, voffA);
            PG8_WAIT_V(8); PG8_WAIT_L(0); PG8_BAR; PG8_MMA(1, 0, At, B0); PG8_MMA(1, 1, At, B1); PG8_BAR; PG8_SCHED;
            } else {
            PG8_LDB(B0, 0, 0); PG8_SCHED; PG8_LDA(At, 0, 0); PG8_STAGE(PG8_SA(1, 1), a1 + hstepA, voffA);
            PG8_WAIT_L(8); PG8_BAR; PG8_WAIT_L(0); PG8_MMA(0, 0, At, B0); PG8_BAR; PG8_SCHED;
            PG8_LDB(B1, 0, 1); PG8_STAGE(PG8_SB(0, 0), b2, voffB);
            PG8_BAR; PG8_WAIT_L(0); PG8_MMA(0, 1, At, B1); PG8_BAR;
            PG8_LDA(At, 0, 1); PG8_STAGE(PG8_SA(0, 0), a2, voffA);
            PG8_BAR; PG8_WAIT_L(0); PG8_MMA(1, 0, At, B0); PG8_BAR; PG8_SCHED;
            PG8_STAGE(PG8_SB(0, 1), b2 + hstepB, voffB);
            PG8_WAIT_V(6); PG8_BAR; PG8_MMA(1, 1, At, B1); PG8_BAR;
            PG8_LDB(B0, 1, 0); PG8_SCHED; PG8_LDA(At, 1, 0); PG8_STAGE(PG8_SA(0, 1), a2 + hstepA, voffA);
            PG8_WAIT_L(8); PG8_BAR; PG8_WAIT_L(0); PG8_MMA(0, 0, At, B0); PG8_BAR; PG8_SCHED;
            PG8_LDB(B1, 1, 1); PG8_STAGE(PG8_SB(1, 0), b3, voffB);
            PG8_BAR; PG8_WAIT_L(0); PG8_MMA(0, 1, At, B1); PG8_BAR;
            PG8_LDA(At, 1, 1); PG8_STAGE(PG8_SA(1, 0), a3, voffA);
            PG8_BAR; PG8_WAIT_L(0); PG8_MMA(1, 0, At, B0); PG8_BAR; PG8_SCHED;
            PG8_STAGE(PG8_SB(1, 1), b3 + hstepB, voffB);
            PG8_WAIT_V(6); PG8_BAR; PG8_MMA(1, 1, At, B1); PG8_BAR;
            }
        }
        if constexpr (F8) asm volatile("s_nop 15\n\ts_nop 15" ::: "memory");
        if constexpr (ALIGN_EPI) { if (wr == 0) PG8_BAR; }
        if constexpr (F8) { int t2 = threadIdx.x; asm volatile("" : "+v"(t2));
            const int wid2 = __builtin_amdgcn_readfirstlane(t2 >> 6), lane2 = t2 & 63; E(acc, cur, wid2 >> 2, wid2 & 3, lane2 & 15, lane2 >> 4); }
        else E(acc, cur, wr, wc, fr, fq);
        S.done(cur);
        if (!has_next) break;
#pragma unroll
        for (int a = 0; a < 2; ++a)
#pragma unroll
            for (int b = 0; b < 2; ++b)
#pragma unroll
                for (int m = 0; m < 4; ++m)
#pragma unroll
                    for (int n = 0; n < 2; ++n) acc[a][b][m][n] = (f32x4){0.f, 0.f, 0.f, 0.f};
        cur = nxt; cA = nA; cB = nB; ++ui;
        if constexpr (ALIGN_EPI) { if (wr == 1) PG8_BAR; }
    }
    PG8_WAIT_V(0);
    if constexpr (!ALIGN_EPI) { if (wr == 0) PG8_BAR; }
    PG8_BAR;
#undef PG8_SA
#undef PG8_SB
#undef PG8_STAGE
#undef PG8_LDA
#undef PG8_LDB
#undef PG8_MMA
#undef PG8_CAT8
#undef PG8_WAIT_V
#undef PG8_WAIT_L
#undef PG8_BAR
#undef PG8_SCHED
}

template <class Epi, class Sched>
__device__ __forceinline__ void gemm_naive(PG8_LAS unsigned char* lds, const Gemm g, const Sched& S, const Epi& E) {
    const int tid = threadIdx.x, wid = __builtin_amdgcn_readfirstlane(tid >> 6), lane = tid & 63, wr = wid >> 2, wc = wid & 3, fr = lane & 15, fq = lane >> 4;
    PG8_LAS float* As = (PG8_LAS float*)lds; PG8_LAS float* Bs = As + 256 * 33;
    Unit u;
    for (int ui = 0; S.next(ui, u); ++ui) {
        f32x4 acc[2][2][4][2];
#pragma unroll
        for (int a = 0; a < 2; ++a)
#pragma unroll
            for (int b = 0; b < 2; ++b)
#pragma unroll
                for (int m = 0; m < 4; ++m)
#pragma unroll
                    for (int n = 0; n < 2; ++n) acc[a][b][m][n] = (f32x4){0.f, 0.f, 0.f, 0.f};
        for (int k0 = 0; k0 < g.K; k0 += 32) {
            __syncthreads();
            for (int i = tid; i < 256 * 32; i += 512) { const int r = i >> 5, c = i & 31;
                As[r * 33 + c] = __uint_as_float(((unsigned)g.A[(size_t)(u.pm * 256 + r) * g.lda + k0 + c]) << 16);
                Bs[r * 33 + c] = __uint_as_float(((unsigned)g.Bt[(size_t)(u.pn * 256 + r) * g.K + k0 + c]) << 16); }
            __syncthreads();
            for (int kk = 0; kk < 32; ++kk) {
                float a[2][4], b[2][2][4];
#pragma unroll
                for (int ai = 0; ai < 2; ++ai)
#pragma unroll
                    for (int m = 0; m < 4; ++m) a[ai][m] = As[(128 * ai + 64 * wr + 16 * m + fr) * 33 + kk];
#pragma unroll
                for (int bj = 0; bj < 2; ++bj)
#pragma unroll
                    for (int n = 0; n < 2; ++n)
#pragma unroll
                        for (int j = 0; j < 4; ++j) { const int cl = Epi::PERM ? (128 * bj + 32 * wc + 8 * fq + 4 * n + j) : (128 * bj + 32 * wc + 16 * n + 4 * fq + j); b[bj][n][j] = Bs[cl * 33 + kk]; }
#pragma unroll
                for (int ai = 0; ai < 2; ++ai)
#pragma unroll
                    for (int bj = 0; bj < 2; ++bj)
#pragma unroll
                        for (int m = 0; m < 4; ++m)
#pragma unroll
                            for (int n = 0; n < 2; ++n)
#pragma unroll
                                for (int j = 0; j < 4; ++j) acc[ai][bj][m][n][j] += a[ai][m] * b[bj][n][j];
            }
        }
        E(acc, u, wr, wc, fr, fq);
    }
    __syncthreads();
}
}

constexpr int D = 1024, NB = 8, SEQ = 2048, LC = 256, NLAYER = 2;
constexpr int NL = NB * SEQ;
constexpr int NC = NB * LC;
constexpr int MT = NL + NC;
constexpr int GRID_W = 64;
constexpr int RW_W = 384, RW_IN = 1536, HY_W = 256, HY_IN = 768, NA_W = 384, NA_IN = 1152, GATE_IN = 3072, P_IN = 6528;
constexpr int UA_W = 3584;
constexpr int UA_HY = 1536, UA_NA = 2304;
constexpr int WIN_ROWS = UA_W + GATE_IN;
constexpr int FF = 2816, FFE = 3584, NE = 8;
constexpr int MOE_ROWS = 2 * NL + NE * 256;
constexpr int NFEAT = 8;
constexpr float NORM_EPS = 1e-6f, RW_GN_EPS = 64e-5f;

enum { I_X = 0, I_C, I_CTX, I_CCTX, I_ADAW, I_ADAB, I_N1G, I_N2G, I_WIN, I_RWSHIFT, I_RWW0, I_RWW2, I_RWA0, I_RWA2, I_RWG2, I_RWKK, I_RWKA, I_RWRK, I_RWGNG, I_RWGNB,
       I_HYCW, I_HYCB, I_HYW1, I_HYB1, I_HYW2, I_HYB2, I_HYW3, I_HYFREQ, I_HYSKIP, I_NAQG, I_NAKG, I_NARPB, I_WBRRW, I_WBRHY, I_WBRNA, I_WOUT, I_FFW1, I_FFW3, I_FFW2,
       I_MOER, I_MOEW1, I_MOEW3, I_MOEW2, N_IN };

constexpr size_t al256(size_t x) { return (x + 255) & ~(size_t)255; }
constexpr size_t WS_CTL = 0, CTL_ZERO_BYTES = 1u << 20;
constexpr size_t CTL_MODS_OFF = 65536;
static_assert(CTL_MODS_OFF + (size_t)NLAYER * 9 * 6144 * 4 <= CTL_ZERO_BYTES, "mods inside memset region");
constexpr int CW_BAR = 4096;
constexpr int CW_MOECNT = 8192;
constexpr size_t WS_WIN = CTL_ZERO_BYTES;
constexpr size_t SZ_WIN1 = (size_t)WIN_ROWS * D * 2;
constexpr size_t WS_WBR = WS_WIN + 2 * SZ_WIN1;
constexpr size_t SZ_WBR1 = (size_t)D * 1024 * 2;
constexpr size_t WS_WOUT = WS_WBR + 2 * SZ_WBR1;
constexpr size_t SZ_WOUT1 = (size_t)D * D * 2;
constexpr size_t WS_WFF13 = WS_WOUT + 2 * SZ_WOUT1;
constexpr size_t WS_WFF2 = WS_WFF13 + (size_t)2 * FF * D * 2;
constexpr size_t WS_WM13 = WS_WFF2 + (size_t)D * FF * 2;
constexpr size_t WS_WM2 = WS_WM13 + (size_t)NE * 2 * FFE * D * 2;
constexpr size_t WS_CTXRES = WS_WM2 + (size_t)NE * D * FFE * 2;
constexpr size_t WS_FILT = WS_CTXRES + (size_t)NC * D * 4;
constexpr size_t WS_FILTC = WS_FILT + (size_t)2 * 2 * 256 * 4096 * 2;
constexpr size_t WS_H2BUF = WS_FILTC + (size_t)2 * 256 * 512 * 2;
constexpr size_t WS_MISC = WS_H2BUF + (size_t)2 * 2 * 2048 * 64 * 4;
constexpr size_t MISC_SEL = 0;
constexpr size_t MISC_ROWTOK = MISC_SEL + (size_t)NL * 32;
constexpr size_t MISC_ROWWGT = MISC_ROWTOK + (size_t)MOE_ROWS * 4;
constexpr int RWT_W2 = 0, RWT_A2 = 2 * 384 * 64, RWT_G2 = 4 * 384 * 64, RWT_PER_LAYER = 4 * 384 * 64 + 384 * 128;
constexpr size_t MISC_RWT = al256(MISC_ROWWGT + (size_t)MOE_ROWS * 4);
constexpr size_t MISC_ROPE = MISC_RWT + (size_t)2 * (4 * 384 * 64 + 384 * 128) * 2;
constexpr size_t WS_RA = al256(WS_MISC + MISC_ROPE + 64 * 16 * 2 * 4);
constexpr size_t SZ_RA = (size_t)MT * D * 2;
constexpr size_t WS_RB = WS_RA + SZ_RA;
constexpr size_t RB_YHY = (size_t)2 * MT * RW_W * 2;
static_assert(RB_YHY + (size_t)MT * HY_W * 2 <= SZ_RA, "RB map");
constexpr size_t WS_R1 = WS_RB + SZ_RA;
constexpr size_t SZ_UA = (size_t)MT * UA_W * 2;
constexpr size_t R1_FEAT = SZ_UA;
constexpr size_t R1_G = SZ_UA;
constexpr size_t SZ_R1 = (size_t)MOE_ROWS * FFE * 2;
static_assert(SZ_UA + (size_t)MT * NFEAT * RW_W * 2 <= SZ_R1 && SZ_UA + (size_t)MT * GATE_IN * 2 <= SZ_R1 && (size_t)MT * FF * 2 <= SZ_R1, "R1 map");
static_assert((size_t)MOE_ROWS * D * 2 <= 2 * SZ_RA, "A_sorted fits RA+RB");
constexpr size_t R1_H2U = 0;
constexpr size_t WS_END = WS_R1 + SZ_R1;

constexpr int LDS_BYTES = 147456;
constexpr int LDS_CTL_OFF = LDS_BYTES - 256;
constexpr int NWAVES = 8, NTHREADS = 512;

#define GAS __attribute__((address_space(1)))
#define LAS __attribute__((address_space(3)))
typedef unsigned short bf16;
typedef unsigned v4u __attribute__((ext_vector_type(4)));
typedef unsigned v2u __attribute__((ext_vector_type(2)));
typedef float f32x4 __attribute__((ext_vector_type(4)));
typedef float f32x2 __attribute__((ext_vector_type(2)));
__device__ __forceinline__ unsigned f2bf(float f) { unsigned u = __builtin_bit_cast(unsigned, f); return (u + 0x7fffu + ((u >> 16) & 1u)) >> 16; }
__device__ __forceinline__ unsigned pk2(float lo, float hi) { return f2bf(lo) | (f2bf(hi) << 16); }
__device__ __forceinline__ float bf2f(bf16 v) { return __uint_as_float(((unsigned)v) << 16); }
__device__ __forceinline__ float bflo(unsigned w) { return __uint_as_float(w << 16); }
__device__ __forceinline__ float bfhi(unsigned w) { return __uint_as_float(w & 0xffff0000u); }
__device__ __forceinline__ void unpack8(const v4u w, float (&x)[8]) { x[0] = bflo(w.x); x[1] = bfhi(w.x); x[2] = bflo(w.y); x[3] = bfhi(w.y); x[4] = bflo(w.z); x[5] = bfhi(w.z); x[6] = bflo(w.w); x[7] = bfhi(w.w); }
__device__ __forceinline__ v4u pack8(const float (&x)[8]) { v4u w; w.x = pk2(x[0], x[1]); w.y = pk2(x[2], x[3]); w.z = pk2(x[4], x[5]); w.w = pk2(x[6], x[7]); return w; }
__device__ __forceinline__ float sigmoidf_(float x) { return 1.0f / (1.0f + __expf(-x)); }
__device__ __forceinline__ float siluf_(float x) { return x / (1.0f + __expf(-x)); }
__device__ __forceinline__ unsigned pk4_fp8(float a, float b, float c, float d) { int p = __builtin_amdgcn_cvt_pk_fp8_f32(a, b, 0, false); p = __builtin_amdgcn_cvt_pk_fp8_f32(c, d, p, true); return (unsigned)p; }
__device__ __forceinline__ float wave_sum(float v) {
#pragma unroll
    for (int o = 1; o < 64; o <<= 1) v += __shfl_xor(v, o);
    return v;
}
__device__ __forceinline__ float wave_max(float v) {
#pragma unroll
    for (int o = 1; o < 64; o <<= 1) v = fmaxf(v, __shfl_xor(v, o));
    return v;
}
#define LDS_WAIT() asm volatile("s_waitcnt lgkmcnt(0)" ::: "memory")
#define VM_WAIT() asm volatile("s_waitcnt vmcnt(0)" ::: "memory")

#define XB_TMO      128
#define XB_XCNT(j)  (256  + 64 * (j))
#define XB_XSUB(j)  (1280 + 64 * (j))
#define XB_XGEN(j)  (2304 + 64 * (j))
#define XB_TOP      3328
#define XB_TOPGEN   3392
#define XCD_BAR_WORDS 3456
#define XB_SPIN_CAP (1u << 18)
__device__ __forceinline__ unsigned xb_ld(unsigned* p)              { return __hip_atomic_load(p, __ATOMIC_RELAXED, __HIP_MEMORY_SCOPE_AGENT); }
__device__ __forceinline__ unsigned xb_add(unsigned* p, unsigned v) { return __hip_atomic_fetch_add(p, v, __ATOMIC_RELAXED, __HIP_MEMORY_SCOPE_AGENT); }
__device__ __forceinline__ unsigned xb_xcc_id() { return (unsigned)__builtin_amdgcn_s_getreg((3 << 11) | 20) & 0xFu; }
#define XB_SPIN(cond, bar) do { unsigned _sp = 0; while (cond) { __builtin_amdgcn_s_sleep(1); \
    if ((++_sp & 255u) == 0u) { if (xb_ld(&(bar)[XB_TMO])) break; if (_sp > XB_SPIN_CAP) { atomicAdd(&(bar)[XB_TMO], 1u); break; } } } } while (0)
struct XcdBarrier { unsigned* bar; unsigned x; volatile LAS unsigned* st; };
__device__ __forceinline__ XcdBarrier xcd_barrier_post(unsigned* bar, volatile LAS unsigned* st) {
    XcdBarrier b; b.bar = bar; b.x = xb_xcc_id(); b.st = st;
    if (threadIdx.x == 0) (void)xb_add(&bar[XB_XCNT(b.x)], 1u);
    return b;
}
__device__ __forceinline__ void xcd_barrier_complete(unsigned* bar, unsigned x, unsigned& nloc, unsigned& nx) {
    const unsigned G = gridDim.x * gridDim.y * gridDim.z;
    unsigned sum, cnt, mine, sp = 0u;
    for (;;) {
        sum = 0u; cnt = 0u; mine = 0u;
#pragma unroll
        for (unsigned j = 0; j < 16; ++j) { const unsigned c = xb_ld(&bar[XB_XCNT(j)]); sum += c; cnt += (c > 0u) ? 1u : 0u; mine = (j == x) ? c : mine; }
        if (sum == G) break;
        __builtin_amdgcn_s_sleep(1);
        if ((++sp & 255u) == 0u) { if (xb_ld(&bar[XB_TMO])) break; if (sp > XB_SPIN_CAP) { atomicAdd(&bar[XB_TMO], 1u); break; } }
    }
    nloc = mine > 0u ? mine : 1u; nx = cnt > 0u ? cnt : 1u;
}
__device__ __forceinline__ void xcd_barrier(const XcdBarrier& b) {
    asm volatile("s_waitcnt vmcnt(0)" ::: "memory");
    __syncthreads();
    if (threadIdx.x == 0) {
        unsigned* bar = b.bar;
        __builtin_amdgcn_s_waitcnt(0);
        unsigned nloc = b.st[0], nx = b.st[1];
        if (nloc == 0u) { xcd_barrier_complete(bar, b.x, nloc, nx); b.st[0] = nloc; b.st[1] = nx; }
        const unsigned old = xb_add(&bar[XB_XSUB(b.x)], 1u);
        const unsigned gen = old / nloc;
        if (old + 1u == (gen + 1u) * nloc) {
            __builtin_amdgcn_fence(__ATOMIC_RELEASE, "agent");
            asm volatile("s_waitcnt vmcnt(0)" ::: "memory");
            const unsigned og = xb_add(&bar[XB_TOP], 1u);
            const unsigned tg = og / nx;
            if (og + 1u == (tg + 1u) * nx) xb_add(&bar[XB_TOPGEN], 1u);
            else XB_SPIN(xb_ld(&bar[XB_TOPGEN]) == tg, bar);
            __builtin_amdgcn_fence(__ATOMIC_ACQUIRE, "agent");
            xb_add(&bar[XB_XGEN(b.x)], 1u);
            asm volatile("s_waitcnt vmcnt(0)" ::: "memory");
        } else {
            XB_SPIN(xb_ld(&bar[XB_XGEN(b.x)]) == gen, bar);
            __builtin_amdgcn_fence(__ATOMIC_ACQUIRE, "agent");
            asm volatile("s_waitcnt vmcnt(0)" ::: "memory");
        }
    }
    __syncthreads();
}

struct Args { const float* in[N_IN]; float* out; unsigned char* ws; int ph_lo, ph_hi; };
static_assert(sizeof(Args) == N_IN * 8 + 8 + 8 + 8, "Args has no padding");
#define CAS __attribute__((address_space(4)))
typedef const float* cfp;
struct Frame {
    LAS unsigned char* lds;
    int tid, lane, wave, bid, G;
    const CAS cfp* in;
    float* out; unsigned char* ws;
    __device__ __forceinline__ void fresh() { int t = threadIdx.x, b = blockIdx.x, g = gridDim.x; asm volatile("" : "+v"(t), "+s"(b), "+s"(g)); tid = t; lane = t & 63; wave = __builtin_amdgcn_readfirstlane(t >> 6); bid = b; G = g; }
    template <class T> __device__ __forceinline__ T* wsp(size_t off) const { return (T*)(ws + off); }
    __device__ __forceinline__ const float* mods(int li, int r9) const { return (const float*)(ws + CTL_MODS_OFF) + (size_t)(li * 9 + r9) * 6144; }
};

using pg8::Unit; using pg8::cvt_pk_bf16;
template <int ACT  > struct EpiBf16S {
    static constexpr bool PERM = true;
    bf16* O; int ldc; float sc;
    __device__ __forceinline__ void operator()(const f32x4 (&acc)[2][2][4][2], const Unit& u, int wr, int wc, int fr, int fq) const {
        const int row0 = u.pm * 256 + wr * 64 + fr, col0 = u.pn * 256 + wc * 32 + 8 * fq;
        if (ACT == 0 && u.pn >= 6 && u.pn <= 8) {
#pragma unroll
            for (int ai = 0; ai < 2; ++ai)
#pragma unroll
                for (int m = 0; m < 4; ++m) { const int blk = u.pm * 256 + ai * 128 + wr * 64, i = m * 16 + fr;
#pragma unroll
                    for (int bj = 0; bj < 2; ++bj) { const int cb = bj * 128 + wc * 32 + 8 * fq;
                        bf16* tp = O + (size_t)(blk + (cb >> 2)) * ldc + u.pn * 256 + i; const f32x4 v0 = acc[ai][bj][m][0], v1 = acc[ai][bj][m][1];
#pragma unroll
                        for (int e = 0; e < 4; ++e) { tp[e * 64] = (bf16)f2bf(v0[e]); tp[ldc + e * 64] = (bf16)f2bf(v1[e]); } } }
            return; }
        if (ACT == 0 && u.pn >= 12) {
#pragma unroll
            for (int ai = 0; ai < 2; ++ai)
#pragma unroll
                for (int m = 0; m < 4; ++m) { const int blk = u.pm * 256 + ai * 128 + wr * 64, i = m * 16 + fr;
#pragma unroll
                    for (int bj = 0; bj < 2; ++bj) { const int cb = (u.pn - 12) * 256 + bj * 128 + wc * 32 + 8 * fq;
                        if (cb < 384) { const f32x4 v0 = acc[ai][bj][m][0], v1 = acc[ai][bj][m][1];
#pragma unroll
                            for (int e = 0; e < 8; ++e) { const int cv = cb + e, q6 = (cv * 10923) >> 16, r6 = cv - 6 * q6; O[(size_t)(blk + q6) * ldc + 3072 + r6 * 64 + i] = (bf16)f2bf(e < 4 ? v0[e & 3] : v1[e & 3]); } } } }
            return; }
#pragma unroll
        for (int ai = 0; ai < 2; ++ai)
#pragma unroll
            for (int m = 0; m < 4; ++m) { bf16* rowp = O + (size_t)(row0 + ai * 128 + m * 16) * ldc + col0;
#pragma unroll
                for (int bj = 0; bj < 2; ++bj) { f32x4 v0 = acc[ai][bj][m][0], v1 = acc[ai][bj][m][1];
                    if (ACT == 1) {
#pragma unroll
                        for (int j = 0; j < 4; ++j) { v0[j] = sigmoidf_(v0[j] * sc); v1[j] = sigmoidf_(v1[j] * sc); } }
                    v4u w; w.x = cvt_pk_bf16(v0[0], v0[1]); w.y = cvt_pk_bf16(v0[2], v0[3]); w.z = cvt_pk_bf16(v1[0], v1[1]); w.w = cvt_pk_bf16(v1[2], v1[3]);
                    *(v4u*)(rowp + bj * 128) = w; } }
    }
};
template <int MODE  > struct EpiMerge {
    static constexpr bool PERM = true;
    const bf16* Gt; int ldg; bf16* Mo;
    __device__ __forceinline__ void operator()(const f32x4 (&acc)[2][2][4][2], const Unit& u, int wr, int wc, int fr, int fq) const {
        const int row0 = u.pm * 256 + wr * 64 + fr, col0 = u.pn * 256 + wc * 32 + 8 * fq;
#pragma unroll
        for (int ai = 0; ai < 2; ++ai)
#pragma unroll
            for (int m = 0; m < 4; ++m) { const size_t r = (size_t)(row0 + ai * 128 + m * 16);
#pragma unroll
                for (int bj = 0; bj < 2; ++bj) { const int c = col0 + bj * 128;
                    const v4u gw = *(const v4u*)(Gt + r * ldg + c);
                    f32x4 v0 = acc[ai][bj][m][0], v1 = acc[ai][bj][m][1];
                    v0[0] *= bflo(gw.x); v0[1] *= bfhi(gw.x); v0[2] *= bflo(gw.y); v0[3] *= bfhi(gw.y);
                    v1[0] *= bflo(gw.z); v1[1] *= bfhi(gw.z); v1[2] *= bflo(gw.w); v1[3] *= bfhi(gw.w);
                    bf16* mp = Mo + r * D + c;
                    if (MODE == 1) { const v4u mw = *(const v4u*)mp;
                        v0[0] += bflo(mw.x); v0[1] += bfhi(mw.x); v0[2] += bflo(mw.y); v0[3] += bfhi(mw.y);
                        v1[0] += bflo(mw.z); v1[1] += bfhi(mw.z); v1[2] += bflo(mw.w); v1[3] += bfhi(mw.w); }
                    v4u w; w.x = cvt_pk_bf16(v0[0], v0[1]); w.y = cvt_pk_bf16(v0[2], v0[3]); w.z = cvt_pk_bf16(v1[0], v1[1]); w.w = cvt_pk_bf16(v1[2], v1[3]);
                    *(v4u*)mp = w; } }
    }
};
struct EpiRes {
    static constexpr bool PERM = false;
    const float* base_l; float* out_l; const float* base_c; float* out_c; const float* modl; int goff; float sc;
    __device__ __forceinline__ void operator()(const f32x4 (&acc)[2][2][4][2], const Unit& u, int wr, int wc, int fr, int fq) const {
        const bool isl = u.pm < 64; const int pml = isl ? u.pm : u.pm - 64; const int r9 = isl ? (u.pm >> 3) : 8;
        const float* base = isl ? base_l : base_c; float* out = isl ? out_l : out_c; const float* gate = modl + (size_t)r9 * 6144 + goff;
        const int row0 = pml * 256 + wr * 64 + fr, col0 = u.pn * 256 + wc * 32 + 4 * fq;
        f32x4 gv[2][2];
#pragma unroll
        for (int bj = 0; bj < 2; ++bj)
#pragma unroll
            for (int n = 0; n < 2; ++n) gv[bj][n] = *(const f32x4*)(gate + col0 + bj * 128 + n * 16);
#pragma unroll
        for (int ai = 0; ai < 2; ++ai)
#pragma unroll
            for (int m = 0; m < 4; ++m) { const size_t off = (size_t)(row0 + ai * 128 + m * 16) * D + col0;
#pragma unroll
                for (int bj = 0; bj < 2; ++bj)
#pragma unroll
                    for (int n = 0; n < 2; ++n) { const f32x4 bs = *(const f32x4*)(base + off + bj * 128 + n * 16);
                        *(f32x4*)(out + off + bj * 128 + n * 16) = bs + gv[bj][n] * acc[ai][bj][m][n] * sc; } }
    }
};
template <bool F8OUT = false> struct EpiSwiGLU {
    static constexpr bool PERM = true;
    bf16* H; int ldh; int ntl; float sc;
    __device__ __forceinline__ void operator()(const f32x4 (&acc)[2][2][4][2], const Unit& u, int wr, int wc, int fr, int fq) const {
        const int row0 = u.pm * 256 + wr * 64 + fr, col0 = (u.pn % ntl) * 128 + wc * 32 + 8 * fq;
#pragma unroll
        for (int ai = 0; ai < 2; ++ai)
#pragma unroll
            for (int m = 0; m < 4; ++m) { bf16* rowp = H + (size_t)(row0 + ai * 128 + m * 16) * ldh + col0;
                f32x4 h0, h1;
#pragma unroll
                for (int j = 0; j < 4; ++j) { h0[j] = siluf_(acc[ai][0][m][0][j] * sc) * (acc[ai][1][m][0][j] * sc); h1[j] = siluf_(acc[ai][0][m][1][j] * sc) * (acc[ai][1][m][1][j] * sc); }
                if constexpr (F8OUT) { const v2u w8 = {pk4_fp8(8.f * h0[0], 8.f * h0[1], 8.f * h0[2], 8.f * h0[3]), pk4_fp8(8.f * h1[0], 8.f * h1[1], 8.f * h1[2], 8.f * h1[3])};
                    *(v2u*)((unsigned char*)H + (size_t)(row0 + ai * 128 + m * 16) * ldh + col0) = w8; }
                else { v4u w; w.x = cvt_pk_bf16(h0[0], h0[1]); w.y = cvt_pk_bf16(h0[2], h0[3]); w.z = cvt_pk_bf16(h1[0], h1[1]); w.w = cvt_pk_bf16(h1[2], h1[3]);
                    *(v4u*)rowp = w; } }
    }
};
struct EpiMoeY {
    static constexpr bool PERM = true;
    bf16* O; float sc;
    __device__ __forceinline__ void operator()(const f32x4 (&acc)[2][2][4][2], const Unit& u, int wr, int wc, int fr, int fq) const {
        const int row0 = u.pm * 256 + wr * 64 + fr, col0 = (u.pn & 3) * 256 + wc * 32 + 8 * fq;
#pragma unroll
        for (int ai = 0; ai < 2; ++ai)
#pragma unroll
            for (int m = 0; m < 4; ++m) { bf16* rowp = O + (size_t)(row0 + ai * 128 + m * 16) * D + col0;
#pragma unroll
                for (int bj = 0; bj < 2; ++bj) { const f32x4 v0 = acc[ai][bj][m][0] * sc, v1 = acc[ai][bj][m][1] * sc;
                    v4u w; w.x = cvt_pk_bf16(v0[0], v0[1]); w.y = cvt_pk_bf16(v0[2], v0[3]); w.z = cvt_pk_bf16(v1[0], v1[1]); w.w = cvt_pk_bf16(v1[2], v1[3]);
                    *(v4u*)(rowp + bj * 128) = w; } }
    }
};

#if USE_NAIVE_GEMM
#define GEMM_CALL(EpiT, SchedT, lds, g, S, E) pg8::gemm_naive<EpiT, SchedT>(lds, g, S, E)
#else
#define GEMM_CALL(EpiT, SchedT, lds, g, S, E) pg8::gemm_phase<EpiT, SchedT, true, true>(lds, g, S, E)
#define GEMM_CALL_F8(EpiT, SchedT, lds, g, S, E) pg8::gemm_phase<EpiT, SchedT, true, true, true>(lds, g, S, E)
#endif

__device__ __forceinline__ void tr_item(const float* W, int ldw, int col0, int ncols, int K, bf16* WT, int mode, int row_off, LAS float* scr, int item, int lane) {
    const int nblk = ncols / 32, kb = item / nblk, nb = item % nblk, k0 = 64 * kb, n0 = 32 * nb;
    float tv[32];
#pragma unroll
    for (int i = 0; i < 32; ++i) { const int kk = 2 * i + (lane >> 5); tv[i] = W[(size_t)(k0 + kk) * ldw + col0 + n0 + (lane & 31)]; }
#pragma unroll
    for (int i = 0; i < 32; ++i) { const int kk = 2 * i + (lane >> 5); scr[kk * 33 + (lane & 31)] = tv[i]; }
    LDS_WAIT(); asm volatile("" ::: "memory");
    const int c = lane & 7;
#pragma unroll
    for (int j = 0; j < 4; ++j) { const int n = (lane >> 3) + 8 * j; const LAS float* s = scr + (8 * c) * 33 + n;
        const int nn = n0 + n; const int drow = (mode & 3) == 0 ? row_off + nn : row_off + (nn >> 7) * 256 + (nn & 127);
        if (mode & 4) { const v2u o8 = {pk4_fp8(32.f * s[0 * 33], 32.f * s[1 * 33], 32.f * s[2 * 33], 32.f * s[3 * 33]), pk4_fp8(32.f * s[4 * 33], 32.f * s[5 * 33], 32.f * s[6 * 33], 32.f * s[7 * 33])};
            *(v2u*)((unsigned char*)WT + (size_t)drow * K + k0 + 8 * c) = o8; }
        else { v4u o; o.x = pk2(s[0 * 33], s[1 * 33]); o.y = pk2(s[2 * 33], s[3 * 33]); o.z = pk2(s[4 * 33], s[5 * 33]); o.w = pk2(s[6 * 33], s[7 * 33]);
            *(v4u*)(WT + (size_t)drow * K + k0 + 8 * c) = o; } }
    LDS_WAIT(); asm volatile("" ::: "memory");
}
struct TrDesc { const float* W; int ldw, col0, ncols, K; bf16* WT; int mode, row_off; };
__device__ __forceinline__ void tr_desc_small(const Frame& F, int idx, TrDesc& d) {
    if (idx < 12) { const int li = idx / 6, k = idx % 6;
        if (k == 0) d = TrDesc{F.in[I_WIN] + (size_t)li * D * P_IN, P_IN, 0, 3456, D, F.wsp<bf16>(WS_WIN + li * SZ_WIN1), 0, 0};
        else if (k == 1) d = TrDesc{F.in[I_WIN] + (size_t)li * D * P_IN, P_IN, 3456, GATE_IN, D, F.wsp<bf16>(WS_WIN + li * SZ_WIN1 + (size_t)UA_W * D * 2), 4, 0};
        else if (k == 2) d = TrDesc{F.in[I_WBRRW] + (size_t)li * RW_W * D, D, 0, D, RW_W, F.wsp<bf16>(WS_WBR + li * SZ_WBR1), 0, 0};
        else if (k == 3) d = TrDesc{F.in[I_WBRHY] + (size_t)li * HY_W * D, D, 0, D, HY_W, F.wsp<bf16>(WS_WBR + li * SZ_WBR1 + (size_t)D * RW_W * 2), 0, 0};
        else if (k == 4) d = TrDesc{F.in[I_WBRNA] + (size_t)li * NA_W * D, D, 0, D, NA_W, F.wsp<bf16>(WS_WBR + li * SZ_WBR1 + (size_t)D * (RW_W + HY_W) * 2), 0, 0};
        else d = TrDesc{F.in[I_WOUT] + (size_t)li * D * D, D, 0, D, D, F.wsp<bf16>(WS_WOUT + li * SZ_WOUT1), 0, 0};
    } else if (idx == 12) d = TrDesc{F.in[I_FFW1], FF, 0, FF, D, F.wsp<bf16>(WS_WFF13), 1, 0};
    else if (idx == 13) d = TrDesc{F.in[I_FFW3], FF, 0, FF, D, F.wsp<bf16>(WS_WFF13), 1, 128};
    else d = TrDesc{F.in[I_FFW2], D, 0, D, FF, F.wsp<bf16>(WS_WFF2), 0, 0};
}
__device__ __forceinline__ void tr_load(const TrDesc& d, int item, int lane, float (&tv)[32]) {
    const int nblk = d.ncols / 32, kb = item / nblk, nb = item % nblk, k0 = 64 * kb, n0 = 32 * nb;
#pragma unroll
    for (int i = 0; i < 32; ++i) { const int kk = 2 * i + (lane >> 5); tv[i] = d.W[(size_t)(k0 + kk) * d.ldw + d.col0 + n0 + (lane & 31)]; }
}
__device__ __forceinline__ void tr_store(const TrDesc& d, int item, int lane, const float (&tv)[32], LAS float* scr) {
    const int nblk = d.ncols / 32, kb = item / nblk, nb = item % nblk, k0 = 64 * kb, n0 = 32 * nb;
#pragma unroll
    for (int i = 0; i < 32; ++i) { const int kk = 2 * i + (lane >> 5); scr[kk * 33 + (lane & 31)] = tv[i]; }
    LDS_WAIT(); asm volatile("" ::: "memory");
    const int c = lane & 7;
#pragma unroll
    for (int j = 0; j < 4; ++j) { const int n = (lane >> 3) + 8 * j; const LAS float* s = scr + (8 * c) * 33 + n;
        const int nn = n0 + n; const int drow = (d.mode & 3) == 0 ? d.row_off + nn : d.row_off + (nn >> 7) * 256 + (nn & 127);
        if (d.mode & 4) { const v2u o8 = {pk4_fp8(32.f * s[0 * 33], 32.f * s[1 * 33], 32.f * s[2 * 33], 32.f * s[3 * 33]), pk4_fp8(32.f * s[4 * 33], 32.f * s[5 * 33], 32.f * s[6 * 33], 32.f * s[7 * 33])};
            *(v2u*)((unsigned char*)d.WT + (size_t)drow * d.K + k0 + 8 * c) = o8; }
        else { v4u o; o.x = pk2(s[0 * 33], s[1 * 33]); o.y = pk2(s[2 * 33], s[3 * 33]); o.z = pk2(s[4 * 33], s[5 * 33]); o.w = pk2(s[6 * 33], s[7 * 33]);
            *(v4u*)(d.WT + (size_t)drow * d.K + k0 + 8 * c) = o; } }
    LDS_WAIT(); asm volatile("" ::: "memory");
}
__device__ __forceinline__ void moe_desc(const Frame& F, int mi, TrDesc& d) { const int e = mi / 3, w = mi % 3;
    if (w == 0) d = TrDesc{F.in[I_MOEW1] + (size_t)e * D * FFE, FFE, 0, FFE, D, F.wsp<bf16>(WS_WM13), 1 | 4, e * 2 * FFE};
    else if (w == 1) d = TrDesc{F.in[I_MOEW3] + (size_t)e * D * FFE, FFE, 0, FFE, D, F.wsp<bf16>(WS_WM13), 1 | 4, e * 2 * FFE + 128};
    else d = TrDesc{F.in[I_MOEW2] + (size_t)e * FFE * D, D, 0, D, FFE, F.wsp<bf16>(WS_WM2), 0 | 4, e * D}; }
__device__ __forceinline__ void moe_weight_transposes(Frame& F) {
    const int gw = F.bid * NWAVES + F.wave, NGW = F.G * NWAVES;
    LAS float* scr = (LAS float*)(F.lds + F.wave * 16384);
    constexpr int MOE_ITEMS = 1792, NIT = 24 * MOE_ITEMS;
    int it = gw; if (it >= NIT) return;
    TrDesc dc; moe_desc(F, it / MOE_ITEMS, dc); float tvc[32]; tr_load(dc, it % MOE_ITEMS, F.lane, tvc);
#pragma unroll 1
    for (;;) {
        const int itn = it + NGW; const bool hn = itn < NIT; TrDesc dn = dc; float tvn[32];
        if (hn) { moe_desc(F, itn / MOE_ITEMS, dn); tr_load(dn, itn % MOE_ITEMS, F.lane, tvn); }
        tr_store(dc, it % MOE_ITEMS, F.lane, tvc, scr);
        if (!hn) break;
        dc = dn; it = itn;
#pragma unroll
        for (int i = 0; i < 32; ++i) tvc[i] = tvn[i];
    }
}
__device__ __forceinline__ void p0_prologue(Frame& F) {
    const int gw = F.bid * NWAVES + F.wave, NGW = F.G * NWAVES;
    for (int i = F.bid * NTHREADS + F.tid; i < 2 * 128 * D / 8; i += F.G * NTHREADS) { const int li = i / (128 * D / 8), r = i % (128 * D / 8);
        *(v4u*)(F.wsp<bf16>(WS_WIN + li * SZ_WIN1) + (size_t)3456 * D + (size_t)r * 8) = (v4u){0u, 0u, 0u, 0u}; }
    for (int i = F.bid * NTHREADS + F.tid; i < 2 * RWT_PER_LAYER; i += F.G * NTHREADS) { const int li = i / RWT_PER_LAYER, idx = i % RWT_PER_LAYER; float v;
        if (idx < 4 * 384 * 64) { const int m = idx / (384 * 64), rem = idx % (384 * 64), nn = rem >> 6, k = rem & 63;
            v = m < 2 ? F.in[I_RWW2][((size_t)(li * 2 + m) * 64 + k) * RW_W + nn] : F.in[I_RWA2][((size_t)(li * 2 + (m - 2)) * 64 + k) * RW_W + nn]; }
        else { const int rem = idx - 4 * 384 * 64, nn = rem >> 7, k = rem & 127; v = F.in[I_RWG2][((size_t)li * 128 + k) * RW_W + nn]; }
        F.wsp<bf16>(WS_MISC + MISC_RWT)[i] = (bf16)f2bf(v); }
    if (F.bid == 0) { for (int i = F.tid; i < 1024; i += NTHREADS) { const int pos = i >> 4, fi = i & 15; float sn, cs; sincosf((float)pos * powf(10000.0f, -(float)fi / 16.0f), &sn, &cs);
        float* rt = F.wsp<float>(WS_MISC + MISC_ROPE) + 2 * i; rt[0] = cs; rt[1] = sn; } }
    {
        LAS float* zs = (LAS float*)F.lds;
        LAS float* h1s = zs + 64 * 36;
        const int pl = F.tid >> 3, sub = F.tid & 7;
#pragma unroll 1
        for (int job = F.bid; job < 72; job += F.G) { const int li = job / 36, q = job % 36, seg = q >= 32 ? 1 : 0, p = (seg ? q - 32 : q) * 64 + pl, n = seg ? 256 : 2048;
            __syncthreads();
            if (sub == 0) zs[pl * 36] = (float)p / (float)(n - 1);
#pragma unroll
            for (int e = 0; e < 4; ++e) { const int i = 1 + sub * 4 + e, fi = (i - 1) & 15; const float f = 1e-4f + (float)fi * ((15.0f - 1e-4f) / 15.0f); const float ang = (6.283185307179586f / (float)n) * (float)p * f;
                zs[pl * 36 + i] = i <= 16 ? cosf(ang) : -sinf(ang); }
            __syncthreads();
            const float* w1 = F.in[I_HYW1] + li * 33 * 64 + sub * 8; const float* b1 = F.in[I_HYB1] + li * 64 + sub * 8; const float* fr = F.in[I_HYFREQ] + li * 64 + sub * 8;
            float a[8];
#pragma unroll
            for (int e = 0; e < 8; ++e) a[e] = b1[e];
#pragma unroll 3
            for (int i = 0; i < 33; ++i) { const float z = zs[pl * 36 + i]; const f32x4 wa = *(const f32x4*)(w1 + i * 64), wb = *(const f32x4*)(w1 + i * 64 + 4);
                a[0] += z * wa.x; a[1] += z * wa.y; a[2] += z * wa.z; a[3] += z * wa.w; a[4] += z * wb.x; a[5] += z * wb.y; a[6] += z * wb.z; a[7] += z * wb.w; }
#pragma unroll
            for (int e = 0; e < 8; ++e) h1s[pl * 68 + sub * 8 + e] = sinf(fr[e] * a[e]);
            __syncthreads();
            const float* w2 = F.in[I_HYW2] + li * 64 * 64 + sub * 8; const float* b2 = F.in[I_HYB2] + li * 64 + sub * 8;
#pragma unroll
            for (int e = 0; e < 8; ++e) a[e] = b2[e];
#pragma unroll 4
            for (int i = 0; i < 64; ++i) { const float z = h1s[pl * 68 + i]; const f32x4 wa = *(const f32x4*)(w2 + i * 64), wb = *(const f32x4*)(w2 + i * 64 + 4);
                a[0] += z * wa.x; a[1] += z * wa.y; a[2] += z * wa.z; a[3] += z * wa.w; a[4] += z * wb.x; a[5] += z * wb.y; a[6] += z * wb.z; a[7] += z * wb.w; }
            float* o = F.wsp<float>(WS_H2BUF) + ((size_t)(li * 2 + seg) * 2048 + p) * 64 + sub * 8;
            *(f32x4*)o = (f32x4){sinf(fr[0] * a[0]), sinf(fr[1] * a[1]), sinf(fr[2] * a[2]), sinf(fr[3] * a[3])}; *(f32x4*)(o + 4) = (f32x4){sinf(fr[4] * a[4]), sinf(fr[5] * a[5]), sinf(fr[6] * a[6]), sinf(fr[7] * a[7])};
        }
    }
    __syncthreads();
    if (F.bid < 2 * 96) {
        LAS float* act = (LAS float*)F.lds;
        LAS float* part = act + 9 * 1024;
        for (int i = F.tid; i < 9 * 1024; i += NTHREADS) { const int r = i >> 10, k = i & 1023; const float v = r < 8 ? F.in[I_C][r * D + k] : F.in[I_CCTX][k]; act[i] = siluf_(v); }
        __syncthreads();
#pragma unroll 1
        for (int job = F.bid; job < 2 * 96; job += F.G) { const int li = job / 96, cb = job % 96; const int c = F.tid & 63, kg = F.tid >> 6, col = cb * 64 + c;
            float a[9];
#pragma unroll
            for (int r = 0; r < 9; ++r) a[r] = 0.f;
            const float* wp = F.in[I_ADAW] + ((size_t)li * D + kg * 128) * 6144 + col;
#pragma unroll 1
            for (int k0 = 0; k0 < 128; k0 += 16) { float w[16];
#pragma unroll
                for (int u = 0; u < 16; ++u) w[u] = wp[(size_t)(k0 + u) * 6144];
#pragma unroll
                for (int u = 0; u < 16; ++u)
#pragma unroll
                    for (int r = 0; r < 9; ++r) a[r] += act[r * 1024 + kg * 128 + k0 + u] * w[u]; }
#pragma unroll
            for (int r = 0; r < 9; ++r) part[(kg * 9 + r) * 64 + c] = a[r];
            __syncthreads();
            for (int i = F.tid; i < 9 * 64; i += NTHREADS) { const int r = i >> 6, cc = i & 63; float s = F.in[I_ADAB][li * 6144 + cb * 64 + cc];
#pragma unroll
                for (int g = 0; g < 8; ++g) s += part[(g * 9 + r) * 64 + cc];
                ((float*)(F.ws + CTL_MODS_OFF))[(size_t)(li * 9 + r) * 6144 + cb * 64 + cc] = s; }
            __syncthreads();
        }
    }
    __syncthreads();
    {
        LAS float* scr = (LAS float*)(F.lds + F.wave * 16384);
        for (int mi = 0; mi < 15; ++mi) { TrDesc d; tr_desc_small(F, mi, d); const int items = (d.K / 64) * (d.ncols / 32);
            for (int it = gw; it < items; it += NGW) tr_item(d.W, d.ldw, d.col0, d.ncols, d.K, d.WT, d.mode, d.row_off, scr, it, F.lane); }
    }
}

__device__ __forceinline__ void norm_row(const float* xrow, const float* g, const float* shift, const float* scale, int lane, f32x4 (&v)[4]) {
    const f32x4* xr = (const f32x4*)xrow + lane; float s = 0.f;
#pragma unroll
    for (int j = 0; j < 4; ++j) { v[j] = xr[64 * j]; s += (v[j].x * v[j].x + v[j].y * v[j].y) + (v[j].z * v[j].z + v[j].w * v[j].w); }
    const float rs = 1.0f / sqrtf(wave_sum(s) * (1.f / D) + NORM_EPS);
#pragma unroll
    for (int j = 0; j < 4; ++j) { const f32x4 gg = ((const f32x4*)g)[lane + 64 * j], sh = ((const f32x4*)shift)[lane + 64 * j], sc = ((const f32x4*)scale)[lane + 64 * j];
        v[j] = (v[j] * rs * gg) * (sc + 1.0f) + sh; }
}
__device__ __forceinline__ void store_row_bf16(bf16* orow, int lane, const f32x4 (&v)[4]) {
    v2u* o8 = (v2u*)orow + lane;
#pragma unroll
    for (int j = 0; j < 4; ++j) { v2u w; w.x = pk2(v[j].x, v[j].y); w.y = pk2(v[j].z, v[j].w); o8[64 * j] = w; }
}
__device__ __forceinline__ void hy_filter_job(Frame& F, int layer, int seg, int o, int cg) {
    const int n = seg ? 256 : 2048;
    const float* w3 = F.in[I_HYW3] + (size_t)layer * 64 * 1024;
    const float* h2b = F.wsp<float>(WS_H2BUF) + (size_t)(layer * 2 + seg) * 2048 * 64;
    LAS float* raw = (LAS float*)F.lds;
    LAS float* red = raw + 2048 * 16;
    LAS float* wl = red + 64;
    const float mind = -3.0701134573253945f, maxd = -15.350567286626972f;
    float asum[8];
#pragma unroll
    for (int c = 0; c < 8; ++c) asum[c] = 0.f;
    __syncthreads();
    for (int i = F.tid; i < 1024; i += NTHREADS) { const int q = i >> 6, k = i & 63; wl[i] = w3[(size_t)k * 1024 + o * 512 + (q >> 3) * 256 + cg * 8 + (q & 7)]; }
    __syncthreads();
#pragma unroll 1
    for (int p = F.tid; p < n; p += NTHREADS) {
        f32x4 h[16];
#pragma unroll
        for (int i = 0; i < 16; ++i) h[i] = ((const f32x4*)(h2b + (size_t)p * 64))[i];
        const float tt = (float)p / (float)(n - 1);
#pragma unroll 1
        for (int q = 0; q < 16; ++q) { const int dir = q >> 3, c = q & 7, ch = cg * 8 + c, col = o * 512 + dir * 256 + ch; float a = 0.f;
            (void)col;
#pragma unroll
            for (int i = 0; i < 16; ++i) { const f32x4 w4 = *(const LAS f32x4*)(wl + q * 64 + 4 * i); a += h[i].x * w4.x; a += h[i].y * w4.y; a += h[i].z * w4.z; a += h[i].w * w4.w; }
            const float delta = fabsf(mind + (maxd - mind) * ((float)ch / 255.0f));
            a *= __expf(-tt * delta);
            raw[p * 16 + q] = a;
            const float aa = (dir == 0 || p >= 1) ? fabsf(a) : 0.f;
#pragma unroll
            for (int k = 0; k < 8; ++k) asum[k] += (k == c) ? aa : 0.f; }
    }
#pragma unroll
    for (int c = 0; c < 8; ++c) asum[c] = wave_sum(asum[c]);
    if (F.lane == 0) {
#pragma unroll
        for (int c = 0; c < 8; ++c) red[F.wave * 8 + c] = asum[c]; }
    __syncthreads();
    float inv[8];
#pragma unroll
    for (int c = 0; c < 8; ++c) { float l1 = 0.f;
#pragma unroll
        for (int w = 0; w < 8; ++w) l1 += red[w * 8 + c];
        inv[c] = 1.0f / l1; }
    bf16* dst = seg ? F.wsp<bf16>(WS_FILTC) + (size_t)(o * 256 + cg * 8) * 512 : F.wsp<bf16>(WS_FILT) + (size_t)((layer * 2 + o) * 256 + cg * 8) * 4096;
    const int stride = 2 * n;
#pragma unroll 1
    for (int i = F.tid; i < 8 * n; i += NTHREADS) { const int c = i / n, p = i - c * n; float ic = 0.f;
#pragma unroll
        for (int k = 0; k < 8; ++k) ic = (k == c) ? inv[k] : ic;
        dst[(size_t)c * stride + n + p] = (bf16)f2bf(raw[p * 16 + c] * ic);
        if (p >= 1) dst[(size_t)c * stride + n - p] = (bf16)f2bf(raw[p * 16 + 8 + c] * ic); }
    if (F.tid < 8) dst[(size_t)F.tid * stride] = 0;
}
#define A1F8_PTR(F_, li_) ((li_) == 0 ? (unsigned char*)(F_).out : (F_).ws + WS_WFF13)
static_assert((size_t)NL * D <= (size_t)2 * FF * D * 2 + (size_t)D * FF * 2, "fp8 A1 copy of the last layer fits in the dense FFN weight region");
__device__ __forceinline__ void p1_norm1(Frame& F, int li) {
    const int gw = F.bid * NWAVES + F.wave, NGW = F.G * NWAVES;
    bf16* A1 = F.wsp<bf16>(WS_RA);
    const float* xl = li == 0 ? F.in[I_X] : F.out; const float* xc = li == 0 ? F.in[I_CTX] : F.wsp<float>(WS_CTXRES);
    const float* g = F.in[I_N1G] + li * D;
    unsigned char* a1f8 = A1F8_PTR(F, li);
    for (int row = gw; row < MT; row += NGW) { const bool isl = row < NL; const int r9 = isl ? row >> 11 : 8;
        const float* xr = isl ? xl + (size_t)row * D : xc + (size_t)(row - NL) * D; const float* md = F.mods(li, r9);
        f32x4 v[4]; norm_row(xr, g, md + 0 * D, md + 1 * D, F.lane, v); store_row_bf16(A1 + (size_t)row * D, F.lane, v);
        if (li == 0 || isl) { unsigned* o4 = (unsigned*)(a1f8 + (size_t)row * D) + F.lane;
#pragma unroll
            for (int j = 0; j < 4; ++j) o4[64 * j] = pk4_fp8(v[j].x, v[j].y, v[j].z, v[j].w); } }
    if (li == 0) {
        __syncthreads();
        for (int job = F.bid; job < 192; job += F.G) {
            { const int seg = job >= 128 ? 1 : 0, j2 = job - 128 * seg; hy_filter_job(F, seg ? 0 : j2 >> 6, seg, (j2 >> 5) & 1, j2 & 31); }
            __syncthreads(); }
    }
}

__device__ __forceinline__ void rw_scan_chain(Frame& F, int li, int chain) {
    const int b = chain / 12, h = (chain % 12) >> 1, d = chain & 1, lane = F.lane;
    const bf16* FEAT = F.wsp<bf16>(WS_R1 + R1_FEAT); float* Y = F.wsp<float>(WS_RB);
    LAS float* bc = (LAS float*)(F.lds + F.wave * 2048);
    const float k_k = F.in[I_RWKK][li * RW_W + h * 64 + lane], k_a = F.in[I_RWKA][li * RW_W + h * 64 + lane];
    float S[64];
#pragma unroll
    for (int k = 0; k < 64; ++k) S[k] = 0.f;
    const int fe = 3 + d, fi = 5 + d;
    for (int seg = 0; seg < 2; ++seg) { const int n = seg ? SEQ : LC; const int base = seg ? b * SEQ : NL + b * LC;
        int t = d ? n - 1 : 0;
        const bf16* fp = FEAT + (size_t)(base + t) * NFEAT * RW_W + h * 64 + lane;
        bf16 nr = fp[0], nk = fp[RW_W], nv = fp[2 * RW_W], ne = fp[fe * RW_W], ni = fp[fi * RW_W];
        for (int step = 0; step < n; ++step) {
            const float r = bf2f(nr), k = bf2f(nk), v = bf2f(nv), e = bf2f(ne), ic = bf2f(ni);
            const int row = base + t;
            if (step + 1 < n) { t = d ? t - 1 : t + 1; fp = FEAT + (size_t)(base + t) * NFEAT * RW_W + h * 64 + lane; nr = fp[0]; nk = fp[RW_W]; nv = fp[2 * RW_W]; ne = fp[fe * RW_W]; ni = fp[fi * RW_W]; }
            float kkv = k * k_k; const float ss = wave_sum(kkv * kkv); kkv = kkv / fmaxf(sqrtf(ss), 1e-12f);
            bc[0 * 64 + lane] = __expf(-e); bc[1 * 64 + lane] = k * (1.0f + (ic - 1.0f) * k_a); bc[2 * 64 + lane] = -kkv; bc[3 * 64 + lane] = kkv * ic; bc[4 * 64 + lane] = r;
            LDS_WAIT(); asm volatile("" ::: "memory");
            float sa = 0.f;
#pragma unroll
            for (int k4 = 0; k4 < 16; ++k4) { const f32x4 a4 = ((const LAS f32x4*)(bc + 2 * 64))[k4]; sa += S[4 * k4] * a4.x + S[4 * k4 + 1] * a4.y + S[4 * k4 + 2] * a4.z + S[4 * k4 + 3] * a4.w; }
            float y = 0.f;
#pragma unroll
            for (int k4 = 0; k4 < 16; ++k4) { const f32x4 w4 = ((const LAS f32x4*)(bc + 0 * 64))[k4], kd4 = ((const LAS f32x4*)(bc + 1 * 64))[k4], b4 = ((const LAS f32x4*)(bc + 3 * 64))[k4], r4 = ((const LAS f32x4*)(bc + 4 * 64))[k4];
                S[4 * k4 + 0] = S[4 * k4 + 0] * w4.x + sa * b4.x + v * kd4.x; y += S[4 * k4 + 0] * r4.x;
                S[4 * k4 + 1] = S[4 * k4 + 1] * w4.y + sa * b4.y + v * kd4.y; y += S[4 * k4 + 1] * r4.y;
                S[4 * k4 + 2] = S[4 * k4 + 2] * w4.z + sa * b4.z + v * kd4.z; y += S[4 * k4 + 2] * r4.z;
                S[4 * k4 + 3] = S[4 * k4 + 3] * w4.w + sa * b4.w + v * kd4.w; y += S[4 * k4 + 3] * r4.w; }
            __hip_atomic_fetch_add(Y + (size_t)row * RW_W + h * 64 + lane, y, __ATOMIC_RELAXED, __HIP_MEMORY_SCOPE_AGENT);
            asm volatile("" ::: "memory");
        }
    }
}

__device__ __forceinline__ float hy_short(const bf16* U, const float* cw, float cb, int rowbase, int t, int n, int chcol) {
    const float u0 = t > 0 ? bf2f(U[(size_t)(rowbase + t - 1) * UA_W + UA_HY + chcol]) : 0.f;
    const float u1 = bf2f(U[(size_t)(rowbase + t) * UA_W + UA_HY + chcol]);
    const float u2 = t < n - 1 ? bf2f(U[(size_t)(rowbase + t + 1) * UA_W + UA_HY + chcol]) : 0.f;
    return cb + cw[0] * u0 + cw[HY_IN] * u1 + cw[2 * HY_IN] * u2;
}
__device__ __forceinline__ void hy_job(Frame& F, int li, int seg, int b, int cg) {
    const int n = seg ? LC : SEQ, rowbase = seg ? NL + b * LC : b * SEQ;
    bf16* U = F.wsp<bf16>(WS_R1);
    LAS bf16* zA = (LAS bf16*)F.lds; LAS bf16* zB = zA + 2048 * 8; LAS bf16* Fl = zB + 2048 * 8;
    const float* cw = F.in[I_HYCW] + (size_t)li * 3 * HY_IN; const float* cbv = F.in[I_HYCB] + (size_t)li * HY_IN;
    __syncthreads();
    for (int idx = F.tid; idx < n * 8; idx += NTHREADS) { const int t = idx >> 3, c = idx & 7, ch = cg * 8 + c;
        zA[idx] = (bf16)f2bf(hy_short(U, cw + ch, cbv[ch], rowbase, t, n, ch)); }
    LAS bf16* zin = zA; LAS bf16* zout = zB;
    for (int o = 0; o < 2; ++o) {
        const bf16* fsrc = seg ? F.wsp<bf16>(WS_FILTC) + (size_t)(o * 256 + cg * 8) * 512 : F.wsp<bf16>(WS_FILT) + (size_t)((li * 2 + o) * 256 + cg * 8) * 4096;
        __syncthreads();
        for (int idx = F.tid; idx < 8 * 2 * n / 8; idx += NTHREADS) ((LAS v4u*)Fl)[idx] = ((const v4u*)fsrc)[idx];
        __syncthreads();
        const int c = F.tid & 7, tq = F.tid >> 3, ch = cg * 8 + c;
        const LAS bf16* fl = Fl + c * 2 * n;
        const float skip = F.in[I_HYSKIP][(li * 2 + o) * HY_W + ch];
        const int xcol = (o + 1) * HY_W + ch;
        for (int blk = 0; blk < n / 512 + (n < 512 ? 1 : 0); ++blk) { const int t0 = (blk * 64 + tq) * 8;
            if (t0 < n) {
                float acc[8];
#pragma unroll
                for (int j = 0; j < 8; ++j) acc[j] = 0.f;
                for (int s8 = 0; s8 < n; s8 += 8) {
                    float fw[15], zz[8];
                    const int fb = t0 - s8 - 7 + n;
#pragma unroll
                    for (int i = 0; i < 15; ++i) fw[i] = bf2f(fl[fb + i]);
#pragma unroll
                    for (int q = 0; q < 8; ++q) zz[q] = bf2f(zin[(s8 + q) * 8 + c]);
#pragma unroll
                    for (int j = 0; j < 8; ++j)
#pragma unroll
                        for (int q = 0; q < 8; ++q) acc[j] += fw[j - q + 7] * zz[q];
                }
#pragma unroll
                for (int j = 0; j < 8; ++j) { const int t = t0 + j; const float xo = hy_short(U, cw + xcol, cbv[xcol], rowbase, t, n, xcol);
                    const float zo = bf2f(zin[t * 8 + c]); const float zn = xo * (acc[j] + skip * zo);
                    if (o == 0) zout[t * 8 + c] = (bf16)f2bf(zn); else U[(size_t)(rowbase + t) * UA_W + UA_HY + ch] = (bf16)f2bf(zn); }
            } }
        LAS bf16* tmp = zin; zin = zout; zout = tmp;
    }
    __syncthreads();
#undef HY_STAGE_RAW
#undef HY_CONV
}

__device__ __forceinline__ void na_job(Frame& F, int li, int kind, int b, int h, int blk) {
    bf16* U = F.wsp<bf16>(WS_R1);
    LAS float* qs = (LAS float*)F.lds; LAS float* ks = qs + 64 * 65; LAS float* Sc = ks + 64 * 65;
    constexpr int SP = 388;
    const int nloc = kind == 0 ? 128 : 0, ntot = nloc + 256, nch = kind == 0 ? 12 : 4;
    const int qrow0 = kind == 0 ? b * SEQ + blk * 64 : NL + b * LC + blk * 64;
    const int gi = blk, r0 = min(max(gi - 4, 0), 24);
    const int qi = F.tid >> 3, sub = F.tid & 7, d0 = sub * 8;
    const int c0 = min(max(qi - 8, 0), 48);
    const float* qg = F.in[I_NAQG] + li * 64; const float* kg = F.in[I_NAKG] + li * 64;
    const float* rpb = F.in[I_NARPB] + (size_t)(li * 6 + h) * 15 * 31;
    __syncthreads();
    { const v4u w = *(const v4u*)(U + (size_t)(qrow0 + qi) * UA_W + UA_NA + h * 64 + d0);
      float x[8] = {bflo(w.x), bfhi(w.x), bflo(w.y), bfhi(w.y), bflo(w.z), bfhi(w.z), bflo(w.w), bfhi(w.w)}; float ss = 0.f;
#pragma unroll
      for (int e = 0; e < 8; ++e) ss += x[e] * x[e];
      ss += __shfl_xor(ss, 1); ss += __shfl_xor(ss, 2); ss += __shfl_xor(ss, 4);
      const float sc = 0.125f / sqrtf(ss * (1.f / 64.f) + NORM_EPS);
#pragma unroll
      for (int e = 0; e < 8; ++e) qs[qi * 65 + d0 + e] = x[e] * sc * qg[d0 + e]; }
    for (int ch = 0; ch < nch; ++ch) {
        const bool loc = kind == 0 && ch < 8; const int cc = kind == 0 ? ch - 8 : ch;
        const int krow0 = loc ? b * SEQ + (r0 + ch) * 64 : NL + b * LC + cc * 64;
        __syncthreads();
        { const v4u w = *(const v4u*)(U + (size_t)(krow0 + qi) * UA_W + UA_NA + NA_W + h * 64 + d0);
          float x[8] = {bflo(w.x), bfhi(w.x), bflo(w.y), bfhi(w.y), bflo(w.z), bfhi(w.z), bflo(w.w), bfhi(w.w)}; float ss = 0.f;
#pragma unroll
          for (int e = 0; e < 8; ++e) ss += x[e] * x[e];
          ss += __shfl_xor(ss, 1); ss += __shfl_xor(ss, 2); ss += __shfl_xor(ss, 4);
          const float sc = 1.0f / sqrtf(ss * (1.f / 64.f) + NORM_EPS);
#pragma unroll
          for (int e = 0; e < 8; ++e) ks[qi * 65 + d0 + e] = x[e] * sc * kg[d0 + e]; }
        __syncthreads();
        if (loc) {
#pragma unroll 1
            for (int e = 0; e < 2; ++e) { const int kc = c0 + sub * 2 + e; float s = 0.f;
#pragma unroll 8
                for (int dd = 0; dd < 64; ++dd) s += qs[qi * 65 + dd] * ks[kc * 65 + dd];
                const int dr = (r0 + ch) - gi + 7, dc = min(max(kc - qi + 15, 0), 30);
                Sc[qi * SP + ch * 16 + sub * 2 + e] = s + rpb[dr * 31 + dc]; }
        } else {
#pragma unroll 1
            for (int e = 0; e < 8; ++e) { const int kj = sub * 8 + e; float s = 0.f;
#pragma unroll 8
                for (int dd = 0; dd < 64; ++dd) s += qs[qi * 65 + dd] * ks[kj * 65 + dd];
                Sc[qi * SP + nloc + cc * 64 + kj] = s; }
        }
    }
    __syncthreads();
    { float mx = -3.0e38f;
      for (int idx = sub; idx < ntot; idx += 8) mx = fmaxf(mx, Sc[qi * SP + idx]);
      mx = fmaxf(mx, __shfl_xor(mx, 1)); mx = fmaxf(mx, __shfl_xor(mx, 2)); mx = fmaxf(mx, __shfl_xor(mx, 4));
      float sm = 0.f;
      for (int idx = sub; idx < ntot; idx += 8) { const float p = __expf(Sc[qi * SP + idx] - mx); Sc[qi * SP + idx] = p; sm += p; }
      sm += __shfl_xor(sm, 1); sm += __shfl_xor(sm, 2); sm += __shfl_xor(sm, 4);
      const float inv = 1.0f / sm;
      for (int idx = sub; idx < ntot; idx += 8) Sc[qi * SP + idx] *= inv; }
    float acc[8];
#pragma unroll
    for (int e = 0; e < 8; ++e) acc[e] = 0.f;
    for (int ch = 0; ch < nch; ++ch) {
        const bool loc = kind == 0 && ch < 8; const int cc = kind == 0 ? ch - 8 : ch;
        const int krow0 = loc ? b * SEQ + (r0 + ch) * 64 : NL + b * LC + cc * 64;
        __syncthreads();
        { const v4u w = *(const v4u*)(U + (size_t)(krow0 + qi) * UA_W + UA_NA + 2 * NA_W + h * 64 + d0);
          ks[qi * 65 + d0 + 0] = bflo(w.x); ks[qi * 65 + d0 + 1] = bfhi(w.x); ks[qi * 65 + d0 + 2] = bflo(w.y); ks[qi * 65 + d0 + 3] = bfhi(w.y);
          ks[qi * 65 + d0 + 4] = bflo(w.z); ks[qi * 65 + d0 + 5] = bfhi(w.z); ks[qi * 65 + d0 + 6] = bflo(w.w); ks[qi * 65 + d0 + 7] = bfhi(w.w); }
        __syncthreads();
        if (loc) {
#pragma unroll 4
            for (int e = 0; e < 16; ++e) { const float p = Sc[qi * SP + ch * 16 + e]; const int kc = c0 + e;
#pragma unroll
                for (int dd = 0; dd < 8; ++dd) acc[dd] += p * ks[kc * 65 + d0 + dd]; } }
        else {
#pragma unroll 4
            for (int kj = 0; kj < 64; ++kj) { const float p = Sc[qi * SP + nloc + cc * 64 + kj];
#pragma unroll
                for (int dd = 0; dd < 8; ++dd) acc[dd] += p * ks[kj * 65 + d0 + dd]; } }
    }
    v4u w; w.x = pk2(acc[0], acc[1]); w.y = pk2(acc[2], acc[3]); w.z = pk2(acc[4], acc[5]); w.w = pk2(acc[6], acc[7]);
    *(v4u*)(U + (size_t)(qrow0 + qi) * UA_W + UA_NA + h * 64 + d0) = w;
    __syncthreads();
}
__device__ __forceinline__ void p5_rw_readout(Frame& F, int li, int row_lo, int row_hi) {
    const int gw = F.wave, NGW = NWAVES, lane = F.lane;
    const bf16* FEAT = F.wsp<bf16>(WS_R1 + R1_FEAT); const bf16* Y = F.wsp<bf16>(WS_RB); bf16* U = F.wsp<bf16>(WS_R1);
    const int nrows = row_hi;
    if (lane >= 48) return;
    const int j0 = 8 * lane;
    float gg[8], gb[8], ka[8], rk[8];
#pragma unroll
    for (int e = 0; e < 8; ++e) { gg[e] = F.in[I_RWGNG][li * RW_W + j0 + e]; gb[e] = F.in[I_RWGNB][li * RW_W + j0 + e]; ka[e] = F.in[I_RWKA][li * RW_W + j0 + e]; rk[e] = F.in[I_RWRK][li * RW_W + j0 + e]; }
#pragma unroll 1
    for (int row0 = row_lo + gw; row0 < nrows; row0 += 2 * NGW) {
        v4u wy0[2], wy1[2], wr[2], wk[2], wv[2], wi0[2], wi1[2], wg[2];
#pragma unroll
        for (int u = 0; u < 2; ++u) { const int row = min(row0 + u * NGW, nrows - 1);
            wy0[u] = *(const v4u*)(Y + (size_t)row * RW_W + j0); wy1[u] = *(const v4u*)(Y + ((size_t)MT + row) * RW_W + j0);
            const bf16* fp = FEAT + (size_t)row * NFEAT * RW_W + j0;
            wr[u] = *(const v4u*)fp; wk[u] = *(const v4u*)(fp + RW_W); wv[u] = *(const v4u*)(fp + 2 * RW_W); wi0[u] = *(const v4u*)(fp + 5 * RW_W); wi1[u] = *(const v4u*)(fp + 6 * RW_W); wg[u] = *(const v4u*)(fp + 7 * RW_W); }
#pragma unroll
        for (int u = 0; u < 2; ++u) { const int row = row0 + u * NGW;
            float y0[8], y1[8], r[8], k[8], v[8], i0[8], i1[8], g[8];
            unpack8(wy0[u], y0); unpack8(wy1[u], y1); unpack8(wr[u], r); unpack8(wk[u], k); unpack8(wv[u], v); unpack8(wi0[u], i0); unpack8(wi1[u], i1); unpack8(wg[u], g);
            float sm = 0.f;
#pragma unroll
            for (int e = 0; e < 8; ++e) { y0[e] += y1[e]; sm += y0[e]; }
            sm += __shfl_xor(sm, 1); sm += __shfl_xor(sm, 2); sm += __shfl_xor(sm, 4);
            const float mu = sm * (1.f / 64.f); float sq = 0.f, bs = 0.f;
#pragma unroll
            for (int e = 0; e < 8; ++e) { y0[e] -= mu; sq += y0[e] * y0[e]; bs += r[e] * (k[e] * (2.0f + (i0[e] + i1[e] - 2.0f) * ka[e])) * rk[e]; }
            sq += __shfl_xor(sq, 1); sq += __shfl_xor(sq, 2); sq += __shfl_xor(sq, 4);
            bs += __shfl_xor(bs, 1); bs += __shfl_xor(bs, 2); bs += __shfl_xor(bs, 4);
            const float rs = 1.0f / sqrtf(sq * (1.f / 64.f) + RW_GN_EPS);
            float o[8];
#pragma unroll
            for (int e = 0; e < 8; ++e) o[e] = (y0[e] * rs * gg[e] + gb[e] + bs * v[e]) * g[e];
            if (row < nrows) *(v4u*)(U + (size_t)row * UA_W + j0) = pack8(o); }
    }
}

__device__ __forceinline__ void p8_norm2(Frame& F, int li, int dry) {
    const int gw = F.bid * NWAVES + F.wave, NGW = F.G * NWAVES, lane = F.lane;
    const float* g = F.in[I_N2G] + li * D;
    if (li == 0) {
        bf16* H2 = F.wsp<bf16>(WS_RA);
        for (int row = gw; row < MT; row += NGW) { const bool isl = row < NL; const int r9 = isl ? row >> 11 : 8;
            const float* xr = isl ? F.out + (size_t)row * D : F.wsp<float>(WS_CTXRES) + (size_t)(row - NL) * D; const float* md = F.mods(li, r9);
            f32x4 v[4]; norm_row(xr, g, md + 3 * D, md + 4 * D, lane, v); store_row_bf16(H2 + (size_t)row * D, lane, v); }
    } else {
        bf16* H2 = F.wsp<bf16>(WS_R1 + R1_H2U);
        int* rowtok = (int*)(F.ws + WS_MISC + MISC_ROWTOK);
        if (!dry) for (int i = F.bid * NTHREADS + F.tid; i < MOE_ROWS; i += F.G * NTHREADS) rowtok[i] = -1;
        unsigned* cnt = (unsigned*)(F.ws + WS_CTL) + CW_MOECNT;
        const float* router = F.in[I_MOER];
        int* sel = (int*)(F.ws + WS_MISC + MISC_SEL);
        for (int row = gw; row < NL; row += NGW) { const float* md = F.mods(li, row >> 11);
            f32x4 v[4]; norm_row(F.out + (size_t)row * D, g, md + 3 * D, md + 4 * D, lane, v);
            { unsigned* o4 = (unsigned*)((unsigned char*)H2 + (size_t)row * D) + lane;
#pragma unroll
              for (int j = 0; j < 4; ++j) o4[64 * j] = pk4_fp8(v[j].x, v[j].y, v[j].z, v[j].w); }
            float lg[8];
#pragma unroll
            for (int e = 0; e < 8; ++e) lg[e] = 0.f;
#pragma unroll
            for (int j = 0; j < 4; ++j) { const int k0 = 4 * lane + 256 * j;
#pragma unroll
                for (int q = 0; q < 4; ++q) { const f32x4 ra = ((const f32x4*)(router + (size_t)(k0 + q) * 8))[0], rb = ((const f32x4*)(router + (size_t)(k0 + q) * 8))[1]; const float x = v[j][q];
                    lg[0] += x * ra.x; lg[1] += x * ra.y; lg[2] += x * ra.z; lg[3] += x * ra.w; lg[4] += x * rb.x; lg[5] += x * rb.y; lg[6] += x * rb.z; lg[7] += x * rb.w; } }
#pragma unroll
            for (int e = 0; e < 8; ++e) lg[e] = wave_sum(lg[e]);
            int ea = 0; float la = lg[0];
#pragma unroll
            for (int e = 1; e < 8; ++e) if (lg[e] > la) { la = lg[e]; ea = e; }
            int eb = -1; float lb = -3.0e38f;
#pragma unroll
            for (int e = 0; e < 8; ++e) if (e != ea && lg[e] > lb) { lb = lg[e]; eb = e; }
            const float wa = 1.0f / (1.0f + __expf(lb - la)), wb = 1.0f - wa;
            if (lane == 0) { const unsigned inc = dry ? 0u : 1u; const unsigned ra = __hip_atomic_fetch_add(cnt + 64 * ea, inc, __ATOMIC_RELAXED, __HIP_MEMORY_SCOPE_AGENT), rb = __hip_atomic_fetch_add(cnt + 64 * eb, inc, __ATOMIC_RELAXED, __HIP_MEMORY_SCOPE_AGENT);
                if (!dry) {
                int* s = sel + (size_t)row * 8; s[0] = ea; s[1] = (int)ra; s[2] = __float_as_int(wa); s[3] = eb; s[4] = (int)rb; s[5] = __float_as_int(wb); } }
        }
    }
}
__device__ __forceinline__ void p8b_gather(Frame& F) {
    const int gw = F.bid * NWAVES + F.wave, NGW = F.G * NWAVES, lane = F.lane;
    const unsigned* cnt = (const unsigned*)(F.ws + WS_CTL) + CW_MOECNT;
    int off[8]; { int t = 0;
#pragma unroll
        for (int e = 0; e < 8; ++e) { off[e] = t * 256; t += (int)((__builtin_amdgcn_readfirstlane(cnt[64 * e]) + 255u) >> 8); } }
    const bf16* H2 = F.wsp<bf16>(WS_R1 + R1_H2U); bf16* AS = F.wsp<bf16>(WS_RA);
    int* rowtok = (int*)(F.ws + WS_MISC + MISC_ROWTOK); float* rowwgt = (float*)(F.ws + WS_MISC + MISC_ROWWGT);
    const int* sel = (const int*)(F.ws + WS_MISC + MISC_SEL);
    for (int row = gw; row < NL; row += NGW) { const int* s = sel + (size_t)row * 8;
        const int ea = s[0], ra = s[1], eb = s[3], rb = s[4];
        int oa = 0, ob = 0;
#pragma unroll
        for (int e = 0; e < 8; ++e) { oa = (e == ea) ? off[e] : oa; ob = (e == eb) ? off[e] : ob; }
        const int pa = oa + ra, pb = ob + rb;
        const v4u* src = (const v4u*)((const unsigned char*)H2 + (size_t)row * D); v4u* da = (v4u*)((unsigned char*)AS + (size_t)pa * D); v4u* db = (v4u*)((unsigned char*)AS + (size_t)pb * D);
        { const v4u w = src[lane]; da[lane] = w; db[lane] = w; }
        if (lane == 0) { rowtok[pa] = row; rowwgt[pa] = __int_as_float(s[2]); rowtok[pb] = row; rowwgt[pb] = __int_as_float(s[5]); }
    }
}

__device__ __forceinline__ void p11_moe_combine(Frame& F, int li, int dry) {
    const int gw = F.bid * NWAVES + F.wave, NGW = F.G * NWAVES, lane = F.lane;
    const unsigned* cnt = (const unsigned*)(F.ws + WS_CTL) + CW_MOECNT;
    int off[8]; { int t = 0;
#pragma unroll
        for (int e = 0; e < 8; ++e) { off[e] = t * 256; t += (int)((__builtin_amdgcn_readfirstlane(cnt[64 * e]) + 255u) >> 8); } }
    const bf16* YP = F.wsp<bf16>(WS_RA); const int* sel = (const int*)(F.ws + WS_MISC + MISC_SEL);
    for (int row = gw; row < NL; row += NGW) { const int* s = sel + (size_t)row * 8;
        const int ea = s[0], ra = s[1], eb = s[3], rb = s[4]; const float wa = dry ? 0.f : __int_as_float(s[2]), wb = dry ? 0.f : __int_as_float(s[5]);
        int oa = 0, ob = 0;
#pragma unroll
        for (int e = 0; e < 8; ++e) { oa = (e == ea) ? off[e] : oa; ob = (e == eb) ? off[e] : ob; }
        const v2u* ya = (const v2u*)(YP + (size_t)(oa + ra) * D) + lane; const v2u* yb = (const v2u*)(YP + (size_t)(ob + rb) * D) + lane;
        const float* gate = F.mods(li, row >> 11) + 5 * D; f32x4* op = (f32x4*)(F.out + (size_t)row * D) + lane;
#pragma unroll
        for (int j = 0; j < 4; ++j) { const v2u a = ya[64 * j], b = yb[64 * j]; const f32x4 g = ((const f32x4*)gate)[lane + 64 * j]; f32x4 x = op[64 * j];
            x.x += g.x * (wa * bflo(a.x) + wb * bflo(b.x)); x.y += g.y * (wa * bfhi(a.x) + wb * bfhi(b.x));
            x.z += g.z * (wa * bflo(a.y) + wb * bflo(b.y)); x.w += g.w * (wa * bfhi(a.y) + wb * bfhi(b.y));
            op[64 * j] = x; }
    }
}

constexpr int NCHUNK = 36, NCHAIN = 96;
constexpr size_t SCR_GH = WS_WM13;
constexpr size_t SZ_GHSLOT = 2 * 64 * 64 * 4;
constexpr size_t SCR_AW = SCR_GH + (size_t)NCHAIN * NCHUNK * SZ_GHSLOT;
constexpr size_t SZ_AWSLOT = 128 * 64 * 2;
static_assert(SCR_AW + (size_t)NCHAIN * NCHUNK * SZ_AWSLOT <= WS_CTXRES, "RWKV scratch fits in the MoE weight region");
constexpr int LDK = 72;
constexpr int LDF = 68;
constexpr int MATB = 64 * LDK * 2, MATF = 64 * LDF * 4;
typedef short bf16x8_t __attribute__((ext_vector_type(8)));

__device__ __forceinline__ int rw_row(int b, int d, int p) {
    if (p < LC) { const int t = d ? LC - 1 - p : p; return NL + b * LC + t; }
    const int q = p - LC, t = d ? SEQ - 1 - q : q; return b * SEQ + t;
}
__device__ __forceinline__ f32x4 rw_mma(const LAS bf16* A, const LAS bf16* Bt, int lane, f32x4 acc) {
    const int r = lane & 15, q = lane >> 4;
#pragma unroll
    for (int ks = 0; ks < 2; ++ks) { const bf16x8_t a = *(const LAS bf16x8_t*)(A + r * LDK + ks * 32 + q * 8); const bf16x8_t b = *(const LAS bf16x8_t*)(Bt + r * LDK + ks * 32 + q * 8);
        acc = __builtin_amdgcn_mfma_f32_16x16x32_bf16(a, b, acc, 0, 0, 0); }
    return acc;
}

template <int PH>
__device__ __forceinline__ void rw_stage(Frame& F, int li, int b, int h, int d, int c, LAS unsigned char* L, LAS float* ecum,
                                         LAS bf16* m0, LAS bf16* m1, LAS bf16* m2, LAS bf16* t0, LAS bf16* t1, LAS bf16* vt, LAS float* xa, LAS float* gC) {
    const int t = F.tid >> 3, d0 = (F.tid & 7) * 8;
    const int row = rw_row(b, d, c * 64 + t);
    const bf16* fp = F.wsp<bf16>(WS_R1 + R1_FEAT) + (size_t)row * NFEAT * RW_W + h * 64 + d0;
    float r[8], k[8], v[8], e[8], ic[8], kk[8];
    unpack8(*(const v4u*)(fp), r); unpack8(*(const v4u*)(fp + RW_W), k); unpack8(*(const v4u*)(fp + 2 * RW_W), v); unpack8(*(const v4u*)(fp + (3 + d) * RW_W), e); unpack8(*(const v4u*)(fp + (5 + d) * RW_W), ic);
    const float* kkp = F.in[I_RWKK] + li * RW_W + h * 64 + d0; const float* kap = F.in[I_RWKA] + li * RW_W + h * 64 + d0;
    float ss = 0.f;
#pragma unroll
    for (int j = 0; j < 8; ++j) { kk[j] = k[j] * kkp[j]; ss += kk[j] * kk[j]; }
    ss += __shfl_xor(ss, 1); ss += __shfl_xor(ss, 2); ss += __shfl_xor(ss, 4);
    const float inv = 1.0f / fmaxf(sqrtf(ss), 1e-12f);
    float cs[8];
#pragma unroll
    for (int j = 0; j < 8; ++j) { kk[j] *= inv; cs[j] = e[j]; }
#pragma unroll
    for (int off = 8; off < 64; off <<= 1) {
#pragma unroll
        for (int j = 0; j < 8; ++j) { const float u = __shfl_up(cs[j], off); if ((F.tid & 63) >= off) cs[j] += u; } }
    if (((F.tid & 63) >> 3) == 7) {
#pragma unroll
        for (int j = 0; j < 8; ++j) ecum[(F.tid >> 6) * 64 + d0 + j] = cs[j]; }
    __syncthreads();
#pragma unroll
    for (int wq = 0; wq < 7; ++wq) { if (wq < (F.tid >> 6)) { const f32x4 o0 = *(const LAS f32x4*)(ecum + wq * 64 + d0), o1 = *(const LAS f32x4*)(ecum + wq * 64 + d0 + 4);
        cs[0] += o0.x; cs[1] += o0.y; cs[2] += o0.z; cs[3] += o0.w; cs[4] += o1.x; cs[5] += o1.y; cs[6] += o1.z; cs[7] += o1.w; } }
    float at[8], bt[8], kt[8], rt[8];
#pragma unroll
    for (int j = 0; j < 8; ++j) { const float cv = cs[j]; const float g = __expf(-cv), gi = __expf(cv), gp = __expf(e[j] - cv);
        at[j] = -kk[j] * gp; bt[j] = kk[j] * ic[j] * gi; kt[j] = k[j] * (1.0f + (ic[j] - 1.0f) * kap[j]) * gi; rt[j] = r[j] * g;
        if (PH == 0 && t == 63) gC[d0 + j] = g; }
    if (PH == 0) {
        *(LAS v4u*)(m0 + t * LDK + d0) = pack8(at); *(LAS v4u*)(m1 + t * LDK + d0) = pack8(bt); *(LAS v4u*)(m2 + t * LDK + d0) = pack8(kt);
#pragma unroll
        for (int j = 0; j < 8; ++j) { t0[(d0 + j) * LDK + t] = (bf16)f2bf(bt[j]); t1[(d0 + j) * LDK + t] = (bf16)f2bf(kt[j]); vt[(d0 + j) * LDK + t] = (bf16)f2bf(v[j]); xa[(d0 + j) * LDF + t] = at[j]; }
    } else {
        *(LAS v4u*)(m0 + t * LDK + d0) = pack8(bt); *(LAS v4u*)(m1 + t * LDK + d0) = pack8(kt); *(LAS v4u*)(m2 + t * LDK + d0) = pack8(rt);
#pragma unroll
        for (int j = 0; j < 8; ++j) vt[(d0 + j) * LDK + t] = (bf16)f2bf(v[j]);
    }
}

__device__ __forceinline__ void rw_phaseA_job(Frame& F, int li, int chain, int c) {
    const int b = chain / 12, h = (chain % 12) >> 1, d = chain & 1, lane = F.lane, w = F.wave;
    LAS unsigned char* L = F.lds;
    LAS bf16* At = (LAS bf16*)(L + 0 * MATB); LAS bf16* Bt = (LAS bf16*)(L + 1 * MATB); LAS bf16* Kt = (LAS bf16*)(L + 2 * MATB);
    LAS bf16* BtT = (LAS bf16*)(L + 3 * MATB); LAS bf16* KtT = (LAS bf16*)(L + 4 * MATB); LAS bf16* VT = (LAS bf16*)(L + 5 * MATB); LAS bf16* NakT = (LAS bf16*)(L + 6 * MATB);
    LAS bf16* AW = (LAS bf16*)(L + 7 * MATB);
    LAS float* Nab = (LAS float*)(L + 9 * MATB);
    LAS float* X = (LAS float*)(L + 9 * MATB + MATF);
    LAS float* gC = (LAS float*)(L + 9 * MATB + 3 * MATF);
    LAS float* MinvB = gC + 64;
    LAS bf16* NabT = At;
    __syncthreads();
    rw_stage<0>(F, li, b, h, d, c, L, Nab, At, Bt, Kt, BtT, KtT, VT, X, gC);
    __syncthreads();
    const int tr = w >> 1, tcb = (w & 1) * 2, q = lane >> 4, rr = lane & 15;
    f32x4 nab[2], nak[2];
#pragma unroll
    for (int i = 0; i < 2; ++i) { const f32x4 z = {0.f, 0.f, 0.f, 0.f}; nab[i] = rw_mma(Bt + tr * 16 * LDK, At + (tcb + i) * 16 * LDK, lane, z); nak[i] = rw_mma(Kt + tr * 16 * LDK, At + (tcb + i) * 16 * LDK, lane, z); }
    __syncthreads();
#pragma unroll
    for (int i = 0; i < 2; ++i)
#pragma unroll
        for (int g = 0; g < 4; ++g) { const int s = tr * 16 + q * 4 + g, t = (tcb + i) * 16 + rr; const bool keep = s < t;
            Nab[s * LDF + t] = keep ? nab[i][g] : 0.f; NakT[t * LDK + s] = (bf16)f2bf(keep ? nak[i][g] : 0.f); NabT[t * LDK + s] = (bf16)f2bf(keep ? nab[i][g] : 0.f); }
    __syncthreads();
#pragma unroll
    for (int i = 0; i < 2; ++i) { const f32x4 z = {0.f, 0.f, 0.f, 0.f}; const f32x4 o = rw_mma(VT + tr * 16 * LDK, NakT + (tcb + i) * 16 * LDK, lane, z);
#pragma unroll
        for (int g = 0; g < 4; ++g) X[(64 + tr * 16 + q * 4 + g) * LDF + (tcb + i) * 16 + rr] = o[g]; }
    if (F.tid < 64) { const int blk = F.tid >> 4, i = F.tid & 15; float m[16];
#pragma unroll
        for (int t = 0; t < 16; ++t) { float a = (t == i) ? 1.f : 0.f;
#pragma unroll
            for (int s = 0; s < 16; ++s) if (s < t) a += m[s] * Nab[(16 * blk + s) * LDF + 16 * blk + t];
            m[t] = a; }
#pragma unroll
        for (int t = 0; t < 16; ++t) MinvB[(blk * 16 + i) * 16 + t] = m[t]; }
    __syncthreads();
    { typedef short bf16x4_t __attribute__((ext_vector_type(4)));
      const int row = 16 * w + rr; bf16* gslot = (bf16*)(F.ws + SCR_AW + (size_t)(chain * NCHUNK + c) * SZ_AWSLOT);
#pragma unroll
      for (int jb = 0; jb < 4; ++jb) {
          f32x4 t4 = *(const LAS f32x4*)(X + row * LDF + 16 * jb + 4 * q);
#pragma unroll
          for (int j = 0; j < jb; ++j) { const v2u na = *(const LAS v2u*)(NabT + (16 * jb + rr) * LDK + 16 * j + 4 * q), xb = *(const LAS v2u*)(AW + row * LDK + 16 * j + 4 * q);
              t4 = __builtin_amdgcn_mfma_f32_16x16x16bf16_1k(__builtin_bit_cast(bf16x4_t, na), __builtin_bit_cast(bf16x4_t, xb), t4, 0, 0, 0); }
          const v2u tb = {pk2(t4[0], t4[1]), pk2(t4[2], t4[3])};
          const LAS float* mp = MinvB + (jb * 16 + 4 * q) * 16 + rr;
          const v2u ma = {pk2(mp[0], mp[16]), pk2(mp[32], mp[48])};
          const f32x4 z0 = {0.f, 0.f, 0.f, 0.f};
          const f32x4 z = __builtin_amdgcn_mfma_f32_16x16x16bf16_1k(__builtin_bit_cast(bf16x4_t, ma), __builtin_bit_cast(bf16x4_t, tb), z0, 0, 0, 0);
          const v2u pw = {pk2(z[0], z[1]), pk2(z[2], z[3])};
          *(LAS v2u*)(AW + row * LDK + 16 * jb + 4 * q) = pw; *(v2u*)(gslot + row * 64 + 16 * jb + 4 * q) = pw;
      } }
    __syncthreads();
    { float* gh = (float*)(F.ws + SCR_GH + (size_t)(chain * NCHUNK + c) * SZ_GHSLOT);
#pragma unroll
      for (int i = 0; i < 2; ++i) { const f32x4 z = {0.f, 0.f, 0.f, 0.f};
          const f32x4 gg = rw_mma(AW + tr * 16 * LDK, BtT + (tcb + i) * 16 * LDK, lane, z);
          f32x4 hh = rw_mma(AW + (64 + tr * 16) * LDK, BtT + (tcb + i) * 16 * LDK, lane, z); hh = rw_mma(VT + tr * 16 * LDK, KtT + (tcb + i) * 16 * LDK, lane, hh);
          const int kc = (tcb + i) * 16 + rr; const float gk = gC[kc];
#pragma unroll
          for (int g = 0; g < 4; ++g) { const int j = tr * 16 + q * 4 + g; gh[j * 64 + kc] = gg[g] * gk + (j == kc ? gk : 0.f); gh[4096 + j * 64 + kc] = hh[g] * gk; } } }
}

__device__ __forceinline__ void rw_phaseB_chain(Frame& F, int chain, int dry) {
    LAS float* Ss = (LAS float*)F.lds;
    LAS float* Gs = Ss + 64 * LDF;
    const int v = F.tid >> 3, k0 = (F.tid & 7) * 8;
    const unsigned char* base = F.ws + SCR_GH + (size_t)chain * NCHUNK * SZ_GHSLOT;
    f32x4 sp0 = {0.f, 0.f, 0.f, 0.f}, sp1 = sp0;
    __syncthreads();
    *(LAS f32x4*)(Ss + v * LDF + k0) = sp0; *(LAS f32x4*)(Ss + v * LDF + k0 + 4) = sp1;
    f32x4 g0[2], g1[2], h0[2], h1[2];
#pragma unroll
    for (int p = 0; p < 2; ++p) { const float* gh = (const float*)(base + (size_t)p * SZ_GHSLOT);
        g0[p] = *(const f32x4*)(gh + v * 64 + k0); g1[p] = *(const f32x4*)(gh + v * 64 + k0 + 4); h0[p] = *(const f32x4*)(gh + 4096 + v * 64 + k0); h1[p] = *(const f32x4*)(gh + 4096 + v * 64 + k0 + 4); }
#pragma unroll 1
    for (int c2 = 0; c2 < NCHUNK; c2 += 2) {
#pragma unroll
        for (int p = 0; p < 2; ++p) { const int c = c2 + p;
            const f32x4 gc0 = g0[p], gc1 = g1[p]; f32x4 a0 = h0[p], a1 = h1[p];
            asm volatile("" ::: "memory");
            __syncthreads();
            *(LAS f32x4*)(Gs + v * LDF + k0) = gc0; *(LAS f32x4*)(Gs + v * LDF + k0 + 4) = gc1;
            *(LAS f32x4*)(Ss + v * LDF + k0) = sp0; *(LAS f32x4*)(Ss + v * LDF + k0 + 4) = sp1;
            if (c >= 1 && !dry) { float x[8] = {sp0.x, sp0.y, sp0.z, sp0.w, sp1.x, sp1.y, sp1.z, sp1.w}; *(v4u*)((bf16*)(base + (size_t)(c - 1) * SZ_GHSLOT) + v * 64 + k0) = pack8(x); }
            if (c + 2 < NCHUNK) { const float* gh = (const float*)(base + (size_t)(c + 2) * SZ_GHSLOT);
                g0[p] = *(const f32x4*)(gh + v * 64 + k0); g1[p] = *(const f32x4*)(gh + v * 64 + k0 + 4); h0[p] = *(const f32x4*)(gh + 4096 + v * 64 + k0); h1[p] = *(const f32x4*)(gh + 4096 + v * 64 + k0 + 4); }
            __syncthreads();
#pragma unroll 8
            for (int j = 0; j < 64; ++j) { const float s = Ss[v * LDF + j]; const f32x4 ga = *(const LAS f32x4*)(Gs + j * LDF + k0), gb = *(const LAS f32x4*)(Gs + j * LDF + k0 + 4); a0 += s * ga; a1 += s * gb; }
            sp0 = a0; sp1 = a1; }
    }
    __syncthreads();
}

__device__ __forceinline__ void rw_phaseC_job(Frame& F, int li, int chain, int c, int dry) {
    const int b = chain / 12, h = (chain % 12) >> 1, d = chain & 1, lane = F.lane, w = F.wave;
    LAS unsigned char* L = F.lds;
    LAS bf16* Bt = (LAS bf16*)(L + 0 * MATB); LAS bf16* Kt = (LAS bf16*)(L + 1 * MATB); LAS bf16* Rt = (LAS bf16*)(L + 2 * MATB); LAS bf16* VT = (LAS bf16*)(L + 3 * MATB);
    LAS bf16* NrbT = (LAS bf16*)(L + 4 * MATB); LAS bf16* NrkT = (LAS bf16*)(L + 5 * MATB); LAS bf16* QT = (LAS bf16*)(L + 6 * MATB); LAS bf16* AW = (LAS bf16*)(L + 7 * MATB);
    LAS float* ecum = (LAS float*)(L + 9 * MATB); LAS bf16* Sb = (LAS bf16*)(L + 9 * MATB + MATF); LAS float* Yt = (LAS float*)(L + 10 * MATB + MATF);
    __syncthreads();
    rw_stage<1>(F, li, b, h, d, c, L, ecum, Bt, Kt, Rt, nullptr, nullptr, VT, nullptr, nullptr);
    { const bf16* gslot = (const bf16*)(F.ws + SCR_AW + (size_t)(chain * NCHUNK + c) * SZ_AWSLOT);
      const int row = F.tid >> 2, c0 = (F.tid & 3) * 16;
      *(LAS v4u*)(AW + row * LDK + c0) = *(const v4u*)(gslot + row * 64 + c0); *(LAS v4u*)(AW + row * LDK + c0 + 8) = *(const v4u*)(gslot + row * 64 + c0 + 8);
      const bf16* sg = (const bf16*)(F.ws + SCR_GH + (size_t)(chain * NCHUNK + (c > 0 ? c - 1 : 0)) * SZ_GHSLOT);
      const int v = F.tid >> 3, k0 = (F.tid & 7) * 8; v4u sw = *(const v4u*)(sg + v * 64 + k0); if (c == 0) sw = (v4u){0u, 0u, 0u, 0u}; *(LAS v4u*)(Sb + v * LDK + k0) = sw; }
    __syncthreads();
    const int tr = w >> 1, tcb = (w & 1) * 2, q = lane >> 4, rr = lane & 15;
#pragma unroll
    for (int i = 0; i < 2; ++i) { const f32x4 z = {0.f, 0.f, 0.f, 0.f}; const f32x4 nb = rw_mma(Bt + tr * 16 * LDK, Rt + (tcb + i) * 16 * LDK, lane, z), nk = rw_mma(Kt + tr * 16 * LDK, Rt + (tcb + i) * 16 * LDK, lane, z);
#pragma unroll
        for (int g = 0; g < 4; ++g) { const int s = tr * 16 + q * 4 + g, t = (tcb + i) * 16 + rr; const bool keep = s <= t;
            NrbT[t * LDK + s] = (bf16)f2bf(keep ? nb[g] : 0.f); NrkT[t * LDK + s] = (bf16)f2bf(keep ? nk[g] : 0.f); } }
    __syncthreads();
#pragma unroll
    for (int i = 0; i < 2; ++i) { const f32x4 z = {0.f, 0.f, 0.f, 0.f}; const f32x4 o = rw_mma(AW + tr * 16 * LDK, NrbT + (tcb + i) * 16 * LDK, lane, z);
#pragma unroll
        for (int g = 0; g < 4; ++g) { const int k = tr * 16 + q * 4 + g, t = (tcb + i) * 16 + rr; QT[t * LDK + k] = (bf16)f2bf(o[g] + bf2f(Rt[t * LDK + k])); } }
    __syncthreads();
#pragma unroll
    for (int i = 0; i < 2; ++i) { f32x4 o = {0.f, 0.f, 0.f, 0.f};
        o = rw_mma(Sb + tr * 16 * LDK, QT + (tcb + i) * 16 * LDK, lane, o); o = rw_mma(AW + (64 + tr * 16) * LDK, NrbT + (tcb + i) * 16 * LDK, lane, o); o = rw_mma(VT + tr * 16 * LDK, NrkT + (tcb + i) * 16 * LDK, lane, o);
#pragma unroll
        for (int g = 0; g < 4; ++g) Yt[((tcb + i) * 16 + rr) * LDF + tr * 16 + q * 4 + g] = o[g]; }
    __syncthreads();
    { const int t = F.tid >> 3, d0 = (F.tid & 7) * 8; const int row = rw_row(b, d, c * 64 + t); bf16* yp = F.wsp<bf16>(WS_RB) + ((size_t)d * MT + row) * RW_W + h * 64 + d0;
      float x[8];
#pragma unroll
      for (int j = 0; j < 8; ++j) x[j] = Yt[t * LDF + d0 + j];
      *(v4u*)yp = pack8(x); (void)dry; }
}


constexpr int P3_AS = 392;
constexpr int P3_WAVE_LDS = 16 * P3_AS * 2;
constexpr int P3_ROWS = 72;
__device__ __forceinline__ void p3_job(Frame& F, int li, int job) {
    const int lane = F.lane, r = lane & 15, g = lane >> 4;
    const int row0 = job * P3_ROWS;
    const bf16* U = F.wsp<bf16>(WS_R1); bf16* FEAT = F.wsp<bf16>(WS_R1 + R1_FEAT);
    LAS bf16* Ain = (LAS bf16*)F.lds;
    const float* mu0 = F.in[I_RWSHIFT] + (size_t)li * 2 * RW_IN; const float* mu1 = mu0 + RW_IN;
    const float* rope = F.wsp<float>(WS_MISC + MISC_ROPE);
    __syncthreads();
    for (int i = F.tid; i < 8 * P3_AS / 8; i += NTHREADS) *(LAS v4u*)(Ain + 72 * P3_AS + 8 * i) = (v4u){0u, 0u, 0u, 0u};
#pragma unroll 1
    for (int it = 0; it < 3; ++it) {
        const int idx = F.tid + NTHREADS * it, slot = idx % 192, run = idx / 192;
        int c1, c2, kindv;
        int fsel = 0, ocol1 = 0, half = 0, p = 0;
        if (slot < 96) { const int tensor = slot / 48, hd = (slot % 48) >> 3, sub = slot & 7; half = sub >> 2; p = (sub & 3) * 4; c1 = tensor * RW_W + hd * 64 + half * 32 + p; c2 = c1 + 16; kindv = 0; fsel = tensor; ocol1 = hd * 64 + half * 32 + p; }
        else if (slot < 144) { c1 = 2 * RW_W + (slot - 96) * 8; c2 = c1 + 4; kindv = 1; fsel = 2; ocol1 = (slot - 96) * 8; }
        else { c1 = 3 * RW_W + (slot - 144) * 8; c2 = c1 + 4; kindv = 2; ocol1 = (slot - 144) * 8; }
        float m0a[4], m0b[4], m1a[4], m1b[4];
#pragma unroll
        for (int e = 0; e < 4; ++e) { m0a[e] = mu0[c1 + e]; m0b[e] = mu0[c2 + e]; m1a[e] = mu1[c1 + e]; m1b[e] = mu1[c2 + e]; }
        v2u ra[11], rb[11];
#pragma unroll
        for (int i = 0; i < 11; ++i) { const int rw = min(max(row0 + 9 * run - 1 + i, 0), MT - 1); const bf16* up = U + (size_t)rw * UA_W; ra[i] = *(const v2u*)(up + c1); rb[i] = *(const v2u*)(up + c2); }
#pragma unroll
        for (int t9 = 0; t9 < 9; ++t9) { const int tt = 9 * run + t9, row = row0 + tt;
            const bool isl = row < NL; const int t = isl ? (row & (SEQ - 1)) : ((row - NL) & (LC - 1)); const int n = isl ? SEQ : LC;
            const bool hp = t > 0, hn = t < n - 1;
            float xa[4], xb[4];
            { const v2u pa = ra[t9], ca = ra[t9 + 1], na = ra[t9 + 2], pb2 = rb[t9], cb = rb[t9 + 1], nb = rb[t9 + 2];
              const float pav[4] = {bflo(pa.x), bfhi(pa.x), bflo(pa.y), bfhi(pa.y)}, cav[4] = {bflo(ca.x), bfhi(ca.x), bflo(ca.y), bfhi(ca.y)}, nav[4] = {bflo(na.x), bfhi(na.x), bflo(na.y), bfhi(na.y)};
              const float pbv[4] = {bflo(pb2.x), bfhi(pb2.x), bflo(pb2.y), bfhi(pb2.y)}, cbv[4] = {bflo(cb.x), bfhi(cb.x), bflo(cb.y), bfhi(cb.y)}, nbv[4] = {bflo(nb.x), bfhi(nb.x), bflo(nb.y), bfhi(nb.y)};
#pragma unroll
              for (int e = 0; e < 4; ++e) { const float pva = hp ? pav[e] : 0.f, nva = hn ? nav[e] : 0.f, pvb = hp ? pbv[e] : 0.f, nvb = hn ? nbv[e] : 0.f;
                  xa[e] = cav[e] + m0a[e] * (pva - cav[e]) + m1a[e] * (nva - cav[e]); xb[e] = cbv[e] + m0b[e] * (pvb - cbv[e]) + m1b[e] * (nvb - cbv[e]); } }
            if (kindv == 0) {
                float o1[4], o2[4];
                if (isl) { const int pos = half == 0 ? (t >> 6) : (t & 63); const float* rp = rope + (pos * 16 + p) * 2;
#pragma unroll
                    for (int e = 0; e < 4; ++e) { const float cs = rp[2 * e], sn = rp[2 * e + 1]; o1[e] = xa[e] * cs - xb[e] * sn; o2[e] = xa[e] * sn + xb[e] * cs; } }
                else {
#pragma unroll
                    for (int e = 0; e < 4; ++e) { o1[e] = xa[e]; o2[e] = xb[e]; } }
                bf16* fo = FEAT + ((size_t)row * NFEAT + fsel) * RW_W + ocol1;
                *(v2u*)fo = (v2u){pk2(o1[0], o1[1]), pk2(o1[2], o1[3])}; *(v2u*)(fo + 16) = (v2u){pk2(o2[0], o2[1]), pk2(o2[2], o2[3])};
            } else if (kindv == 1) {
                bf16* fo = FEAT + ((size_t)row * NFEAT + 2) * RW_W + ocol1;
                *(v4u*)fo = (v4u){pk2(xa[0], xa[1]), pk2(xa[2], xa[3]), pk2(xb[0], xb[1]), pk2(xb[2], xb[3])};
            } else {
                const int lc = ocol1;
#pragma unroll
                for (int e = 0; e < 4; ++e) { if (lc < 128) { xa[e] = tanhf(xa[e]); xb[e] = tanhf(xb[e]); } else if (lc >= 256) { xa[e] = sigmoidf_(xa[e]); xb[e] = sigmoidf_(xb[e]); } }
                *(LAS v4u*)(Ain + tt * P3_AS + lc) = (v4u){pk2(xa[0], xa[1]), pk2(xa[2], xa[3]), pk2(xb[0], xb[1]), pk2(xb[2], xb[3])};
            }
        }
    }
    __syncthreads();
    const bf16* RWT = F.wsp<bf16>(WS_MISC + MISC_RWT) + (size_t)li * RWT_PER_LAYER;
#pragma unroll 1
    for (int q3 = 0; q3 < 3; ++q3) { const int nt = 3 * F.wave + q3, nc = nt * 16 + r;
        v4u wc[12];
#pragma unroll
        for (int pr = 0; pr < 4; ++pr) { const bf16* wt = RWT + (size_t)pr * 384 * 64 + (size_t)nc * 64 + 8 * g; wc[2 * pr] = *(const v4u*)wt; wc[2 * pr + 1] = *(const v4u*)(wt + 32); }
        { const bf16* wt = RWT + RWT_G2 + (size_t)nc * 128 + 8 * g;
#pragma unroll
          for (int ks = 0; ks < 4; ++ks) wc[8 + ks] = *(const v4u*)(wt + 32 * ks); }
        const int nc0 = nt * 16 + 4 * g;
        const f32x4 w00 = *(const f32x4*)(F.in[I_RWW0] + (li * 2 + 0) * RW_W + nc0), w01 = *(const f32x4*)(F.in[I_RWW0] + (li * 2 + 1) * RW_W + nc0);
        const f32x4 a00 = *(const f32x4*)(F.in[I_RWA0] + (li * 2 + 0) * RW_W + nc0), a01 = *(const f32x4*)(F.in[I_RWA0] + (li * 2 + 1) * RW_W + nc0);
#pragma unroll 1
        for (int mt = 0; mt < 5; ++mt) {
            f32x4 acc[5];
#pragma unroll
            for (int pr = 0; pr < 5; ++pr) acc[pr] = (f32x4){0.f, 0.f, 0.f, 0.f};
            const LAS bf16* ap = Ain + (mt * 16 + r) * P3_AS + 8 * g;
#pragma unroll
            for (int pr = 0; pr < 4; ++pr)
#pragma unroll
                for (int ks = 0; ks < 2; ++ks) acc[pr] = __builtin_amdgcn_mfma_f32_16x16x32_bf16(__builtin_bit_cast(bf16x8_t, wc[2 * pr + ks]), *(const LAS bf16x8_t*)(ap + 32 * (2 * pr + ks)), acc[pr], 0, 0, 0);
#pragma unroll
            for (int ks = 0; ks < 4; ++ks) acc[4] = __builtin_amdgcn_mfma_f32_16x16x32_bf16(__builtin_bit_cast(bf16x8_t, wc[8 + ks]), *(const LAS bf16x8_t*)(ap + 32 * (8 + ks)), acc[4], 0, 0, 0);
            const int tt = mt * 16 + r;
            if (tt < P3_ROWS) { bf16* fo = FEAT + (size_t)(row0 + tt) * NFEAT * RW_W + nc0; float o[4];
#pragma unroll
                for (int e = 0; e < 4; ++e) o[e] = 0.6065306597126334f * sigmoidf_(acc[0][e] + w00[e]);
                *(v2u*)(fo + 3 * RW_W) = (v2u){pk2(o[0], o[1]), pk2(o[2], o[3])};
#pragma unroll
                for (int e = 0; e < 4; ++e) o[e] = 0.6065306597126334f * sigmoidf_(acc[1][e] + w01[e]);
                *(v2u*)(fo + 4 * RW_W) = (v2u){pk2(o[0], o[1]), pk2(o[2], o[3])};
#pragma unroll
                for (int e = 0; e < 4; ++e) o[e] = sigmoidf_(acc[2][e] + a00[e]);
                *(v2u*)(fo + 5 * RW_W) = (v2u){pk2(o[0], o[1]), pk2(o[2], o[3])};
#pragma unroll
                for (int e = 0; e < 4; ++e) o[e] = sigmoidf_(acc[3][e] + a01[e]);
                *(v2u*)(fo + 6 * RW_W) = (v2u){pk2(o[0], o[1]), pk2(o[2], o[3])};
                *(v2u*)(fo + 7 * RW_W) = (v2u){pk2(acc[4][0], acc[4][1]), pk2(acc[4][2], acc[4][3])}; }
        }
    }
}
__device__ __forceinline__ void p3_rw_features(Frame& F, int li) {
#pragma unroll 1
    for (int job = F.bid; job < MT / P3_ROWS; job += F.G) p3_job(F, li, job);
    __syncthreads();
}

typedef float f32x16 __attribute__((ext_vector_type(16)));
constexpr int HY_ZS = 72;
__device__ __forceinline__ void hy_job_mfma(Frame& F, int li, int seg, int c, int dry) {
    const int n = seg ? LC : SEQ, nI = n >> 6, lane = F.lane, b = F.wave, zb = nI * HY_ZS + 8;
    bf16* U = F.wsp<bf16>(WS_R1);
    LAS unsigned char* L = F.lds;
    const int cstride = 2 * n + 16;
    LAS bf16* frev8 = (LAS bf16*)L;
    constexpr int FREV_BYTES = 8 * (2 * SEQ + 16) * 2;
    constexpr int Z_BYTES = 8 * (32 * HY_ZS + 8) * 2;
    LAS bf16* zin = (LAS bf16*)(L + FREV_BYTES); LAS bf16* zout = (LAS bf16*)(L + FREV_BYTES + Z_BYTES);
    LAS bf16* xg = (LAS bf16*)L;
    static_assert(FREV_BYTES + 2 * Z_BYTES <= LDS_CTL_OFF, "hyena LDS map");
    const float* cw = F.in[I_HYCW] + (size_t)li * 3 * HY_IN; const float* cbv = F.in[I_HYCB] + (size_t)li * HY_IN;
    __syncthreads();
#define HY_STAGE_RAW(dst_, col_, tid_) do { const int s_ = (col_) >> 8, c_ = (col_) & 255; _Pragma("unroll 1") for (int v0_ = (tid_); v0_ < 8 * nI * 8; v0_ += 4 * NTHREADS) { v4u rv_[4]; \
        _Pragma("unroll") for (int k_ = 0; k_ < 4; ++k_) { const int vec_ = v0_ + k_ * NTHREADS; rv_[k_] = (v4u){0u, 0u, 0u, 0u}; if (vec_ < 8 * nI * 8) { const int bb_ = vec_ / (nI * 8), I_ = (vec_ >> 3) % nI, p_ = vec_ & 7; \
            rv_[k_] = *(const v4u*)(U + (size_t)((seg ? NL + bb_ * LC : bb_ * SEQ) + 64 * I_ + (c_ >> 2)) * UA_W + UA_HY + s_ * 256 + (c_ & 3) * 64 + 8 * p_); } } \
        _Pragma("unroll") for (int k_ = 0; k_ < 4; ++k_) { const int vec_ = v0_ + k_ * NTHREADS; if (vec_ < 8 * nI * 8) { const int bb_ = vec_ / (nI * 8), I_ = (vec_ >> 3) % nI, p_ = vec_ & 7; *(LAS v4u*)((dst_) + (bb_ * zb + I_ * HY_ZS) + 8 * p_) = rv_[k_]; } } } } while (0)
#define HY_CONV(raw_, bb_, t_, col_) (cbv[col_] + cw[col_] * ((t_) > 0 ? bf2f((raw_)[((bb_) * zb + (((t_) - 1) >> 6) * HY_ZS) + (((t_) - 1) & 63)]) : 0.f) \
        + cw[HY_IN + (col_)] * bf2f((raw_)[((bb_) * zb + ((t_) >> 6) * HY_ZS) + ((t_) & 63)]) + cw[2 * HY_IN + (col_)] * ((t_) < n - 1 ? bf2f((raw_)[((bb_) * zb + (((t_) + 1) >> 6) * HY_ZS) + (((t_) + 1) & 63)]) : 0.f))
    HY_STAGE_RAW(zout, c, F.tid);
    __syncthreads();
#pragma unroll 1
    for (int idx = F.tid; idx < 8 * n; idx += NTHREADS) { const int bb = idx / n, t = idx - bb * n;
        zin[bb * zb + (t >> 6) * HY_ZS + (t & 63)] = (bf16)f2bf(HY_CONV(zout, bb, t, c)); }
#pragma unroll 1
    for (int o = 0; o < 2; ++o) {
        const bf16* fsrc = seg ? F.wsp<bf16>(WS_FILTC) + (size_t)(o * 256 + c) * 512 : F.wsp<bf16>(WS_FILT) + (size_t)((li * 2 + o) * 256 + c) * 4096;
        __syncthreads();
        int tid_o = F.tid; asm volatile("" : "+v"(tid_o));
#pragma unroll 1
        for (int m = tid_o; m < 2 * n / 8; m += NTHREADS) { float x[8];
#pragma unroll
            for (int e = 0; e < 8; ++e) { const int y = 8 * m + e; x[e] = y == 0 ? 0.f : bf2f(fsrc[2 * n - y]); }
            *(LAS v4u*)(frev8 + 8 * m) = pack8(x); }
        __syncthreads();
        if (b >= 1) { const int rho = b, q = rho >> 1; const bool odd = rho & 1; LAS bf16* dst = frev8 + rho * cstride;
#pragma unroll 1
            for (int m = (tid_o & 63); m < 2 * n / 8; m += 64) { const v4u lo = *(const LAS v4u*)(frev8 + 8 * m); v4u hi = {0u, 0u, 0u, 0u}; if (m + 1 < 2 * n / 8) hi = *(const LAS v4u*)(frev8 + 8 * m + 8);
                unsigned a0, a1, a2, a3, a4;
                if (q == 0) { a0 = lo.x; a1 = lo.y; a2 = lo.z; a3 = lo.w; a4 = hi.x; } else if (q == 1) { a0 = lo.y; a1 = lo.z; a2 = lo.w; a3 = hi.x; a4 = hi.y; }
                else if (q == 2) { a0 = lo.z; a1 = lo.w; a2 = hi.x; a3 = hi.y; a4 = hi.z; } else { a0 = lo.w; a1 = hi.x; a2 = hi.y; a3 = hi.z; a4 = hi.w; }
                v4u ov; if (odd) { ov.x = (a0 >> 16) | (a1 << 16); ov.y = (a1 >> 16) | (a2 << 16); ov.z = (a2 >> 16) | (a3 << 16); ov.w = (a3 >> 16) | (a4 << 16); } else { ov.x = a0; ov.y = a1; ov.z = a2; ov.w = a3; }
                *(LAS v4u*)(dst + 8 * m) = ov; } }
        __syncthreads();
        f32x16 acc0, acc1;
#pragma unroll
        for (int r = 0; r < 16; ++r) { acc0[r] = 0.f; acc1[r] = 0.f; }
        { const int ir = tid_o & 31, hh = (tid_o >> 5) & 1, bc = ir & 7, I = 4 * b + (ir >> 3);
          const int Dlo = max(4 * b - (nI - 1), -(nI - 1)), Dhi = 4 * b < nI ? min(4 * b + 3, nI - 1) : -nI;
#pragma unroll 1
          for (int Dd = Dlo; Dd <= Dhi; ++Dd) { const int J = I - Dd; const bool valid = (I < nI) && (J >= 0) && (J < nI);
              const LAS bf16* zrow = zin + bc * zb + (valid ? J : 0) * HY_ZS + 8 * hh;
              const int ybase = n - 64 * Dd - ir + 8 * hh;
#pragma unroll
              for (int ks = 0; ks < 4; ++ks) {
                  v4u bw = *(const LAS v4u*)(zrow + 16 * ks); if (!valid) bw = (v4u){0u, 0u, 0u, 0u};
                  const int y0 = ybase + 16 * ks, y1 = y0 - 32;
                  const v4u aw0 = *(const LAS v4u*)(frev8 + (y0 & 7) * cstride + (y0 & ~7)); const v4u aw1 = *(const LAS v4u*)(frev8 + (y1 & 7) * cstride + (y1 & ~7));
                  acc0 = __builtin_amdgcn_mfma_f32_32x32x16_bf16(__builtin_bit_cast(bf16x8_t, aw0), __builtin_bit_cast(bf16x8_t, bw), acc0, 0, 0, 0);
                  acc1 = __builtin_amdgcn_mfma_f32_32x32x16_bf16(__builtin_bit_cast(bf16x8_t, aw1), __builtin_bit_cast(bf16x8_t, bw), acc1, 0, 0, 0);
              } } }
        __syncthreads();
        const int xcol = (o + 1) * HY_W + c;
        HY_STAGE_RAW(xg, xcol, tid_o);
        __syncthreads();
        { const int ir = tid_o & 31, hh = (tid_o >> 5) & 1, bc = ir & 7, I = 4 * b + (ir >> 3); const float skip = F.in[I_HYSKIP][(li * 2 + o) * HY_W + c]; const int rowbase = seg ? NL + bc * LC : bc * SEQ;
          if (I < nI) {
#pragma unroll
              for (int ti = 0; ti < 2; ++ti)
#pragma unroll
                  for (int r = 0; r < 16; ++r) { const int i = 32 * ti + (r & 3) + 8 * (r >> 2) + 4 * hh; const int idx = bc * zb + I * HY_ZS + i;
                      const float a = ti == 0 ? acc0[r] : acc1[r]; const int tq = 64 * I + i; const float zn = HY_CONV(xg, bc, tq, xcol) * (a + skip * bf2f(zin[idx]));
                      if (o == 0) zout[idx] = (bf16)f2bf(zn); else { if (dry) U[(size_t)(rowbase + 64 * I + i) * UA_W + 3456 + (c & 127)] = (bf16)f2bf(zn); else F.wsp<bf16>(WS_RB + RB_YHY)[(size_t)(rowbase + 64 * I + i) * HY_W + c] = (bf16)f2bf(zn); } } } }
        LAS bf16* tmp = zin; zin = zout; zout = tmp;
    }
    __syncthreads();
#undef HY_STAGE_RAW
#undef HY_CONV
}


constexpr int NA_KS = 72;
constexpr int NA_BUF = 2 * 64 * NA_KS * 2 + 256;
template <int kind>
__device__ __forceinline__ void na_job(Frame& F, int li, int b, int h, int gi, int dry) {
    const int lane = F.lane, r = lane & 15, g = lane >> 4, w = F.wave, qg = w & 3, kh = w >> 2;
    bf16* U = F.wsp<bf16>(WS_R1);
    LAS unsigned char* L = F.lds;
    LAS float* rpbs = (LAS float*)(L + 4 * NA_BUF);
    LAS float* comb = (LAS float*)(L + 4 * NA_BUF + 2048);
    const int r0 = min(max(gi - 4, 0), 24);
    const int qrow0 = (kind == 0 ? b * SEQ + gi * 64 : NL + b * LC + gi * 64) + qg * 16;
    const int nloc = kind == 0 ? 8 : 0, nsteps = nloc + 4;
    __syncthreads();
    { const float* rp = F.in[I_NARPB] + (size_t)(li * 6 + h) * 465; if (F.tid < 465) rpbs[F.tid] = rp[F.tid]; }
    bf16x8_t aq[2];
    { const bf16* qp = U + (size_t)(qrow0 + r) * UA_W + UA_NA + h * 64 + 8 * g; float x0[8], x1[8]; unpack8(*(const v4u*)qp, x0); unpack8(*(const v4u*)(qp + 32), x1);
      float ss = 0.f;
#pragma unroll
      for (int e = 0; e < 8; ++e) ss += x0[e] * x0[e] + x1[e] * x1[e];
      ss += __shfl_xor(ss, 16); ss += __shfl_xor(ss, 32);
      const float rq = 0.125f / sqrtf(ss * (1.f / 64.f) + NORM_EPS);
      const float* qg_ = F.in[I_NAQG] + li * 64 + 8 * g; const float* kg_ = F.in[I_NAKG] + li * 64 + 8 * g;
#pragma unroll
      for (int e = 0; e < 8; ++e) { x0[e] *= rq * qg_[e] * kg_[e]; x1[e] *= rq * qg_[32 + e] * kg_[32 + e]; }
      aq[0] = __builtin_bit_cast(bf16x8_t, pack8(x0)); aq[1] = __builtin_bit_cast(bf16x8_t, pack8(x1)); }
    const int qj = qg * 16 + r, c0q = min(max(qj - 8, 0), 48);
    const int wlo = min(max(qg * 16 - 8, 0), 48), whi = min(max(qg * 16 + 15 - 8, 0), 48) + 15;
    const bool half_live = !(32 * kh > whi || 32 * kh + 31 < wlo);
    float lsum = 0.f;
    f32x4 O[4];
#pragma unroll
    for (int dt = 0; dt < 4; ++dt) O[dt] = (f32x4){0.f, 0.f, 0.f, 0.f};
    const int sx = F.tid >> 3, sp = F.tid & 7;
    const int cvs = h * 64 + sx, q6s = (cvs * 10923) >> 16, vsoff = q6s * UA_W + 3072 + (cvs - 6 * q6s) * 64 + 8 * sp;
    const int nst2 = nsteps >> 1;
#define NA_KROW0(rw_) (((rw_) < nloc) ? (b * SEQ + (r0 + (rw_)) * 64) : (NL + b * LC + 64 * ((rw_) - nloc)))
    v4u kA[2], vA[2], kB[2], vB[2];
#define NA_GLOAD(s_, K_, V_) do { _Pragma("unroll") for (int u_ = 0; u_ < 2; ++u_) { const int kb_ = NA_KROW0(2 * (s_) + u_); \
        K_[u_] = *(const v4u*)(U + (size_t)(kb_ + sx) * UA_W + UA_NA + NA_W + h * 64 + 8 * sp); V_[u_] = *(const v4u*)(U + (size_t)kb_ * UA_W + vsoff); } } while (0)
#define NA_LSTORE(buf_, K_, V_) do { _Pragma("unroll") for (int u_ = 0; u_ < 2; ++u_) { LAS unsigned char* B_ = L + (buf_) * (2 * NA_BUF) + u_ * NA_BUF; float y_[8]; unpack8(K_[u_], y_); float ss_ = 0.f; \
        _Pragma("unroll") for (int e = 0; e < 8; ++e) ss_ += y_[e] * y_[e]; \
        ss_ += __shfl_xor(ss_, 1); ss_ += __shfl_xor(ss_, 2); ss_ += __shfl_xor(ss_, 4); \
        *(LAS v4u*)((LAS bf16*)B_ + sx * NA_KS + 8 * sp) = K_[u_]; *(LAS v4u*)((LAS bf16*)(B_ + 64 * NA_KS * 2) + sx * NA_KS + 8 * sp) = V_[u_]; \
        if (sp == 0) ((LAS float*)(B_ + 2 * 64 * NA_KS * 2))[sx] = 1.0f / sqrtf(ss_ * (1.f / 64.f) + NORM_EPS); } } while (0)
    NA_GLOAD(0, kA, vA); NA_LSTORE(0, kA, vA);
    { const int s1 = 1 < nst2 ? 1 : 0; NA_GLOAD(s1, kA, vA); }
    __syncthreads();
#pragma unroll 1
    for (int s = 0; s < nst2; ++s) {
        { const int s2 = s + 2 < nst2 ? s + 2 : nst2 - 1; NA_GLOAD(s2, kB, vB); }
#pragma unroll
        for (int u = 0; u < 2; ++u) { const int rw = 2 * s + u; const bool loc = rw < nloc;
          if (!loc || half_live) {
            LAS unsigned char* B_ = L + (s & 1) * (2 * NA_BUF) + u * NA_BUF; const LAS bf16* Ks = (const LAS bf16*)B_; const LAS bf16* Vt = (const LAS bf16*)(B_ + 64 * NA_KS * 2); const LAS float* rks = (const LAS float*)(B_ + 2 * 64 * NA_KS * 2);
            float p[8];
#pragma unroll
            for (int kt = 0; kt < 2; ++kt) { const int key0 = 32 * kh + 16 * kt;
                const bf16x8_t k0 = *(const LAS bf16x8_t*)(Ks + (key0 + r) * NA_KS + 8 * g), k1 = *(const LAS bf16x8_t*)(Ks + (key0 + r) * NA_KS + 32 + 8 * g);
                const f32x4 rk = *(const LAS f32x4*)(rks + key0 + 4 * g);
                f32x4 acc = {0.f, 0.f, 0.f, 0.f};
                acc = __builtin_amdgcn_mfma_f32_16x16x32_bf16(k0, aq[0], acc, 0, 0, 0);
                acc = __builtin_amdgcn_mfma_f32_16x16x32_bf16(k1, aq[1], acc, 0, 0, 0);
#pragma unroll
                for (int e = 0; e < 4; ++e) { float v = acc[e] * rk[e]; bool ok = true;
                    if (loc) { const int kcol = key0 + 4 * g + e; ok = kcol >= c0q && kcol < c0q + 16; const int dr = r0 + rw - gi + 7, dc = min(max(kcol - qj + 15, 0), 30); v += rpbs[dr * 31 + dc]; }
                    const float pe = ok ? __expf(v) : 0.f; lsum += pe; p[4 * kt + e] = pe; } }
            const v4u pw = {pg8::cvt_pk_bf16(p[0], p[1]), pg8::cvt_pk_bf16(p[2], p[3]), pg8::cvt_pk_bf16(p[4], p[5]), pg8::cvt_pk_bf16(p[6], p[7])}; const bf16x8_t pb = __builtin_bit_cast(bf16x8_t, pw);
#pragma unroll
            for (int dt = 0; dt < 4; ++dt) { const v2u va = *(const LAS v2u*)(Vt + (16 * dt + r) * NA_KS + 32 * kh + 4 * g), vb = *(const LAS v2u*)(Vt + (16 * dt + r) * NA_KS + 32 * kh + 16 + 4 * g);
                const v4u vw = {va.x, va.y, vb.x, vb.y};
                O[dt] = __builtin_amdgcn_mfma_f32_16x16x32_bf16(__builtin_bit_cast(bf16x8_t, vw), pb, O[dt], 0, 0, 0); }
          } }
        NA_LSTORE((s + 1) & 1, kA, vA);
#pragma unroll
        for (int u = 0; u < 2; ++u) { kA[u] = kB[u]; vA[u] = vB[u]; }
        __syncthreads();
    }
#undef NA_KROW0
#undef NA_GLOAD
#undef NA_LSTORE
    if (kh == 1) { LAS float* cp = comb + (qg * 64 + lane) * 17;
#pragma unroll
        for (int dt = 0; dt < 4; ++dt)
#pragma unroll
            for (int e = 0; e < 4; ++e) cp[4 * dt + e] = O[dt][e];
        cp[16] = lsum; }
    __syncthreads();
    if (kh == 0) { const LAS float* cp = comb + (qg * 64 + lane) * 17;
#pragma unroll
        for (int dt = 0; dt < 4; ++dt)
#pragma unroll
            for (int e = 0; e < 4; ++e) O[dt][e] += cp[4 * dt + e];
        lsum += cp[16];
        lsum += __shfl_xor(lsum, 16); lsum += __shfl_xor(lsum, 32);
        const float inv = 1.0f / lsum;
        bf16* op = U + (size_t)(qrow0 + r) * UA_W + (dry ? 3456 + (h & 1) * 64 : UA_NA + h * 64) + 4 * g;
#pragma unroll
        for (int dt = 0; dt < 4; ++dt) *(v2u*)(op + 16 * dt) = (v2u){pk2(O[dt][0] * inv, O[dt][1] * inv), pk2(O[dt][2] * inv, O[dt][3] * inv)}; }
}

__device__ __forceinline__ void na2_job(Frame& F, int li, int b, int h, int gp, int dry) {
    const int lane = F.lane, r = lane & 15, g = lane >> 4, w = F.wave, qg = w & 3, qi = w >> 2;
    bf16* U = F.wsp<bf16>(WS_R1);
    LAS unsigned char* L = F.lds;
    LAS float* rpbs = (LAS float*)(L + 4 * NA_BUF) + 16;
    const int gi = 2 * gp + qi, r0 = min(max(gi - 4, 0), 24), R0 = min(max(2 * gp - 4, 0), 24);
    const int qrow0 = b * SEQ + gi * 64 + qg * 16;
    __syncthreads();
    { const float* rp = F.in[I_NARPB] + (size_t)(li * 6 + h) * 465; if (F.tid < 497) rpbs[F.tid - 16] = (F.tid >= 16 && F.tid < 481) ? rp[F.tid - 16] : 0.f; }
    bf16x8_t aq[2];
    { const bf16* qp = U + (size_t)(qrow0 + r) * UA_W + UA_NA + h * 64 + 8 * g; float x0[8], x1[8]; unpack8(*(const v4u*)qp, x0); unpack8(*(const v4u*)(qp + 32), x1);
      float ss = 0.f;
#pragma unroll
      for (int e = 0; e < 8; ++e) ss += x0[e] * x0[e] + x1[e] * x1[e];
      ss += __shfl_xor(ss, 16); ss += __shfl_xor(ss, 32);
      const float rq = 0.125f / sqrtf(ss * (1.f / 64.f) + NORM_EPS);
      const float* qg_ = F.in[I_NAQG] + li * 64 + 8 * g; const float* kg_ = F.in[I_NAKG] + li * 64 + 8 * g;
#pragma unroll
      for (int e = 0; e < 8; ++e) { x0[e] *= rq * qg_[e] * kg_[e]; x1[e] *= rq * qg_[32 + e] * kg_[32 + e]; }
      aq[0] = __builtin_bit_cast(bf16x8_t, pack8(x0)); aq[1] = __builtin_bit_cast(bf16x8_t, pack8(x1)); }
    const int qj = qg * 16 + r, c0q = min(max(qj - 8, 0), 48);
    const int ks = qg == 0 ? 0 : (qg == 1 ? 8 : (qg == 2 ? 24 : 32));
    float lsum = 0.f;
    f32x4 O[4];
#pragma unroll
    for (int dt = 0; dt < 4; ++dt) O[dt] = (f32x4){0.f, 0.f, 0.f, 0.f};
    const int sx = F.tid >> 3, sp = F.tid & 7;
    const int cvs = h * 64 + sx, q6s = (cvs * 10923) >> 16, vsoff = q6s * UA_W + 3072 + (cvs - 6 * q6s) * 64 + 8 * sp;
    constexpr int NBLK = 13, NST = 7;
#define NA2_KROW0(bk_) (((bk_) < 9) ? (b * SEQ + min(R0 + (bk_), 31) * 64) : (NL + b * LC + 64 * ((bk_) - 9)))
    v4u kA[2], vA[2], kB[2], vB[2];
#define NA2_GLOAD(s_, K_, V_) do { _Pragma("unroll") for (int u_ = 0; u_ < 2; ++u_) { const int bk_ = min(2 * (s_) + u_, NBLK - 1); const int kb_ = NA2_KROW0(bk_); \
        K_[u_] = *(const v4u*)(U + (size_t)(kb_ + sx) * UA_W + UA_NA + NA_W + h * 64 + 8 * sp); V_[u_] = *(const v4u*)(U + (size_t)kb_ * UA_W + vsoff); } } while (0)
#define NA2_LSTORE(buf_, K_, V_) do { _Pragma("unroll") for (int u_ = 0; u_ < 2; ++u_) { LAS unsigned char* B_ = L + (buf_) * (2 * NA_BUF) + u_ * NA_BUF; float y_[8]; unpack8(K_[u_], y_); float ss_ = 0.f; \
        _Pragma("unroll") for (int e = 0; e < 8; ++e) ss_ += y_[e] * y_[e]; \
        ss_ += __shfl_xor(ss_, 1); ss_ += __shfl_xor(ss_, 2); ss_ += __shfl_xor(ss_, 4); \
        *(LAS v4u*)((LAS bf16*)B_ + sx * NA_KS + 8 * sp) = K_[u_]; *(LAS v4u*)((LAS bf16*)(B_ + 64 * NA_KS * 2) + sx * NA_KS + 8 * sp) = V_[u_]; \
        if (sp == 0) ((LAS float*)(B_ + 2 * 64 * NA_KS * 2))[sx] = 1.0f / sqrtf(ss_ * (1.f / 64.f) + NORM_EPS); } } while (0)
#define NA2_PASS(kb_, HASB_, BS_) do { float p[8]; \
        _Pragma("unroll") for (int kt = 0; kt < 2; ++kt) { const int key0 = (kb_) + 16 * kt; \
            const bf16x8_t k0 = *(const LAS bf16x8_t*)(Ks + (key0 + r) * NA_KS + 8 * g), k1 = *(const LAS bf16x8_t*)(Ks + (key0 + r) * NA_KS + 32 + 8 * g); \
            const f32x4 rk = *(const LAS f32x4*)(rks + key0 + 4 * g); \
            f32x4 acc = {0.f, 0.f, 0.f, 0.f}; \
            acc = __builtin_amdgcn_mfma_f32_16x16x32_bf16(k0, aq[0], acc, 0, 0, 0); \
            acc = __builtin_amdgcn_mfma_f32_16x16x32_bf16(k1, aq[1], acc, 0, 0, 0); \
            _Pragma("unroll") for (int e = 0; e < 4; ++e) { const float pe = __expf(HASB_ ? fmaf(acc[e], rk[e], (BS_)[4 * kt + e]) : acc[e] * rk[e]); lsum += pe; p[4 * kt + e] = pe; } } \
        const v4u pw = {pg8::cvt_pk_bf16(p[0], p[1]), pg8::cvt_pk_bf16(p[2], p[3]), pg8::cvt_pk_bf16(p[4], p[5]), pg8::cvt_pk_bf16(p[6], p[7])}; const bf16x8_t pb = __builtin_bit_cast(bf16x8_t, pw); \
        _Pragma("unroll") for (int dt = 0; dt < 4; ++dt) { const v2u va = *(const LAS v2u*)(Vt + (16 * dt + r) * NA_KS + (kb_) + 4 * g), vb = *(const LAS v2u*)(Vt + (16 * dt + r) * NA_KS + (kb_) + 16 + 4 * g); \
            const v4u vw = {va.x, va.y, vb.x, vb.y}; \
            O[dt] = __builtin_amdgcn_mfma_f32_16x16x32_bf16(__builtin_bit_cast(bf16x8_t, vw), pb, O[dt], 0, 0, 0); } } while (0)
    NA2_GLOAD(0, kA, vA); NA2_LSTORE(0, kA, vA);
    NA2_GLOAD(1, kA, vA);
    __syncthreads();
    float mk[8];
#pragma unroll
    for (int j = 0; j < 8; ++j) { const int kcol = ks + 16 * (j >> 2) + 4 * g + (j & 3); mk[j] = (kcol >= c0q && kcol < c0q + 16) ? 0.f : -1.0e30f; }
    const int bcol = ks + 4 * g - qj + 15;
#pragma unroll 1
    for (int s = 0; s < NST; ++s) {
        { const int s2 = s + 2 < NST ? s + 2 : NST - 1; NA2_GLOAD(s2, kB, vB); }
#pragma unroll
        for (int u = 0; u < 2; ++u) { const int bk = 2 * s + u;
          if (bk < NBLK) {
            LAS unsigned char* B_ = L + (s & 1) * (2 * NA_BUF) + u * NA_BUF; const LAS bf16* Ks = (const LAS bf16*)B_; const LAS bf16* Vt = (const LAS bf16*)(B_ + 64 * NA_KS * 2); const LAS float* rks = (const LAS float*)(B_ + 2 * 64 * NA_KS * 2);
            if (bk < 9) { const int krow = R0 + bk;
                if (krow >= r0 && krow < r0 + 8) { const LAS float* bp = rpbs + (krow - gi + 7) * 31 + bcol; float bs[8];
#pragma unroll
                    for (int j = 0; j < 8; ++j) bs[j] = bp[16 * (j >> 2) + (j & 3)] + mk[j];
                    NA2_PASS(ks, true, bs); } }
            else { NA2_PASS(0, false, mk); NA2_PASS(32, false, mk); }
          } }
        NA2_LSTORE((s + 1) & 1, kA, vA);
#pragma unroll
        for (int u = 0; u < 2; ++u) { kA[u] = kB[u]; vA[u] = vB[u]; }
        __syncthreads();
    }
#undef NA2_PASS
#undef NA2_KROW0
#undef NA2_GLOAD
#undef NA2_LSTORE
    lsum += __shfl_xor(lsum, 16); lsum += __shfl_xor(lsum, 32);
    const float inv = 1.0f / lsum;
    bf16* op = U + (size_t)(qrow0 + r) * UA_W + (dry ? 3456 + (h & 1) * 64 : UA_NA + h * 64) + 4 * g;
#pragma unroll
    for (int dt = 0; dt < 4; ++dt) *(v2u*)(op + 16 * dt) = (v2u){pk2(O[dt][0] * inv, O[dt][1] * inv), pk2(O[dt][2] * inv, O[dt][3] * inv)};
}

constexpr int CW_HYQ = 9216, CW_ROQ = 9216 + 64;
__device__ __forceinline__ void p4_hy_na(Frame& F, int li, int dry) {
    unsigned* qh = (unsigned*)(F.ws + WS_CTL) + CW_HYQ + li + 4 * dry;
    volatile LAS unsigned* slot = (volatile LAS unsigned*)(F.lds + LDS_CTL_OFF) + 16;
    const int nhl = (dry && (PROBE_SUB == 2 || PROBE_SUB == 3)) ? 0 : 256, nhc = (dry && (PROBE_SUB == 2 || PROBE_SUB == 3)) ? 0 : (li == 0 ? 256 : 0);
    const int nnl = (dry && (PROBE_SUB == 1 || PROBE_SUB == 3)) ? 0 : 768, nnc = (dry && (PROBE_SUB == 1 || PROBE_SUB == 3)) ? 0 : (li == 0 ? 192 : 0);
#pragma unroll 1
    for (;;) {
        __syncthreads();
        if (F.tid == 0) *slot = __hip_atomic_fetch_add(qh, 1u, __ATOMIC_RELAXED, __HIP_MEMORY_SCOPE_AGENT);
        __syncthreads();
        int job = (int)*slot;
        if (job >= nhl + nnl + nhc + nnc) break;
        if (job < nhl) { hy_job_mfma(F, li, 0, job, dry); continue; } job -= nhl;
        if (job < nnl) { const int bb = job / 96, q = job % 96; na2_job(F, li, bb, q >> 4, q & 15, dry); continue; } job -= nnl;
        if (job < nhc) { hy_job_mfma(F, li, 1, job, dry); continue; } job -= nhc;
        { const int bb = job / 24, q = job % 24; na_job<1>(F, li, bb, q >> 2, q & 3, dry); }
    }
    __syncthreads();
}

constexpr int PPL = 14;
constexpr int N_PHASES = 1 + PPL * NLAYER + 1;
#define IN(k) (lo <= (k) && (k) < hi)
#define SEAM(k) do { if (IN(k) && IN((k) + 1)) xcd_barrier(bar); } while (0)
template <int li> __device__ __forceinline__ void layer_body(Frame& F, const int lo, const int hi, const XcdBarrier& bar) {
    LAS unsigned char* L = F.lds;
    constexpr int pb = 1 + PPL * li;
    constexpr bool last = li == NLAYER - 1;
    constexpr int Mrows = last ? NL : MT;
    bf16* const RA = F.wsp<bf16>(WS_RA); bf16* const UA = F.wsp<bf16>(WS_R1); bf16* const GT = F.wsp<bf16>(WS_WM13);
    const bf16* const WIN = F.wsp<bf16>(WS_WIN + li * SZ_WIN1);
    if (IN(pb + 0)) { for (int rep_ = 0; rep_ < (PROBE_ID == (pb + 0) ? PROBE_REPS : 1); ++rep_) { const int dry = rep_ > 0; (void)dry; F.fresh(); if (rep_) { VM_WAIT(); __syncthreads(); } p1_norm1(F, li); } } SEAM(pb + 0);
    if (IN(pb + 1)) { for (int rep_ = 0; rep_ < (PROBE_ID == (pb + 1) ? PROBE_REPS : 1); ++rep_) { const int dry = rep_ > 0; (void)dry; F.fresh(); if (rep_) { VM_WAIT(); __syncthreads(); }
        pg8::Gemm g{RA, WIN, MT, UA_W, D, D}; pg8::StaticOrder S; S.init(MT, UA_W, F.G, F.bid);
        EpiBf16S<0> E{UA, UA_W, 1.0f};
        GEMM_CALL(EpiBf16S<0>, pg8::StaticOrder, L, g, S, E);
    } } SEAM(pb + 1);
    if (IN(pb + 2)) { for (int rep_ = 0; rep_ < (PROBE_ID == (pb + 2) ? PROBE_REPS : 1); ++rep_) { const int dry = rep_ > 0; (void)dry; F.fresh(); if (rep_) { VM_WAIT(); __syncthreads(); } p3_rw_features(F, li); } } SEAM(pb + 2);
    if (IN(pb + 3)) { for (int rep_ = 0; rep_ < (PROBE_ID == (pb + 3) ? PROBE_REPS : 1); ++rep_) { const int dry = rep_ > 0; (void)dry; F.fresh(); if (rep_) { VM_WAIT(); __syncthreads(); }
#pragma unroll 1
        for (int job = F.bid; job < NCHAIN * NCHUNK; job += F.G) rw_phaseA_job(F, li, job / NCHUNK, job % NCHUNK);
    } } SEAM(pb + 3);
    if (IN(pb + 4)) { for (int rep_ = 0; rep_ < (PROBE_ID == (pb + 4) ? PROBE_REPS : 1); ++rep_) { const int dry = rep_ > 0; (void)dry; F.fresh(); if (rep_) { VM_WAIT(); __syncthreads(); }
        if (F.bid < NCHAIN && !(dry && (PROBE_SUB == 1 || PROBE_SUB == 2))) rw_phaseB_chain(F, F.bid, dry);
        p4_hy_na(F, li, dry);
    } } SEAM(pb + 4);
    if (IN(pb + 5)) { for (int rep_ = 0; rep_ < (PROBE_ID == (pb + 5) ? PROBE_REPS : 1); ++rep_) { const int dry = rep_ > 0; (void)dry; F.fresh(); if (rep_) { VM_WAIT(); __syncthreads(); }
#pragma unroll 1
        for (int job = F.bid; job < NCHAIN * NCHUNK; job += F.G) rw_phaseC_job(F, li, job / NCHUNK, job % NCHUNK, dry);
    } } SEAM(pb + 5);
    if (IN(pb + 6)) { for (int rep_ = 0; rep_ < (PROBE_ID == (pb + 6) ? PROBE_REPS : 1); ++rep_) { const int dry = rep_ > 0; (void)dry; F.fresh(); if (rep_) { VM_WAIT(); __syncthreads(); }
        { pg8::Gemm g{(const bf16*)A1F8_PTR(F, li), WIN + (size_t)UA_W * D, Mrows, GATE_IN, D, D}; pg8::StaticOrder S; S.init(Mrows, GATE_IN, F.G, F.bid);
          EpiBf16S<1> E{GT, GATE_IN, 1.0f / 32.0f};
          GEMM_CALL_F8(EpiBf16S<1>, pg8::StaticOrder, L, g, S, E); }
        { unsigned* qr = (unsigned*)(F.ws + WS_CTL) + CW_ROQ + li + 4 * dry; volatile LAS unsigned* slot = (volatile LAS unsigned*)(F.lds + LDS_CTL_OFF) + 20;
#pragma unroll 1
          for (;;) { __syncthreads();
              if (F.tid == 0) *slot = __hip_atomic_fetch_add(qr, 1u, __ATOMIC_RELAXED, __HIP_MEMORY_SCOPE_AGENT);
              __syncthreads();
              const int blk = (int)*slot; if (blk >= Mrows / 64) break;
              p5_rw_readout(F, li, blk * 64, blk * 64 + 64); } }
    } } SEAM(pb + 6);
    if (IN(pb + 8)) { for (int rep_ = 0; rep_ < (PROBE_ID == (pb + 8) ? PROBE_REPS : 1); ++rep_) { const int dry = rep_ > 0; (void)dry; F.fresh(); if (rep_) { VM_WAIT(); __syncthreads(); }
        const bf16* WBR = F.wsp<bf16>(WS_WBR + li * SZ_WBR1);
        { pg8::Gemm g{UA, WBR, Mrows, D, RW_W, UA_W}; pg8::StaticOrder S; S.init(Mrows, D, F.G, F.bid); EpiMerge<0> E{GT, GATE_IN, RA};
          GEMM_CALL(EpiMerge<0>, pg8::StaticOrder, L, g, S, E); }
        VM_WAIT(); __syncthreads();
        { pg8::Gemm g{F.wsp<bf16>(WS_RB + RB_YHY), WBR + (size_t)D * RW_W, Mrows, D, HY_W, HY_W}; pg8::StaticOrder S; S.init(Mrows, D, F.G, F.bid); EpiMerge<1> E{GT + D, GATE_IN, RA};
          GEMM_CALL(EpiMerge<1>, pg8::StaticOrder, L, g, S, E); }
        VM_WAIT(); __syncthreads();
        { pg8::Gemm g{UA + UA_NA, WBR + (size_t)D * (RW_W + HY_W), Mrows, D, NA_W, UA_W}; pg8::StaticOrder S; S.init(Mrows, D, F.G, F.bid); EpiMerge<1> E{GT + 2 * D, GATE_IN, RA};
          GEMM_CALL(EpiMerge<1>, pg8::StaticOrder, L, g, S, E); }
    } } SEAM(pb + 8);
    if (IN(pb + 9)) { for (int rep_ = 0; rep_ < (PROBE_ID == (pb + 9) ? PROBE_REPS : 1); ++rep_) { const int dry = rep_ > 0; (void)dry; F.fresh(); if (rep_) { VM_WAIT(); __syncthreads(); }
        pg8::Gemm g{RA, F.wsp<bf16>(WS_WOUT + li * SZ_WOUT1), Mrows, D, D, D}; pg8::StaticOrder S; S.init(Mrows, D, F.G, F.bid);
        EpiRes E{li == 0 ? F.in[I_X] : F.out, F.out, li == 0 ? F.in[I_CTX] : F.wsp<float>(WS_CTXRES), F.wsp<float>(WS_CTXRES), F.mods(li, 0), 2 * D, (dry && li > 0) ? 0.f : 1.f};
        GEMM_CALL(EpiRes, pg8::StaticOrder, L, g, S, E);
    } } SEAM(pb + 9);
    if (IN(pb + 10)) { for (int rep_ = 0; rep_ < (PROBE_ID == (pb + 10) ? PROBE_REPS : 1); ++rep_) { const int dry = rep_ > 0; (void)dry; F.fresh(); if (rep_) { VM_WAIT(); __syncthreads(); } p8_norm2(F, li, dry); if (last) { __syncthreads(); moe_weight_transposes(F); } } } SEAM(pb + 10);
    if (!last) {
        if (IN(pb + 11) && IN(pb + 12)) {}
        if (IN(pb + 12)) { for (int rep_ = 0; rep_ < (PROBE_ID == (pb + 12) ? PROBE_REPS : 1); ++rep_) { const int dry = rep_ > 0; (void)dry; F.fresh(); if (rep_) { VM_WAIT(); __syncthreads(); }
            pg8::Gemm g{RA, F.wsp<bf16>(WS_WFF13), MT, 2 * FF, D, D}; pg8::StaticOrder S; S.init(MT, 2 * FF, F.G, F.bid);
            EpiSwiGLU<false> E{F.wsp<bf16>(WS_R1), FF, 2 * FF / 256, 1.0f};
            GEMM_CALL(EpiSwiGLU<false>, pg8::StaticOrder, L, g, S, E);
        } } SEAM(pb + 12);
        if (IN(pb + 13)) { for (int rep_ = 0; rep_ < (PROBE_ID == (pb + 13) ? PROBE_REPS : 1); ++rep_) { const int dry = rep_ > 0; (void)dry; F.fresh(); if (rep_) { VM_WAIT(); __syncthreads(); }
            pg8::Gemm g{F.wsp<bf16>(WS_R1), F.wsp<bf16>(WS_WFF2), MT, D, FF, FF}; pg8::StaticOrder S; S.init(MT, D, F.G, F.bid);
            EpiRes E{F.out, F.out, F.wsp<float>(WS_CTXRES), F.wsp<float>(WS_CTXRES), F.mods(li, 0), 5 * D, dry ? 0.f : 1.f};
            GEMM_CALL(EpiRes, pg8::StaticOrder, L, g, S, E);
        } } SEAM(pb + 13);
    } else {
        if (IN(pb + 11)) { for (int rep_ = 0; rep_ < (PROBE_ID == (pb + 11) ? PROBE_REPS : 1); ++rep_) { const int dry = rep_ > 0; (void)dry; F.fresh(); if (rep_) { VM_WAIT(); __syncthreads(); } p8b_gather(F); } } SEAM(pb + 11);
        const unsigned* cnt = (const unsigned*)(F.ws + WS_CTL) + CW_MOECNT;
        if (IN(pb + 12)) { for (int rep_ = 0; rep_ < (PROBE_ID == (pb + 12) ? PROBE_REPS : 1); ++rep_) { const int dry = rep_ > 0; (void)dry; F.fresh(); if (rep_) { VM_WAIT(); __syncthreads(); }
            pg8::Gemm g{RA, F.wsp<bf16>(WS_WM13), MOE_ROWS, 2 * FFE, D, D}; pg8::MoeOrder S; S.init(cnt, 2 * FFE / 256, F.G, F.bid);
            EpiSwiGLU<true> E{F.wsp<bf16>(WS_R1), FFE, 2 * FFE / 256, 1.0f / 32.0f};
            GEMM_CALL_F8(EpiSwiGLU<true>, pg8::MoeOrder, L, g, S, E);
        } } SEAM(pb + 12);
        if (IN(pb + 13)) { for (int rep_ = 0; rep_ < (PROBE_ID == (pb + 13) ? PROBE_REPS : 1); ++rep_) { const int dry = rep_ > 0; (void)dry; F.fresh(); if (rep_) { VM_WAIT(); __syncthreads(); }
            pg8::Gemm g{F.wsp<bf16>(WS_R1), F.wsp<bf16>(WS_WM2), MOE_ROWS, D, FFE, FFE}; pg8::MoeOrder S; S.init(cnt, D / 256, F.G, F.bid);
            EpiMoeY E{RA, 1.0f / 256.0f};
            GEMM_CALL_F8(EpiMoeY, pg8::MoeOrder, L, g, S, E);
        } } SEAM(pb + 13);
        if (IN(pb + 14)) { for (int rep_ = 0; rep_ < (PROBE_ID == (pb + 14) ? PROBE_REPS : 1); ++rep_) { const int dry = rep_ > 0; (void)dry; F.fresh(); if (rep_) { VM_WAIT(); __syncthreads(); } p11_moe_combine(F, li, dry); } }
    }
}
#undef IN
#undef SEAM
__global__ void __launch_bounds__(NTHREADS, 2) fwd_kernel(Args args) {
    extern __shared__ __attribute__((aligned(16))) unsigned char lds_raw[];
    Frame F;
    F.lds = (LAS unsigned char*)lds_raw;
    F.tid = threadIdx.x; F.lane = F.tid & 63; F.wave = __builtin_amdgcn_readfirstlane(F.tid >> 6);
    F.G = gridDim.x; F.bid = blockIdx.x;
    F.in = (const CAS cfp*)__builtin_amdgcn_kernarg_segment_ptr(); F.out = args.out; F.ws = args.ws;
    volatile LAS unsigned* MISC = (volatile LAS unsigned*)(F.lds + LDS_CTL_OFF);
    if (F.tid < 64) MISC[F.tid] = 0u;
    __syncthreads();
    const int lo = args.ph_lo, hi = args.ph_hi;
    XcdBarrier bar; bar.bar = (unsigned*)(F.ws + WS_CTL) + CW_BAR; bar.x = 0; bar.st = nullptr;
    if (hi - lo > 1) bar = xcd_barrier_post((unsigned*)(F.ws + WS_CTL) + CW_BAR, MISC + 8);
    if (lo <= 0 && 0 < hi) { for (int rep_ = 0; rep_ < (PROBE_ID == 0 ? PROBE_REPS : 1); ++rep_) { F.fresh(); if (rep_) { VM_WAIT(); __syncthreads(); } p0_prologue(F); } }
    if (lo <= 0 && 1 < hi) xcd_barrier(bar);
    layer_body<0>(F, lo, hi, bar);
    layer_body<1>(F, lo, hi, bar);
}

extern "C" void kernel_launch(void* const* d_in, const int* in_sizes, int n_in, void* d_out, int out_size, void* d_ws, size_t ws_size, hipStream_t stream) {
    static int grid = 0;
    if (grid == 0) {
        if (n_in != N_IN || out_size != NL * D || ws_size < WS_END) { fprintf(stderr, "kernel_launch: shape/workspace mismatch (n_in %d, out %d, ws %zu, need %zu); nothing launched\n", n_in, out_size, ws_size, (size_t)WS_END); grid = -1; return; }
        int dev = 0, cus = 0, per_cu = 0;
        if (hipGetDevice(&dev) != hipSuccess || hipDeviceGetAttribute(&cus, hipDeviceAttributeMultiprocessorCount, dev) != hipSuccess) { grid = -1; return; }
        if (hipFuncSetAttribute((const void*)fwd_kernel, hipFuncAttributeMaxDynamicSharedMemorySize, LDS_BYTES) != hipSuccess) { fprintf(stderr, "kernel_launch: hipFuncSetAttribute failed\n"); grid = -1; return; }
        if (hipOccupancyMaxActiveBlocksPerMultiprocessor(&per_cu, (const void*)fwd_kernel, NTHREADS, LDS_BYTES) != hipSuccess || per_cu < 1) fprintf(stderr, "kernel_launch: occupancy query says %d\n", per_cu);
        (void)hipGetLastError();
        grid = cus;
    }
    if (grid < 0) return;
    if (hipMemsetAsync((char*)d_ws + WS_CTL, 0, CTL_ZERO_BYTES, stream) != hipSuccess) return;
    Args a{};
    for (int i = 0; i < N_IN; ++i) a.in[i] = (const float*)d_in[i];
    a.out = (float*)d_out; a.ws = (unsigned char*)d_ws;
#if MK_ONE_LAUNCH
    a.ph_lo = 0; a.ph_hi = N_PHASES;
    hipLaunchKernelGGL(fwd_kernel, dim3(grid), dim3(NTHREADS), LDS_BYTES, stream, a);
#else
    for (int p = 0; p < N_PHASES; ++p) {
        if (p == 1 + 11) continue;
        a.ph_lo = p; a.ph_hi = p + 1;
        hipLaunchKernelGGL(fwd_kernel, dim3(grid), dim3(NTHREADS), LDS_BYTES, stream, a);
    }
#endif
}
```

```cpp
#include <hip/hip_runtime.h>
#include <cstdio>
#include <cstdint>

#ifndef MK_ONE_LAUNCH
#define MK_ONE_LAUNCH 1
#endif
#ifndef PROBE_ID
#define PROBE_ID (-1)
#endif
#ifndef PROBE_REPS
#define PROBE_REPS 2
#endif
#ifndef PROBE_SUB
#define PROBE_SUB 0
#endif
#ifndef USE_NAIVE_GEMM
#define USE_NAIVE_GEMM 0
#endif

namespace pg8 {
#define PG8_LAS __attribute__((address_space(3)))
typedef unsigned short bf16_t;
typedef short bf16x8 __attribute__((ext_vector_type(8)));
typedef float f32x4 __attribute__((ext_vector_type(4)));
typedef unsigned u32x4 __attribute__((ext_vector_type(4)));
constexpr int BM = 256, BK = 64, HALF = 128, HTB = HALF * BK * 2  , STAGE_BYTES = 8 * HTB, NXCD = 8, WGM = 8;

__host__ __device__ __forceinline__ int lds_byte(int r, int c) { const int st = (r >> 4) * 2 + (c >> 5), rr = r & 15, cc = c & 31, ob = rr * 64 + cc * 2; return st * 1024 + (ob ^ (((ob >> 9) & 1) << 5)); }
__host__ __device__ __forceinline__ void stage_rc(int b, int& R, int& C) { const int st = b / 1024, sb = b % 1024, swz = sb ^ (((sb >> 9) & 1) << 5); R = (st >> 1) * 16 + swz / 64; C = (st & 1) * 32 + (swz % 64) / 2; }
__host__ __device__ __forceinline__ int perm32(int rho) { const int n = rho >> 4, i = rho & 15; return 8 * (i >> 2) + 4 * n + (i & 3); }

struct Unit { int pm, pn; };
struct Gemm { const bf16_t* A; const bf16_t* Bt; int M, N, K, lda; };

struct StaticOrder {
    int nM, nN, nwg, G, c;
    __host__ __device__ void init(int M, int N, int G_, int c_) { nM = M / BM; nN = N / BM; nwg = nM * nN; G = G_; c = c_; }
    __host__ __device__ bool next(int i, Unit& u) const {
        const long L = (long)i * G + c; if (L >= nwg) return false;
        int wgid = (int)L; { const int q = nwg / NXCD, r = nwg % NXCD, xcd = wgid % NXCD, off = wgid / NXCD; wgid = (xcd < r ? xcd * (q + 1) : r * (q + 1) + (xcd - r) * q) + off; }
        const int nig = WGM * nN, gid = wgid / nig, fm = gid * WGM, gsz = (nM - fm) < WGM ? (nM - fm) : WGM;
        u.pm = fm + ((wgid % nig) % gsz); u.pn = (wgid % nig) / gsz; return true;
    }
    __device__ __forceinline__ void a_ready(const Unit&) const {}
    __device__ __forceinline__ void done(const Unit&) const {}
};
struct MoeOrder {
    int nM, nN, nwg, G, c; int toff[9];
    __device__ void init(const unsigned* cnt, int nN_, int G_, int c_) {
        int t = 0;
#pragma unroll
        for (int e = 0; e < 8; ++e) { toff[e] = t; t += (int)((__builtin_amdgcn_readfirstlane(cnt[64 * e]) + 255u) >> 8); }
        toff[8] = t; nM = t; nN = nN_; nwg = nM * nN; G = G_; c = c_;
    }
    __device__ bool next(int i, Unit& u) const {
        const long L = (long)i * G + c; if (L >= nwg) return false;
        int wgid = (int)L; { const int q = nwg / NXCD, r = nwg % NXCD, xcd = wgid % NXCD, off = wgid / NXCD; wgid = (xcd < r ? xcd * (q + 1) : r * (q + 1) + (xcd - r) * q) + off; }
        const int nig = WGM * nN, gid = wgid / nig, fm = gid * WGM, gsz = (nM - fm) < WGM ? (nM - fm) : WGM;
        const int pm = fm + ((wgid % nig) % gsz), pn = (wgid % nig) / gsz;
        int e = 0;
#pragma unroll
        for (int k = 1; k < 8; ++k) e += (pm >= toff[k]) ? 1 : 0;
        u.pm = pm; u.pn = e * nN + pn; return true;
    }
    __device__ __forceinline__ void a_ready(const Unit&) const {}
    __device__ __forceinline__ void done(const Unit&) const {}
};

__device__ __forceinline__ unsigned cvt_pk_bf16(float lo, float hi) { unsigned r; asm volatile("v_cvt_pk_bf16_f32 %0, %1, %2" : "=v"(r) : "v"(lo), "v"(hi)); return r; }

typedef int i32x4_t __attribute__((ext_vector_type(4)));
typedef int i32x8_t __attribute__((ext_vector_type(8)));
template <class Epi, class Sched, bool ALIGN_EPI = false, bool SP2 = false, bool F8 = false>
__device__ __forceinline__ void gemm_phase(PG8_LAS unsigned char* lds, const Gemm g, const Sched& S, const Epi& E) {
    int tid_ = threadIdx.x; asm volatile("" : "+v"(tid_));
    const int tid = tid_, wid = __builtin_amdgcn_readfirstlane(tid >> 6), lane = tid & 63, wr = wid >> 2, wc = wid & 3, fr = lane & 15, fq = lane >> 4;
    constexpr int ES = F8 ? 1 : 2;
    const int K = g.K, nt = K * ES / (BK * 2), LDA = g.lda;
    unsigned voffA[2], voffB[2];
#pragma unroll
    for (int i = 0; i < 2; ++i) { int R, C; stage_rc(tid * 16 + i * 8192, R, C); const int Rb = Epi::PERM ? ((R & ~31) + perm32(R & 31)) : R;
        voffA[i] = (unsigned)(R * LDA * ES + C * 2); voffB[i] = (unsigned)(Rb * K * ES + C * 2); }
    const size_t kstep = (size_t)(BK * 2);
    const size_t hstepA = (size_t)HALF * LDA * ES, hstepB = (size_t)HALF * K * ES;
    const size_t tstepA = 2 * hstepA, tstepB = 2 * hstepB;
    const unsigned ldsw = (unsigned)wid * 1024u;
    const int aoff = lds_byte(wr * 64 + fr, fq * 8), boff = lds_byte(wc * 32 + fr, fq * 8);
#define PG8_SA(b, h) (((b) * 2 + (h)) * HTB)
#define PG8_SB(b, h) ((4 + (b) * 2 + (h)) * HTB)
#define PG8_STAGE(bufoff, gbase, voff) do { _Pragma("unroll") for (int _i = 0; _i < 2; ++_i) \
        __builtin_amdgcn_global_load_lds((const unsigned*)((const char*)(gbase) + (voff)[_i]), (PG8_LAS unsigned*)(lds + (bufoff) + ldsw + _i * 8192), 16, 0, 0); } while (0)
#define PG8_LDA(dst, b, h) do { _Pragma("unroll") for (int m = 0; m < 4; ++m) _Pragma("unroll") for (int k = 0; k < 2; ++k) dst[m][k] = *(const PG8_LAS bf16x8*)(lds + PG8_SA(b, h) + aoff + m * 2048 + k * 1024); } while (0)
#define PG8_LDB(dst, b, h) do { _Pragma("unroll") for (int n = 0; n < 2; ++n) _Pragma("unroll") for (int k = 0; k < 2; ++k) dst[n][k] = *(const PG8_LAS bf16x8*)(lds + PG8_SB(b, h) + boff + n * 2048 + k * 1024); } while (0)
#define PG8_CAT8(x_, y_) __builtin_shufflevector(__builtin_bit_cast(i32x4_t, (x_)), __builtin_bit_cast(i32x4_t, (y_)), 0, 1, 2, 3, 4, 5, 6, 7)
#define PG8_MMA(ai, bj, At, Bt) do { __builtin_amdgcn_s_setprio(1); \
        if constexpr (F8) { _Pragma("unroll") for (int m = 0; m < 4; ++m) _Pragma("unroll") for (int n = 0; n < 2; ++n) \
            { const i32x8_t b8_ = PG8_CAT8(Bt[n][0], Bt[n][1]), a8_ = PG8_CAT8(At[m][0], At[m][1]); \
              asm volatile("v_mfma_f32_16x16x128_f8f6f4 %0, %1, %2, %0" : "+v"(acc[ai][bj][m][n]) : "v"(b8_), "v"(a8_)); } } \
        else { _Pragma("unroll") for (int m = 0; m < 4; ++m) _Pragma("unroll") for (int n = 0; n < 2; ++n) _Pragma("unroll") for (int k = 0; k < 2; ++k) \
            acc[ai][bj][m][n] = __builtin_amdgcn_mfma_f32_16x16x32_bf16(Bt[n][k], At[m][k], acc[ai][bj][m][n], 0, 0, 0); } \
        __builtin_amdgcn_s_setprio(0); } while (0)
#define PG8_WAIT_V(n) asm volatile("s_waitcnt vmcnt(" #n ")" ::: "memory")
#define PG8_WAIT_L(n) asm volatile("s_waitcnt lgkmcnt(" #n ")" ::: "memory")
#define PG8_BAR __builtin_amdgcn_s_barrier()
#define PG8_SCHED __builtin_amdgcn_sched_barrier(0)
    Unit cur, nxt; int ui = 0;
    if (!S.next(0, cur)) return;
    f32x4 acc[2][2][4][2];
#pragma unroll
    for (int a = 0; a < 2; ++a)
#pragma unroll
        for (int b = 0; b < 2; ++b)
#pragma unroll
            for (int m = 0; m < 4; ++m)
#pragma unroll
                for (int n = 0; n < 2; ++n) acc[a][b][m][n] = (f32x4){0.f, 0.f, 0.f, 0.f};
    bf16x8 At[4][2], B0[2][2], B1[2][2];
    const char* cA = (const char*)g.A + (size_t)cur.pm * tstepA; const char* cB = (const char*)g.Bt + (size_t)cur.pn * tstepB;
    S.a_ready(cur);
    if constexpr (SP2) {
        PG8_STAGE(PG8_SB(0, 0), cB, voffB); PG8_STAGE(PG8_SB(0, 1), cB + hstepB, voffB); PG8_STAGE(PG8_SA(0, 0), cA, voffA); PG8_STAGE(PG8_SA(0, 1), cA + hstepA, voffA);
        if (wr == 1) PG8_BAR;
        PG8_WAIT_V(2); PG8_BAR;
        PG8_STAGE(PG8_SB(1, 0), cB + kstep, voffB); PG8_STAGE(PG8_SA(1, 0), cA + kstep, voffA); PG8_STAGE(PG8_SB(1, 1), cB + hstepB + kstep, voffB);
        PG8_WAIT_V(6); PG8_BAR;
    } else {
        PG8_STAGE(PG8_SB(0, 0), cB, voffB); PG8_STAGE(PG8_SA(0, 0), cA, voffA); PG8_STAGE(PG8_SB(0, 1), cB + hstepB, voffB); PG8_STAGE(PG8_SA(0, 1), cA + hstepA, voffA);
        if (wr == 1) PG8_BAR;
        PG8_WAIT_V(4); PG8_BAR;
        PG8_STAGE(PG8_SB(1, 0), cB + kstep, voffB); PG8_STAGE(PG8_SA(1, 0), cA + kstep, voffA); PG8_STAGE(PG8_SB(1, 1), cB + hstepB + kstep, voffB);
        PG8_WAIT_V(6); PG8_BAR;
    }
    for (;;) {
        const bool has_next = S.next(ui + 1, nxt);
        const char* nA = has_next ? (const char*)g.A + (size_t)nxt.pm * tstepA : cA; const char* nB = has_next ? (const char*)g.Bt + (size_t)nxt.pn * tstepB : cB;
#pragma unroll 1
        for (int t = 0; t < nt; t += 2) {
            const bool last = (t == nt - 2);
            const char* a1 = cA + (size_t)(t + 1) * kstep;
            const char* a2 = last ? nA : cA + (size_t)(t + 2) * kstep; const char* b2 = last ? nB : cB + (size_t)(t + 2) * kstep;
            const char* a3 = a2 + kstep; const char* b3 = b2 + kstep;
            if (last && has_next) S.a_ready(nxt);
            if constexpr (SP2) {
            PG8_LDB(B0, 0, 0); PG8_LDB(B1, 0, 1); PG8_SCHED; PG8_LDA(At, 0, 0); PG8_STAGE(PG8_SA(1, 1), a1 + hstepA, voffA);
            PG8_WAIT_V(8); PG8_WAIT_L(0); PG8_BAR; PG8_MMA(0, 0, At, B0); PG8_MMA(0, 1, At, B1); PG8_BAR; PG8_SCHED;
            PG8_LDA(At, 0, 1); PG8_STAGE(PG8_SB(0, 0), b2, voffB); PG8_STAGE(PG8_SB(0, 1), b2 + hstepB, voffB); PG8_STAGE(PG8_SA(0, 0), a2, voffA);
            PG8_WAIT_V(8); PG8_WAIT_L(0); PG8_BAR; PG8_MMA(1, 0, At, B0); PG8_MMA(1, 1, At, B1); PG8_BAR; PG8_SCHED;
            PG8_LDB(B0, 1, 0); PG8_LDB(B1, 1, 1); PG8_SCHED; PG8_LDA(At, 1, 0); PG8_STAGE(PG8_SA(0, 1), a2 + hstepA, voffA);
            PG8_WAIT_V(8); PG8_WAIT_L(0); PG8_BAR; PG8_MMA(0, 0, At, B0); PG8_MMA(0, 1, At, B1); PG8_BAR; PG8_SCHED;
            PG8_LDA(At, 1, 1); PG8_STAGE(PG8_SB(1, 0), b3, voffB); PG8_STAGE(PG8_SB(1, 1), b3 + hstepB, voffB); PG8_STAGE(PG8_SA(1, 0), a3, voffA);
            PG8_WAIT_V(8); PG8_WAIT_L(0); PG8_BAR; PG8_MMA(1, 0, At, B0); PG8_MMA(1, 1, At, B1); PG8_BAR; PG8_SCHED;
            } else {
            PG8_LDB(B0, 0, 0); PG8_SCHED; PG8_LDA(At, 0, 0); PG8_STAGE(PG8_SA(1, 1), a1 + hstepA, voffA);
            PG8_WAIT_L(8); PG8_BAR; PG8_WAIT_L(0); PG8_MMA(0, 0, At, B0); PG8_BAR; PG8_SCHED;
            PG8_LDB(B1, 0, 1); PG8_STAGE(PG8_SB(0, 0), b2, voffB);
            PG8_BAR; PG8_WAIT_L(0); PG8_MMA(0, 1, At, B1); PG8_BAR;
            PG8_LDA(At, 0, 1); PG8_STAGE(PG8_SA(0, 0), a2, voffA);
            PG8_BAR; PG8_WAIT_L(0); PG8_MMA(1, 0, At, B0); PG8_BAR; PG8_SCHED;
            PG8_STAGE(PG8_SB(0, 1), b2 + hstepB, voffB);
            PG8_WAIT_V(6); PG8_BAR; PG8_MMA(1, 1, At, B1); PG8_BAR;
            PG8_LDB(B0, 1, 0); PG8_SCHED; PG8_LDA(At, 1, 0); PG8_STAGE(PG8_SA(0, 1), a2 + hstepA, voffA);
            PG8_WAIT_L(8); PG8_BAR; PG8_WAIT_L(0); PG8_MMA(0, 0, At, B0); PG8_BAR; PG8_SCHED;
            PG8_LDB(B1, 1, 1); PG8_STAGE(PG8_SB(1, 0), b3, voffB);
            PG8_BAR; PG8_WAIT_L(0); PG8_MMA(0, 1, At, B1); PG8_BAR;
            PG8_LDA(At, 1, 1); PG8_STAGE(PG8_SA(1, 0), a3, voffA);
            PG8_BAR; PG8_WAIT_L(0); PG8_MMA(1, 0, At, B0); PG8_BAR; PG8_SCHED;
            PG8_STAGE(PG8_SB(1, 1), b3 + hstepB, voffB);
            PG8_WAIT_V(6); PG8_BAR; PG8_MMA(1, 1, At, B1); PG8_BAR;
            }
        }
        if constexpr (F8) asm volatile("s_nop 15\n\ts_nop 15" ::: "memory");
        if constexpr (ALIGN_EPI) { if (wr == 0) PG8_BAR; }
        if constexpr (F8) { int t2 = threadIdx.x; asm volatile("" : "+v"(t2));
            const int wid2 = __builtin_amdgcn_readfirstlane(t2 >> 6), lane2 = t2 & 63; E(acc, cur, wid2 >> 2, wid2 & 3, lane2 & 15, lane2 >> 4); }
        else E(acc, cur, wr, wc, fr, fq);
        S.done(cur);
        if (!has_next) break;
#pragma unroll
        for (int a = 0; a < 2; ++a)
#pragma unroll
            for (int b = 0; b < 2; ++b)
#pragma unroll
                for (int m = 0; m < 4; ++m)
#pragma unroll
                    for (int n = 0; n < 2; ++n) acc[a][b][m][n] = (f32x4){0.f, 0.f, 0.f, 0.f};
        cur = nxt; cA = nA; cB = nB; ++ui;
        if constexpr (ALIGN_EPI) { if (wr == 1) PG8_BAR; }
    }
    PG8_WAIT_V(0);
    if constexpr (!ALIGN_EPI) { if (wr == 0) PG8_BAR; }
    PG8_BAR;
#undef PG8_SA
#undef PG8_SB
#undef PG8_STAGE
#undef PG8_LDA
#undef PG8_LDB
#undef PG8_MMA
#undef PG8_CAT8
#undef PG8_WAIT_V
#undef PG8_WAIT_L
#undef PG8_BAR
#undef PG8_SCHED
}

template <class Epi, class Sched>
__device__ __forceinline__ void gemm_naive(PG8_LAS unsigned char* lds, const Gemm g, const Sched& S, const Epi& E) {
    const int tid = threadIdx.x, wid = __builtin_amdgcn_readfirstlane(tid >> 6), lane = tid & 63, wr = wid >> 2, wc = wid & 3, fr = lane & 15, fq = lane >> 4;
    PG8_LAS float* As = (PG8_LAS float*)lds; PG8_LAS float* Bs = As + 256 * 33;
    Unit u;
    for (int ui = 0; S.next(ui, u); ++ui) {
        f32x4 acc[2][2][4][2];
#pragma unroll
        for (int a = 0; a < 2; ++a)
#pragma unroll
            for (int b = 0; b < 2; ++b)
#pragma unroll
                for (int m = 0; m < 4; ++m)
#pragma unroll
                    for (int n = 0; n < 2; ++n) acc[a][b][m][n] = (f32x4){0.f, 0.f, 0.f, 0.f};
        for (int k0 = 0; k0 < g.K; k0 += 32) {
            __syncthreads();
            for (int i = tid; i < 256 * 32; i += 512) { const int r = i >> 5, c = i & 31;
                As[r * 33 + c] = __uint_as_float(((unsigned)g.A[(size_t)(u.pm * 256 + r) * g.lda + k0 + c]) << 16);
                Bs[r * 33 + c] = __uint_as_float(((unsigned)g.Bt[(size_t)(u.pn * 256 + r) * g.K + k0 + c]) << 16); }
            __syncthreads();
            for (int kk = 0; kk < 32; ++kk) {
                float a[2][4], b[2][2][4];
#pragma unroll
                for (int ai = 0; ai < 2; ++ai)
#pragma unroll
                    for (int m = 0; m < 4; ++m) a[ai][m] = As[(128 * ai + 64 * wr + 16 * m + fr) * 33 + kk];
#pragma unroll
                for (int bj = 0; bj < 2; ++bj)
#pragma unroll
                    for (int n = 0; n < 2; ++n)
#pragma unroll
                        for (int j = 0; j < 4; ++j) { const int cl = Epi::PERM ? (128 * bj + 32 * wc + 8 * fq + 4 * n + j) : (128 * bj + 32 * wc + 16 * n + 4 * fq + j); b[bj][n][j] = Bs[cl * 33 + kk]; }
#pragma unroll
                for (int ai = 0; ai < 2; ++ai)
#pragma unroll
                    for (int bj = 0; bj < 2; ++bj)
#pragma unroll
                        for (int m = 0; m < 4; ++m)
#pragma unroll
                            for (int n = 0; n < 2; ++n)
#pragma unroll
                                for (int j = 0; j < 4; ++j) acc[ai][bj][m][n][j] += a[ai][m] * b[bj][n][j];
            }
        }
        E(acc, u, wr, wc, fr, fq);
    }
    __syncthreads();
}
}

constexpr int D = 1024, NB = 8, SEQ = 2048, LC = 256, NLAYER = 2;
constexpr int NL = NB * SEQ;
constexpr int NC = NB * LC;
constexpr int MT = NL + NC;
constexpr int GRID_W = 64;
constexpr int RW_W = 384, RW_IN = 1536, HY_W = 256, HY_IN = 768, NA_W = 384, NA_IN = 1152, GATE_IN = 3072, P_IN = 6528;
constexpr int UA_W = 3584;
constexpr int UA_HY = 1536, UA_NA = 2304;
constexpr int WIN_ROWS = UA_W + GATE_IN;
constexpr int FF = 2816, FFE = 3584, NE = 8;
constexpr int MOE_ROWS = 2 * NL + NE * 256;
constexpr int NFEAT = 8;
constexpr float NORM_EPS = 1e-6f, RW_GN_EPS = 64e-5f;

enum { I_X = 0, I_C, I_CTX, I_CCTX, I_ADAW, I_ADAB, I_N1G, I_N2G, I_WIN, I_RWSHIFT, I_RWW0, I_RWW2, I_RWA0, I_RWA2, I_RWG2, I_RWKK, I_RWKA, I_RWRK, I_RWGNG, I_RWGNB,
       I_HYCW, I_HYCB, I_HYW1, I_HYB1, I_HYW2, I_HYB2, I_HYW3, I_HYFREQ, I_HYSKIP, I_NAQG, I_NAKG, I_NARPB, I_WBRRW, I_WBRHY, I_WBRNA, I_WOUT, I_FFW1, I_FFW3, I_FFW2,
       I_MOER, I_MOEW1, I_MOEW3, I_MOEW2, N_IN };

constexpr size_t al256(size_t x) { return (x + 255) & ~(size_t)255; }
constexpr size_t WS_CTL = 0, CTL_ZERO_BYTES = 1u << 20;
constexpr size_t CTL_MODS_OFF = 65536;
static_assert(CTL_MODS_OFF + (size_t)NLAYER * 9 * 6144 * 4 <= CTL_ZERO_BYTES, "mods inside memset region");
constexpr int CW_BAR = 4096;
constexpr int CW_MOECNT = 8192;
constexpr size_t WS_WIN = CTL_ZERO_BYTES;
constexpr size_t SZ_WIN1 = (size_t)WIN_ROWS * D * 2;
constexpr size_t WS_WBR = WS_WIN + 2 * SZ_WIN1;
constexpr size_t SZ_WBR1 = (size_t)D * 1024 * 2;
constexpr size_t WS_WOUT = WS_WBR + 2 * SZ_WBR1;
constexpr size_t SZ_WOUT1 = (size_t)D * D * 2;
constexpr size_t WS_WFF13 = WS_WOUT + 2 * SZ_WOUT1;
constexpr size_t WS_WFF2 = WS_WFF13 + (size_t)2 * FF * D * 2;
constexpr size_t WS_WM13 = WS_WFF2 + (size_t)D * FF * 2;
constexpr size_t WS_WM2 = WS_WM13 + (size_t)NE * 2 * FFE * D * 2;
constexpr size_t WS_CTXRES = WS_WM2 + (size_t)NE * D * FFE * 2;
constexpr size_t WS_W13F8 = WS_WM13 + (size_t)96 * 36 * 32768;
constexpr size_t WS_W2F8 = WS_WM13;
constexpr size_t WS_FILT = WS_CTXRES + (size_t)NC * D * 4;
constexpr size_t WS_FILTC = WS_FILT + (size_t)2 * 2 * 256 * 4096 * 2;
constexpr size_t WS_H2BUF = WS_FILTC + (size_t)2 * 256 * 512 * 2;
constexpr size_t WS_MISC = WS_H2BUF + (size_t)2 * 2 * 2048 * 64 * 4;
constexpr size_t MISC_SEL = 0;
constexpr size_t MISC_ROWTOK = MISC_SEL + (size_t)NL * 32;
constexpr size_t MISC_ROWWGT = MISC_ROWTOK + (size_t)MOE_ROWS * 4;
constexpr int RWT_W2 = 0, RWT_A2 = 2 * 384 * 64, RWT_G2 = 4 * 384 * 64, RWT_PER_LAYER = 4 * 384 * 64 + 384 * 128;
constexpr size_t MISC_RWT = al256(MISC_ROWWGT + (size_t)MOE_ROWS * 4);
constexpr size_t MISC_ROPE = MISC_RWT + (size_t)2 * (4 * 384 * 64 + 384 * 128) * 2;
constexpr size_t WS_RA = al256(WS_MISC + MISC_ROPE + 64 * 16 * 2 * 4);
constexpr size_t SZ_RA = (size_t)MT * D * 2;
constexpr size_t WS_RB = WS_RA + SZ_RA;
constexpr size_t RB_YHY = (size_t)2 * MT * RW_W * 2;
static_assert(RB_YHY + (size_t)MT * HY_W * 2 <= SZ_RA, "RB map");
constexpr size_t WS_R1 = WS_RB + SZ_RA;
constexpr size_t SZ_UA = (size_t)MT * UA_W * 2;
constexpr size_t R1_FEAT = SZ_UA;
constexpr size_t R1_G = SZ_UA;
constexpr size_t SZ_R1 = (size_t)MOE_ROWS * FFE * 2;
static_assert(SZ_UA + (size_t)MT * NFEAT * RW_W * 2 <= SZ_R1 && SZ_UA + (size_t)MT * GATE_IN * 2 <= SZ_R1 && (size_t)MT * FF * 2 <= SZ_R1, "R1 map");
static_assert((size_t)MOE_ROWS * D * 2 <= 2 * SZ_RA, "A_sorted fits RA+RB");
constexpr size_t R1_H2U = 0;
constexpr size_t WS_END = WS_R1 + SZ_R1;

constexpr int LDS_BYTES = 147456;
constexpr int LDS_CTL_OFF = LDS_BYTES - 256;
constexpr int NWAVES = 8, NTHREADS = 512;

#define GAS __attribute__((address_space(1)))
#define LAS __attribute__((address_space(3)))
typedef unsigned short bf16;
typedef unsigned v4u __attribute__((ext_vector_type(4)));
typedef unsigned v2u __attribute__((ext_vector_type(2)));
typedef float f32x4 __attribute__((ext_vector_type(4)));
typedef float f32x2 __attribute__((ext_vector_type(2)));
__device__ __forceinline__ unsigned f2bf(float f) { unsigned u = __builtin_bit_cast(unsigned, f); return (u + 0x7fffu + ((u >> 16) & 1u)) >> 16; }
__device__ __forceinline__ unsigned pk2(float lo, float hi) { return f2bf(lo) | (f2bf(hi) << 16); }
__device__ __forceinline__ float bf2f(bf16 v) { return __uint_as_float(((unsigned)v) << 16); }
__device__ __forceinline__ float bflo(unsigned w) { return __uint_as_float(w << 16); }
__device__ __forceinline__ float bfhi(unsigned w) { return __uint_as_float(w & 0xffff0000u); }
__device__ __forceinline__ void unpack8(const v4u w, float (&x)[8]) { x[0] = bflo(w.x); x[1] = bfhi(w.x); x[2] = bflo(w.y); x[3] = bfhi(w.y); x[4] = bflo(w.z); x[5] = bfhi(w.z); x[6] = bflo(w.w); x[7] = bfhi(w.w); }
__device__ __forceinline__ v4u pack8(const float (&x)[8]) { v4u w; w.x = pk2(x[0], x[1]); w.y = pk2(x[2], x[3]); w.z = pk2(x[4], x[5]); w.w = pk2(x[6], x[7]); return w; }
__device__ __forceinline__ float sigmoidf_(float x) { return 1.0f / (1.0f + __expf(-x)); }
__device__ __forceinline__ float siluf_(float x) { return x / (1.0f + __expf(-x)); }
__device__ __forceinline__ unsigned pk4_fp8(float a, float b, float c, float d) { int p = __builtin_amdgcn_cvt_pk_fp8_f32(a, b, 0, false); p = __builtin_amdgcn_cvt_pk_fp8_f32(c, d, p, true); return (unsigned)p; }
__device__ __forceinline__ float wave_sum(float v) {
#pragma unroll
    for (int o = 1; o < 64; o <<= 1) v += __shfl_xor(v, o);
    return v;
}
__device__ __forceinline__ float wave_max(float v) {
#pragma unroll
    for (int o = 1; o < 64; o <<= 1) v = fmaxf(v, __shfl_xor(v, o));
    return v;
}
#define LDS_WAIT() asm volatile("s_waitcnt lgkmcnt(0)" ::: "memory")
#define VM_WAIT() asm volatile("s_waitcnt vmcnt(0)" ::: "memory")

#define XB_TMO      128
#define XB_XCNT(j)  (256  + 64 * (j))
#define XB_XSUB(j)  (1280 + 64 * (j))
#define XB_XGEN(j)  (2304 + 64 * (j))
#define XB_TOP      3328
#define XB_TOPGEN   3392
#define XCD_BAR_WORDS 3456
#define XB_SPIN_CAP (1u << 18)
__device__ __forceinline__ unsigned xb_ld(unsigned* p)              { return __hip_atomic_load(p, __ATOMIC_RELAXED, __HIP_MEMORY_SCOPE_AGENT); }
__device__ __forceinline__ unsigned xb_add(unsigned* p, unsigned v) { return __hip_atomic_fetch_add(p, v, __ATOMIC_RELAXED, __HIP_MEMORY_SCOPE_AGENT); }
__device__ __forceinline__ unsigned xb_xcc_id() { return (unsigned)__builtin_amdgcn_s_getreg((3 << 11) | 20) & 0xFu; }
#define XB_SPIN(cond, bar) do { unsigned _sp = 0; while (cond) { __builtin_amdgcn_s_sleep(1); \
    if ((++_sp & 255u) == 0u) { if (xb_ld(&(bar)[XB_TMO])) break; if (_sp > XB_SPIN_CAP) { atomicAdd(&(bar)[XB_TMO], 1u); break; } } } } while (0)
struct XcdBarrier { unsigned* bar; unsigned x; volatile LAS unsigned* st; };
__device__ __forceinline__ XcdBarrier xcd_barrier_post(unsigned* bar, volatile LAS unsigned* st) {
    XcdBarrier b; b.bar = bar; b.x = xb_xcc_id(); b.st = st;
    if (threadIdx.x == 0) (void)xb_add(&bar[XB_XCNT(b.x)], 1u);
    return b;
}
__device__ __forceinline__ void xcd_barrier_complete(unsigned* bar, unsigned x, unsigned& nloc, unsigned& nx) {
    const unsigned G = gridDim.x * gridDim.y * gridDim.z;
    unsigned sum, cnt, mine, sp = 0u;
    for (;;) {
        sum = 0u; cnt = 0u; mine = 0u;
#pragma unroll
        for (unsigned j = 0; j < 16; ++j) { const unsigned c = xb_ld(&bar[XB_XCNT(j)]); sum += c; cnt += (c > 0u) ? 1u : 0u; mine = (j == x) ? c : mine; }
        if (sum == G) break;
        __builtin_amdgcn_s_sleep(1);
        if ((++sp & 255u) == 0u) { if (xb_ld(&bar[XB_TMO])) break; if (sp > XB_SPIN_CAP) { atomicAdd(&bar[XB_TMO], 1u); break; } }
    }
    nloc = mine > 0u ? mine : 1u; nx = cnt > 0u ? cnt : 1u;
}
__device__ __forceinline__ void xcd_barrier(const XcdBarrier& b) {
    asm volatile("s_waitcnt vmcnt(0)" ::: "memory");
    __syncthreads();
    if (threadIdx.x == 0) {
        unsigned* bar = b.bar;
        __builtin_amdgcn_s_waitcnt(0);
        unsigned nloc = b.st[0], nx = b.st[1];
        if (nloc == 0u) { xcd_barrier_complete(bar, b.x, nloc, nx); b.st[0] = nloc; b.st[1] = nx; }
        const unsigned old = xb_add(&bar[XB_XSUB(b.x)], 1u);
        const unsigned gen = old / nloc;
        if (old + 1u == (gen + 1u) * nloc) {
            __builtin_amdgcn_fence(__ATOMIC_RELEASE, "agent");
            asm volatile("s_waitcnt vmcnt(0)" ::: "memory");
            const unsigned og = xb_add(&bar[XB_TOP], 1u);
            const unsigned tg = og / nx;
            if (og + 1u == (tg + 1u) * nx) xb_add(&bar[XB_TOPGEN], 1u);
            else XB_SPIN(xb_ld(&bar[XB_TOPGEN]) == tg, bar);
            __builtin_amdgcn_fence(__ATOMIC_ACQUIRE, "agent");
            xb_add(&bar[XB_XGEN(b.x)], 1u);
            asm volatile("s_waitcnt vmcnt(0)" ::: "memory");
        } else {
            XB_SPIN(xb_ld(&bar[XB_XGEN(b.x)]) == gen, bar);
            __builtin_amdgcn_fence(__ATOMIC_ACQUIRE, "agent");
            asm volatile("s_waitcnt vmcnt(0)" ::: "memory");
        }
    }
    __syncthreads();
}

struct Args { const float* in[N_IN]; float* out; unsigned char* ws; int ph_lo, ph_hi; };
static_assert(sizeof(Args) == N_IN * 8 + 8 + 8 + 8, "Args has no padding");
#define CAS __attribute__((address_space(4)))
typedef const float* cfp;
struct Frame {
    LAS unsigned char* lds;
    int tid, lane, wave, bid, G;
    const CAS cfp* in;
    float* out; unsigned char* ws;
    __device__ __forceinline__ void fresh() { int t = threadIdx.x, b = blockIdx.x, g = gridDim.x; asm volatile("" : "+v"(t), "+s"(b), "+s"(g)); tid = t; lane = t & 63; wave = __builtin_amdgcn_readfirstlane(t >> 6); bid = b; G = g; }
    template <class T> __device__ __forceinline__ T* wsp(size_t off) const { return (T*)(ws + off); }
    __device__ __forceinline__ const float* mods(int li, int r9) const { return (const float*)(ws + CTL_MODS_OFF) + (size_t)(li * 9 + r9) * 6144; }
};

using pg8::Unit; using pg8::cvt_pk_bf16;
template <int ACT  > struct EpiBf16S {
    static constexpr bool PERM = true;
    bf16* O; int ldc; float sc;
    __device__ __forceinline__ void operator()(const f32x4 (&acc)[2][2][4][2], const Unit& u, int wr, int wc, int fr, int fq) const {
        const int row0 = u.pm * 256 + wr * 64 + fr, col0 = u.pn * 256 + wc * 32 + 8 * fq;
        if (ACT == 0 && u.pn >= 6 && u.pn <= 8) {
#pragma unroll
            for (int ai = 0; ai < 2; ++ai)
#pragma unroll
                for (int m = 0; m < 4; ++m) { const int blk = u.pm * 256 + ai * 128 + wr * 64, i = m * 16 + fr;
#pragma unroll
                    for (int bj = 0; bj < 2; ++bj) { const int cb = bj * 128 + wc * 32 + 8 * fq;
                        bf16* tp = O + (size_t)(blk + (cb >> 2)) * ldc + u.pn * 256 + i; const f32x4 v0 = acc[ai][bj][m][0], v1 = acc[ai][bj][m][1];
#pragma unroll
                        for (int e = 0; e < 4; ++e) { tp[e * 64] = (bf16)f2bf(v0[e]); tp[ldc + e * 64] = (bf16)f2bf(v1[e]); } } }
            return; }
        if (ACT == 0 && u.pn >= 12) {
#pragma unroll
            for (int ai = 0; ai < 2; ++ai)
#pragma unroll
                for (int m = 0; m < 4; ++m) { const int blk = u.pm * 256 + ai * 128 + wr * 64, i = m * 16 + fr;
#pragma unroll
                    for (int bj = 0; bj < 2; ++bj) { const int cb = (u.pn - 12) * 256 + bj * 128 + wc * 32 + 8 * fq;
                        if (cb < 384) { const f32x4 v0 = acc[ai][bj][m][0], v1 = acc[ai][bj][m][1];
#pragma unroll
                            for (int e = 0; e < 8; ++e) { const int cv = cb + e, q6 = (cv * 10923) >> 16, r6 = cv - 6 * q6; O[(size_t)(blk + q6) * ldc + 3072 + r6 * 64 + i] = (bf16)f2bf(e < 4 ? v0[e & 3] : v1[e & 3]); } } } }
            return; }
#pragma unroll
        for (int ai = 0; ai < 2; ++ai)
#pragma unroll
            for (int m = 0; m < 4; ++m) { bf16* rowp = O + (size_t)(row0 + ai * 128 + m * 16) * ldc + col0;
#pragma unroll
                for (int bj = 0; bj < 2; ++bj) { f32x4 v0 = acc[ai][bj][m][0], v1 = acc[ai][bj][m][1];
                    if (ACT == 1) {
#pragma unroll
                        for (int j = 0; j < 4; ++j) { v0[j] = sigmoidf_(v0[j] * sc); v1[j] = sigmoidf_(v1[j] * sc); } }
                    v4u w; w.x = cvt_pk_bf16(v0[0], v0[1]); w.y = cvt_pk_bf16(v0[2], v0[3]); w.z = cvt_pk_bf16(v1[0], v1[1]); w.w = cvt_pk_bf16(v1[2], v1[3]);
                    *(v4u*)(rowp + bj * 128) = w; } }
    }
};
template <int MODE  > struct EpiMerge {
    static constexpr bool PERM = true;
    const bf16* Gt; int ldg; bf16* Mo;
    __device__ __forceinline__ void operator()(const f32x4 (&acc)[2][2][4][2], const Unit& u, int wr, int wc, int fr, int fq) const {
        const int row0 = u.pm * 256 + wr * 64 + fr, col0 = u.pn * 256 + wc * 32 + 8 * fq;
#pragma unroll
        for (int ai = 0; ai < 2; ++ai)
#pragma unroll
            for (int m = 0; m < 4; ++m) { const size_t r = (size_t)(row0 + ai * 128 + m * 16);
#pragma unroll
                for (int bj = 0; bj < 2; ++bj) { const int c = col0 + bj * 128;
                    const v4u gw = *(const v4u*)(Gt + r * ldg + c);
                    f32x4 v0 = acc[ai][bj][m][0], v1 = acc[ai][bj][m][1];
                    v0[0] *= bflo(gw.x); v0[1] *= bfhi(gw.x); v0[2] *= bflo(gw.y); v0[3] *= bfhi(gw.y);
                    v1[0] *= bflo(gw.z); v1[1] *= bfhi(gw.z); v1[2] *= bflo(gw.w); v1[3] *= bfhi(gw.w);
                    bf16* mp = Mo + r * D + c;
                    if (MODE == 1) { const v4u mw = *(const v4u*)mp;
                        v0[0] += bflo(mw.x); v0[1] += bfhi(mw.x); v0[2] += bflo(mw.y); v0[3] += bfhi(mw.y);
                        v1[0] += bflo(mw.z); v1[1] += bfhi(mw.z); v1[2] += bflo(mw.w); v1[3] += bfhi(mw.w); }
                    v4u w; w.x = cvt_pk_bf16(v0[0], v0[1]); w.y = cvt_pk_bf16(v0[2], v0[3]); w.z = cvt_pk_bf16(v1[0], v1[1]); w.w = cvt_pk_bf16(v1[2], v1[3]);
                    *(v4u*)mp = w; } }
    }
};
struct EpiRes {
    static constexpr bool PERM = false;
    const float* base_l; float* out_l; const float* base_c; float* out_c; const float* modl; int goff; float sc;
    __device__ __forceinline__ void operator()(const f32x4 (&acc)[2][2][4][2], const Unit& u, int wr, int wc, int fr, int fq) const {
        const bool isl = u.pm < 64; const int pml = isl ? u.pm : u.pm - 64; const int r9 = isl ? (u.pm >> 3) : 8;
        const float* base = isl ? base_l : base_c; float* out = isl ? out_l : out_c; const float* gate = modl + (size_t)r9 * 6144 + goff;
        const int row0 = pml * 256 + wr * 64 + fr, col0 = u.pn * 256 + wc * 32 + 4 * fq;
        f32x4 gv[2][2];
#pragma unroll
        for (int bj = 0; bj < 2; ++bj)
#pragma unroll
            for (int n = 0; n < 2; ++n) gv[bj][n] = *(const f32x4*)(gate + col0 + bj * 128 + n * 16);
#pragma unroll
        for (int ai = 0; ai < 2; ++ai)
#pragma unroll
            for (int m = 0; m < 4; ++m) { const size_t off = (size_t)(row0 + ai * 128 + m * 16) * D + col0;
#pragma unroll
                for (int bj = 0; bj < 2; ++bj)
#pragma unroll
                    for (int n = 0; n < 2; ++n) { const f32x4 bs = *(const f32x4*)(base + off + bj * 128 + n * 16);
                        *(f32x4*)(out + off + bj * 128 + n * 16) = bs + gv[bj][n] * acc[ai][bj][m][n] * sc; } }
    }
};
template <bool F8OUT = false> struct EpiSwiGLU {
    static constexpr bool PERM = true;
    bf16* H; int ldh; int ntl; float sc;
    __device__ __forceinline__ void operator()(const f32x4 (&acc)[2][2][4][2], const Unit& u, int wr, int wc, int fr, int fq) const {
        const int row0 = u.pm * 256 + wr * 64 + fr, col0 = (u.pn % ntl) * 128 + wc * 32 + 8 * fq;
#pragma unroll
        for (int ai = 0; ai < 2; ++ai)
#pragma unroll
            for (int m = 0; m < 4; ++m) { bf16* rowp = H + (size_t)(row0 + ai * 128 + m * 16) * ldh + col0;
                f32x4 h0, h1;
#pragma unroll
                for (int j = 0; j < 4; ++j) { h0[j] = siluf_(acc[ai][0][m][0][j] * sc) * (acc[ai][1][m][0][j] * sc); h1[j] = siluf_(acc[ai][0][m][1][j] * sc) * (acc[ai][1][m][1][j] * sc); }
                if constexpr (F8OUT) { const v2u w8 = {pk4_fp8(8.f * h0[0], 8.f * h0[1], 8.f * h0[2], 8.f * h0[3]), pk4_fp8(8.f * h1[0], 8.f * h1[1], 8.f * h1[2], 8.f * h1[3])};
                    *(v2u*)((unsigned char*)H + (size_t)(row0 + ai * 128 + m * 16) * ldh + col0) = w8; }
                else { v4u w; w.x = cvt_pk_bf16(h0[0], h0[1]); w.y = cvt_pk_bf16(h0[2], h0[3]); w.z = cvt_pk_bf16(h1[0], h1[1]); w.w = cvt_pk_bf16(h1[2], h1[3]);
                    *(v4u*)rowp = w; } }
    }
};
struct EpiMoeY {
    static constexpr bool PERM = true;
    bf16* O; float sc;
    __device__ __forceinline__ void operator()(const f32x4 (&acc)[2][2][4][2], const Unit& u, int wr, int wc, int fr, int fq) const {
        const int row0 = u.pm * 256 + wr * 64 + fr, col0 = (u.pn & 3) * 256 + wc * 32 + 8 * fq;
#pragma unroll
        for (int ai = 0; ai < 2; ++ai)
#pragma unroll
            for (int m = 0; m < 4; ++m) { bf16* rowp = O + (size_t)(row0 + ai * 128 + m * 16) * D + col0;
#pragma unroll
                for (int bj = 0; bj < 2; ++bj) { const f32x4 v0 = acc[ai][bj][m][0] * sc, v1 = acc[ai][bj][m][1] * sc;
                    v4u w; w.x = cvt_pk_bf16(v0[0], v0[1]); w.y = cvt_pk_bf16(v0[2], v0[3]); w.z = cvt_pk_bf16(v1[0], v1[1]); w.w = cvt_pk_bf16(v1[2], v1[3]);
                    *(v4u*)(rowp + bj * 128) = w; } }
    }
};

#if USE_NAIVE_GEMM
#define GEMM_CALL(EpiT, SchedT, lds, g, S, E) pg8::gemm_naive<EpiT, SchedT>(lds, g, S, E)
#else
#define GEMM_CALL(EpiT, SchedT, lds, g, S, E) pg8::gemm_phase<EpiT, SchedT, true, true>(lds, g, S, E)
#define GEMM_CALL_F8(EpiT, SchedT, lds, g, S, E) pg8::gemm_phase<EpiT, SchedT, true, true, true>(lds, g, S, E)
#endif

__device__ __forceinline__ void tr_item(const float* W, int ldw, int col0, int ncols, int K, bf16* WT, int mode, int row_off, LAS float* scr, int item, int lane) {
    const int nblk = ncols / 32, kb = item / nblk, nb = item % nblk, k0 = 64 * kb, n0 = 32 * nb;
    float tv[32];
#pragma unroll
    for (int i = 0; i < 32; ++i) { const int kk = 2 * i + (lane >> 5); tv[i] = __builtin_nontemporal_load(&W[(size_t)(k0 + kk) * ldw + col0 + n0 + (lane & 31)]); }
#pragma unroll
    for (int i = 0; i < 32; ++i) { const int kk = 2 * i + (lane >> 5); scr[kk * 33 + (lane & 31)] = tv[i]; }
    LDS_WAIT(); asm volatile("" ::: "memory");
    const int c = lane & 7;
#pragma unroll
    for (int j = 0; j < 4; ++j) { const int n = (lane >> 3) + 8 * j; const LAS float* s = scr + (8 * c) * 33 + n;
        const int nn = n0 + n; const int drow = (mode & 3) == 0 ? row_off + nn : row_off + (nn >> 7) * 256 + (nn & 127);
        if (mode & 4) { const v2u o8 = {pk4_fp8(32.f * s[0 * 33], 32.f * s[1 * 33], 32.f * s[2 * 33], 32.f * s[3 * 33]), pk4_fp8(32.f * s[4 * 33], 32.f * s[5 * 33], 32.f * s[6 * 33], 32.f * s[7 * 33])};
            *(v2u*)((unsigned char*)WT + (size_t)drow * K + k0 + 8 * c) = o8; }
        else { v4u o; o.x = pk2(s[0 * 33], s[1 * 33]); o.y = pk2(s[2 * 33], s[3 * 33]); o.z = pk2(s[4 * 33], s[5 * 33]); o.w = pk2(s[6 * 33], s[7 * 33]);
            *(v4u*)(WT + (size_t)drow * K + k0 + 8 * c) = o; } }
    LDS_WAIT(); asm volatile("" ::: "memory");
}
struct TrDesc { const float* W; int ldw, col0, ncols, K; bf16* WT; int mode, row_off; };
__device__ __forceinline__ void tr_desc_small(const Frame& F, int idx, TrDesc& d) {
    if (idx < 12) { const int li = idx / 6, k = idx % 6;
        if (k == 0) d = TrDesc{F.in[I_WIN] + (size_t)li * D * P_IN, P_IN, 0, 3456, D, F.wsp<bf16>(WS_WIN + li * SZ_WIN1), 0, 0};
        else if (k == 1) d = TrDesc{F.in[I_WIN] + (size_t)li * D * P_IN, P_IN, 3456, GATE_IN, D, F.wsp<bf16>(WS_WIN + li * SZ_WIN1 + (size_t)UA_W * D * 2), 4, 0};
        else if (k == 2) d = TrDesc{F.in[I_WBRRW] + (size_t)li * RW_W * D, D, 0, D, RW_W, F.wsp<bf16>(WS_WBR + li * SZ_WBR1), 0, 0};
        else if (k == 3) d = TrDesc{F.in[I_WBRHY] + (size_t)li * HY_W * D, D, 0, D, HY_W, F.wsp<bf16>(WS_WBR + li * SZ_WBR1 + (size_t)D * RW_W * 2), 0, 0};
        else if (k == 4) d = TrDesc{F.in[I_WBRNA] + (size_t)li * NA_W * D, D, 0, D, NA_W, F.wsp<bf16>(WS_WBR + li * SZ_WBR1 + (size_t)D * (RW_W + HY_W) * 2), 0, 0};
        else d = TrDesc{F.in[I_WOUT] + (size_t)li * D * D, D, 0, D, D, F.wsp<bf16>(WS_WOUT + li * SZ_WOUT1), 0, 0};
    } else if (idx == 12) d = TrDesc{F.in[I_FFW1], FF, 0, FF, D, F.wsp<bf16>(WS_WFF13), 1, 0};
    else if (idx == 13) d = TrDesc{F.in[I_FFW3], FF, 0, FF, D, F.wsp<bf16>(WS_WFF13), 1, 128};
    else d = TrDesc{F.in[I_FFW2], D, 0, D, FF, F.wsp<bf16>(WS_WFF2), 0, 0};
}
__device__ __forceinline__ void tr_load(const TrDesc& d, int item, int lane, float (&tv)[32]) {
    const int nblk = d.ncols / 32, kb = item / nblk, nb = item % nblk, k0 = 64 * kb, n0 = 32 * nb;
#pragma unroll
    for (int i = 0; i < 32; ++i) { const int kk = 2 * i + (lane >> 5); tv[i] = __builtin_nontemporal_load(&d.W[(size_t)(k0 + kk) * d.ldw + d.col0 + n0 + (lane & 31)]); }
}
__device__ __forceinline__ void tr_store(const TrDesc& d, int item, int lane, const float (&tv)[32], LAS float* scr) {
    const int nblk = d.ncols / 32, kb = item / nblk, nb = item % nblk, k0 = 64 * kb, n0 = 32 * nb;
#pragma unroll
    for (int i = 0; i < 32; ++i) { const int kk = 2 * i + (lane >> 5); scr[kk * 33 + (lane & 31)] = tv[i]; }
    LDS_WAIT(); asm volatile("" ::: "memory");
    const int c = lane & 7;
#pragma unroll
    for (int j = 0; j < 4; ++j) { const int n = (lane >> 3) + 8 * j; const LAS float* s = scr + (8 * c) * 33 + n;
        const int nn = n0 + n; const int drow = (d.mode & 3) == 0 ? d.row_off + nn : d.row_off + (nn >> 7) * 256 + (nn & 127);
        if (d.mode & 4) { const v2u o8 = {pk4_fp8(32.f * s[0 * 33], 32.f * s[1 * 33], 32.f * s[2 * 33], 32.f * s[3 * 33]), pk4_fp8(32.f * s[4 * 33], 32.f * s[5 * 33], 32.f * s[6 * 33], 32.f * s[7 * 33])};
            __builtin_nontemporal_store(o8, (v2u*)((unsigned char*)d.WT + (size_t)drow * d.K + k0 + 8 * c)); }
        else { v4u o; o.x = pk2(s[0 * 33], s[1 * 33]); o.y = pk2(s[2 * 33], s[3 * 33]); o.z = pk2(s[4 * 33], s[5 * 33]); o.w = pk2(s[6 * 33], s[7 * 33]);
            *(v4u*)(d.WT + (size_t)drow * d.K + k0 + 8 * c) = o; } }
    LDS_WAIT(); asm volatile("" ::: "memory");
}
__device__ __forceinline__ void moe_desc(const Frame& F, int mi, TrDesc& d) { const int e = mi / 3, w = mi % 3;
    if (w == 0) d = TrDesc{F.in[I_MOEW1] + (size_t)e * D * FFE, FFE, 0, FFE, D, F.wsp<bf16>(WS_W13F8), 1 | 4, e * 2 * FFE};
    else if (w == 1) d = TrDesc{F.in[I_MOEW3] + (size_t)e * D * FFE, FFE, 0, FFE, D, F.wsp<bf16>(WS_W13F8), 1 | 4, e * 2 * FFE + 128};
    else d = TrDesc{F.in[I_MOEW2] + (size_t)e * FFE * D, D, 0, D, FFE, F.wsp<bf16>(WS_W2F8), 0 | 4, e * D}; }
__device__ __forceinline__ void moe_weight_transposes(Frame& F, int which, int wg0, int nwg) {
    if (F.bid < wg0) return;
    const int gw = (F.bid - wg0) * NWAVES + F.wave, NGW = nwg * NWAVES;
    LAS float* scr = (LAS float*)(F.lds + F.wave * 16384);
    constexpr int MOE_ITEMS = 1792; const int NIT = (which ? 8 : 16) * MOE_ITEMS;
#define MOE_MI(it_) (which ? 3 * ((it_) / MOE_ITEMS) + 2 : 3 * (((it_) / MOE_ITEMS) >> 1) + (((it_) / MOE_ITEMS) & 1))
    int it = gw; if (it >= NIT) return;
    TrDesc dc; moe_desc(F, MOE_MI(it), dc); float tvc[32]; tr_load(dc, it % MOE_ITEMS, F.lane, tvc);
#pragma unroll 1
    for (;;) {
        const int itn = it + NGW; const bool hn = itn < NIT; TrDesc dn = dc; float tvn[32];
        if (hn) { moe_desc(F, MOE_MI(itn), dn); tr_load(dn, itn % MOE_ITEMS, F.lane, tvn); }
        tr_store(dc, it % MOE_ITEMS, F.lane, tvc, scr);
        if (!hn) break;
        dc = dn; it = itn;
#pragma unroll
        for (int i = 0; i < 32; ++i) tvc[i] = tvn[i];
    }
}
__device__ __forceinline__ void p0_prologue(Frame& F) {
    const int gw = F.bid * NWAVES + F.wave, NGW = F.G * NWAVES;
    for (int i = F.bid * NTHREADS + F.tid; i < 2 * 128 * D / 8; i += F.G * NTHREADS) { const int li = i / (128 * D / 8), r = i % (128 * D / 8);
        *(v4u*)(F.wsp<bf16>(WS_WIN + li * SZ_WIN1) + (size_t)3456 * D + (size_t)r * 8) = (v4u){0u, 0u, 0u, 0u}; }
    for (int i = F.bid * NTHREADS + F.tid; i < 2 * RWT_PER_LAYER; i += F.G * NTHREADS) { const int li = i / RWT_PER_LAYER, idx = i % RWT_PER_LAYER; float v;
        if (idx < 4 * 384 * 64) { const int m = idx / (384 * 64), rem = idx % (384 * 64), nn = rem >> 6, k = rem & 63;
            v = m < 2 ? F.in[I_RWW2][((size_t)(li * 2 + m) * 64 + k) * RW_W + nn] : F.in[I_RWA2][((size_t)(li * 2 + (m - 2)) * 64 + k) * RW_W + nn]; }
        else { const int rem = idx - 4 * 384 * 64, nn = rem >> 7, k = rem & 127; v = F.in[I_RWG2][((size_t)li * 128 + k) * RW_W + nn]; }
        F.wsp<bf16>(WS_MISC + MISC_RWT)[i] = (bf16)f2bf(v); }
    if (F.bid == 0) { for (int i = F.tid; i < 1024; i += NTHREADS) { const int pos = i >> 4, fi = i & 15; float sn, cs; sincosf((float)pos * powf(10000.0f, -(float)fi / 16.0f), &sn, &cs);
        float* rt = F.wsp<float>(WS_MISC + MISC_ROPE) + 2 * i; rt[0] = cs; rt[1] = sn; } }
    {
        LAS float* zs = (LAS float*)F.lds;
        LAS float* h1s = zs + 64 * 36;
        const int pl = F.tid >> 3, sub = F.tid & 7;
#pragma unroll 1
        for (int job = F.bid; job < 72; job += F.G) { const int li = job / 36, q = job % 36, seg = q >= 32 ? 1 : 0, p = (seg ? q - 32 : q) * 64 + pl, n = seg ? 256 : 2048;
            __syncthreads();
            if (sub == 0) zs[pl * 36] = (float)p / (float)(n - 1);
#pragma unroll
            for (int e = 0; e < 4; ++e) { const int i = 1 + sub * 4 + e, fi = (i - 1) & 15; const float f = 1e-4f + (float)fi * ((15.0f - 1e-4f) / 15.0f); const float ang = (6.283185307179586f / (float)n) * (float)p * f;
                zs[pl * 36 + i] = i <= 16 ? cosf(ang) : -sinf(ang); }
            __syncthreads();
            const float* w1 = F.in[I_HYW1] + li * 33 * 64 + sub * 8; const float* b1 = F.in[I_HYB1] + li * 64 + sub * 8; const float* fr = F.in[I_HYFREQ] + li * 64 + sub * 8;
            float a[8];
#pragma unroll
            for (int e = 0; e < 8; ++e) a[e] = b1[e];
#pragma unroll 3
            for (int i = 0; i < 33; ++i) { const float z = zs[pl * 36 + i]; const f32x4 wa = *(const f32x4*)(w1 + i * 64), wb = *(const f32x4*)(w1 + i * 64 + 4);
                a[0] += z * wa.x; a[1] += z * wa.y; a[2] += z * wa.z; a[3] += z * wa.w; a[4] += z * wb.x; a[5] += z * wb.y; a[6] += z * wb.z; a[7] += z * wb.w; }
#pragma unroll
            for (int e = 0; e < 8; ++e) h1s[pl * 68 + sub * 8 + e] = sinf(fr[e] * a[e]);
            __syncthreads();
            const float* w2 = F.in[I_HYW2] + li * 64 * 64 + sub * 8; const float* b2 = F.in[I_HYB2] + li * 64 + sub * 8;
#pragma unroll
            for (int e = 0; e < 8; ++e) a[e] = b2[e];
#pragma unroll 4
            for (int i = 0; i < 64; ++i) { const float z = h1s[pl * 68 + i]; const f32x4 wa = *(const f32x4*)(w2 + i * 64), wb = *(const f32x4*)(w2 + i * 64 + 4);
                a[0] += z * wa.x; a[1] += z * wa.y; a[2] += z * wa.z; a[3] += z * wa.w; a[4] += z * wb.x; a[5] += z * wb.y; a[6] += z * wb.z; a[7] += z * wb.w; }
            float* o = F.wsp<float>(WS_H2BUF) + ((size_t)(li * 2 + seg) * 2048 + p) * 64 + sub * 8;
            *(f32x4*)o = (f32x4){sinf(fr[0] * a[0]), sinf(fr[1] * a[1]), sinf(fr[2] * a[2]), sinf(fr[3] * a[3])}; *(f32x4*)(o + 4) = (f32x4){sinf(fr[4] * a[4]), sinf(fr[5] * a[5]), sinf(fr[6] * a[6]), sinf(fr[7] * a[7])};
        }
    }
    __syncthreads();
    if (F.bid < 2 * 96) {
        LAS float* act = (LAS float*)F.lds;
        LAS float* part = act + 9 * 1024;
        for (int i = F.tid; i < 9 * 1024; i += NTHREADS) { const int r = i >> 10, k = i & 1023; const float v = r < 8 ? F.in[I_C][r * D + k] : F.in[I_CCTX][k]; act[i] = siluf_(v); }
        __syncthreads();
#pragma unroll 1
        for (int job = F.bid; job < 2 * 96; job += F.G) { const int li = job / 96, cb = job % 96; const int c = F.tid & 63, kg = F.tid >> 6, col = cb * 64 + c;
            float a[9];
#pragma unroll
            for (int r = 0; r < 9; ++r) a[r] = 0.f;
            const float* wp = F.in[I_ADAW] + ((size_t)li * D + kg * 128) * 6144 + col;
#pragma unroll 1
            for (int k0 = 0; k0 < 128; k0 += 16) { float w[16];
#pragma unroll
                for (int u = 0; u < 16; ++u) w[u] = wp[(size_t)(k0 + u) * 6144];
#pragma unroll
                for (int u = 0; u < 16; ++u)
#pragma unroll
                    for (int r = 0; r < 9; ++r) a[r] += act[r * 1024 + kg * 128 + k0 + u] * w[u]; }
#pragma unroll
            for (int r = 0; r < 9; ++r) part[(kg * 9 + r) * 64 + c] = a[r];
            __syncthreads();
            for (int i = F.tid; i < 9 * 64; i += NTHREADS) { const int r = i >> 6, cc = i & 63; float s = F.in[I_ADAB][li * 6144 + cb * 64 + cc];
#pragma unroll
                for (int g = 0; g < 8; ++g) s += part[(g * 9 + r) * 64 + cc];
                ((float*)(F.ws + CTL_MODS_OFF))[(size_t)(li * 9 + r) * 6144 + cb * 64 + cc] = s; }
            __syncthreads();
        }
    }
    __syncthreads();
    {
        LAS float* scr = (LAS float*)(F.lds + F.wave * 16384);
        for (int mi = 0; mi < 15; ++mi) { TrDesc d; tr_desc_small(F, mi, d); const int items = (d.K / 64) * (d.ncols / 32);
            for (int it = gw; it < items; it += NGW) tr_item(d.W, d.ldw, d.col0, d.ncols, d.K, d.WT, d.mode, d.row_off, scr, it, F.lane); }
    }
}

__device__ __forceinline__ void norm_row(const float* xrow, const float* g, const float* shift, const float* scale, int lane, f32x4 (&v)[4]) {
    const f32x4* xr = (const f32x4*)xrow + lane; float s = 0.f;
#pragma unroll
    for (int j = 0; j < 4; ++j) { v[j] = xr[64 * j]; s += (v[j].x * v[j].x + v[j].y * v[j].y) + (v[j].z * v[j].z + v[j].w * v[j].w); }
    const float rs = 1.0f / sqrtf(wave_sum(s) * (1.f / D) + NORM_EPS);
#pragma unroll
    for (int j = 0; j < 4; ++j) { const f32x4 gg = ((const f32x4*)g)[lane + 64 * j], sh = ((const f32x4*)shift)[lane + 64 * j], sc = ((const f32x4*)scale)[lane + 64 * j];
        v[j] = (v[j] * rs * gg) * (sc + 1.0f) + sh; }
}
__device__ __forceinline__ void store_row_bf16(bf16* orow, int lane, const f32x4 (&v)[4]) {
    v2u* o8 = (v2u*)orow + lane;
#pragma unroll
    for (int j = 0; j < 4; ++j) { v2u w; w.x = pk2(v[j].x, v[j].y); w.y = pk2(v[j].z, v[j].w); o8[64 * j] = w; }
}
__device__ __forceinline__ void hy_filter_job(Frame& F, int layer, int seg, int o, int cg) {
    const int n = seg ? 256 : 2048;
    const float* w3 = F.in[I_HYW3] + (size_t)layer * 64 * 1024;
    const float* h2b = F.wsp<float>(WS_H2BUF) + (size_t)(layer * 2 + seg) * 2048 * 64;
    LAS float* raw = (LAS float*)F.lds;
    LAS float* red = raw + 2048 * 16;
    LAS float* wl = red + 64;
    const float mind = -3.0701134573253945f, maxd = -15.350567286626972f;
    float asum[8];
#pragma unroll
    for (int c = 0; c < 8; ++c) asum[c] = 0.f;
    __syncthreads();
    for (int i = F.tid; i < 1024; i += NTHREADS) { const int q = i >> 6, k = i & 63; wl[i] = w3[(size_t)k * 1024 + o * 512 + (q >> 3) * 256 + cg * 8 + (q & 7)]; }
    __syncthreads();
#pragma unroll 1
    for (int p = F.tid; p < n; p += NTHREADS) {
        f32x4 h[16];
#pragma unroll
        for (int i = 0; i < 16; ++i) h[i] = ((const f32x4*)(h2b + (size_t)p * 64))[i];
        const float tt = (float)p / (float)(n - 1);
#pragma unroll 1
        for (int q = 0; q < 16; ++q) { const int dir = q >> 3, c = q & 7, ch = cg * 8 + c, col = o * 512 + dir * 256 + ch; float a = 0.f;
            (void)col;
#pragma unroll
            for (int i = 0; i < 16; ++i) { const f32x4 w4 = *(const LAS f32x4*)(wl + q * 64 + 4 * i); a += h[i].x * w4.x; a += h[i].y * w4.y; a += h[i].z * w4.z; a += h[i].w * w4.w; }
            const float delta = fabsf(mind + (maxd - mind) * ((float)ch / 255.0f));
            a *= __expf(-tt * delta);
            raw[p * 16 + q] = a;
            const float aa = (dir == 0 || p >= 1) ? fabsf(a) : 0.f;
#pragma unroll
            for (int k = 0; k < 8; ++k) asum[k] += (k == c) ? aa : 0.f; }
    }
#pragma unroll
    for (int c = 0; c < 8; ++c) asum[c] = wave_sum(asum[c]);
    if (F.lane == 0) {
#pragma unroll
        for (int c = 0; c < 8; ++c) red[F.wave * 8 + c] = asum[c]; }
    __syncthreads();
    float inv[8];
#pragma unroll
    for (int c = 0; c < 8; ++c) { float l1 = 0.f;
#pragma unroll
        for (int w = 0; w < 8; ++w) l1 += red[w * 8 + c];
        inv[c] = 1.0f / l1; }
    bf16* dst = seg ? F.wsp<bf16>(WS_FILTC) + (size_t)(o * 256 + cg * 8) * 512 : F.wsp<bf16>(WS_FILT) + (size_t)((layer * 2 + o) * 256 + cg * 8) * 4096;
    const int stride = 2 * n;
#pragma unroll 1
    for (int i = F.tid; i < 8 * n; i += NTHREADS) { const int c = i / n, p = i - c * n; float ic = 0.f;
#pragma unroll
        for (int k = 0; k < 8; ++k) ic = (k == c) ? inv[k] : ic;
        dst[(size_t)c * stride + n + p] = (bf16)f2bf(raw[p * 16 + c] * ic);
        if (p >= 1) dst[(size_t)c * stride + n - p] = (bf16)f2bf(raw[p * 16 + 8 + c] * ic); }
    if (F.tid < 8) dst[(size_t)F.tid * stride] = 0;
}
#define A1F8_PTR(F_, li_) ((li_) == 0 ? (unsigned char*)(F_).out : (F_).ws + WS_WFF13)
static_assert((size_t)NL * D <= (size_t)2 * FF * D * 2 + (size_t)D * FF * 2, "fp8 A1 copy of the last layer fits in the dense FFN weight region");
__device__ __forceinline__ void p1_norm1(Frame& F, int li) {
    const int gw = F.bid * NWAVES + F.wave, NGW = F.G * NWAVES;
    bf16* A1 = F.wsp<bf16>(WS_RA);
    const float* xl = li == 0 ? F.in[I_X] : F.out; const float* xc = li == 0 ? F.in[I_CTX] : F.wsp<float>(WS_CTXRES);
    const float* g = F.in[I_N1G] + li * D;
    unsigned char* a1f8 = A1F8_PTR(F, li);
    for (int row = gw; row < MT; row += NGW) { const bool isl = row < NL; const int r9 = isl ? row >> 11 : 8;
        const float* xr = isl ? xl + (size_t)row * D : xc + (size_t)(row - NL) * D; const float* md = F.mods(li, r9);
        f32x4 v[4]; norm_row(xr, g, md + 0 * D, md + 1 * D, F.lane, v); store_row_bf16(A1 + (size_t)row * D, F.lane, v);
        if (li == 0 || isl) { unsigned* o4 = (unsigned*)(a1f8 + (size_t)row * D) + F.lane;
#pragma unroll
            for (int j = 0; j < 4; ++j) o4[64 * j] = pk4_fp8(v[j].x, v[j].y, v[j].z, v[j].w); } }
    if (li == 0) {
        __syncthreads();
        for (int job = F.bid; job < 192; job += F.G) {
            { const int seg = job >= 128 ? 1 : 0, j2 = job - 128 * seg; hy_filter_job(F, seg ? 0 : j2 >> 6, seg, (j2 >> 5) & 1, j2 & 31); }
            __syncthreads(); }
    }
}

__device__ __forceinline__ void rw_scan_chain(Frame& F, int li, int chain) {
    const int b = chain / 12, h = (chain % 12) >> 1, d = chain & 1, lane = F.lane;
    const bf16* FEAT = F.wsp<bf16>(WS_R1 + R1_FEAT); float* Y = F.wsp<float>(WS_RB);
    LAS float* bc = (LAS float*)(F.lds + F.wave * 2048);
    const float k_k = F.in[I_RWKK][li * RW_W + h * 64 + lane], k_a = F.in[I_RWKA][li * RW_W + h * 64 + lane];
    float S[64];
#pragma unroll
    for (int k = 0; k < 64; ++k) S[k] = 0.f;
    const int fe = 3 + d, fi = 5 + d;
    for (int seg = 0; seg < 2; ++seg) { const int n = seg ? SEQ : LC; const int base = seg ? b * SEQ : NL + b * LC;
        int t = d ? n - 1 : 0;
        const bf16* fp = FEAT + (size_t)(base + t) * NFEAT * RW_W + h * 64 + lane;
        bf16 nr = fp[0], nk = fp[RW_W], nv = fp[2 * RW_W], ne = fp[fe * RW_W], ni = fp[fi * RW_W];
        for (int step = 0; step < n; ++step) {
            const float r = bf2f(nr), k = bf2f(nk), v = bf2f(nv), e = bf2f(ne), ic = bf2f(ni);
            const int row = base + t;
            if (step + 1 < n) { t = d ? t - 1 : t + 1; fp = FEAT + (size_t)(base + t) * NFEAT * RW_W + h * 64 + lane; nr = fp[0]; nk = fp[RW_W]; nv = fp[2 * RW_W]; ne = fp[fe * RW_W]; ni = fp[fi * RW_W]; }
            float kkv = k * k_k; const float ss = wave_sum(kkv * kkv); kkv = kkv / fmaxf(sqrtf(ss), 1e-12f);
            bc[0 * 64 + lane] = __expf(-e); bc[1 * 64 + lane] = k * (1.0f + (ic - 1.0f) * k_a); bc[2 * 64 + lane] = -kkv; bc[3 * 64 + lane] = kkv * ic; bc[4 * 64 + lane] = r;
            LDS_WAIT(); asm volatile("" ::: "memory");
            float sa = 0.f;
#pragma unroll
            for (int k4 = 0; k4 < 16; ++k4) { const f32x4 a4 = ((const LAS f32x4*)(bc + 2 * 64))[k4]; sa += S[4 * k4] * a4.x + S[4 * k4 + 1] * a4.y + S[4 * k4 + 2] * a4.z + S[4 * k4 + 3] * a4.w; }
            float y = 0.f;
#pragma unroll
            for (int k4 = 0; k4 < 16; ++k4) { const f32x4 w4 = ((const LAS f32x4*)(bc + 0 * 64))[k4], kd4 = ((const LAS f32x4*)(bc + 1 * 64))[k4], b4 = ((const LAS f32x4*)(bc + 3 * 64))[k4], r4 = ((const LAS f32x4*)(bc + 4 * 64))[k4];
                S[4 * k4 + 0] = S[4 * k4 + 0] * w4.x + sa * b4.x + v * kd4.x; y += S[4 * k4 + 0] * r4.x;
                S[4 * k4 + 1] = S[4 * k4 + 1] * w4.y + sa * b4.y + v * kd4.y; y += S[4 * k4 + 1] * r4.y;
                S[4 * k4 + 2] = S[4 * k4 + 2] * w4.z + sa * b4.z + v * kd4.z; y += S[4 * k4 + 2] * r4.z;
                S[4 * k4 + 3] = S[4 * k4 + 3] * w4.w + sa * b4.w + v * kd4.w; y += S[4 * k4 + 3] * r4.w; }
            __hip_atomic_fetch_add(Y + (size_t)row * RW_W + h * 64 + lane, y, __ATOMIC_RELAXED, __HIP_MEMORY_SCOPE_AGENT);
            asm volatile("" ::: "memory");
        }
    }
}

__device__ __forceinline__ float hy_short(const bf16* U, const float* cw, float cb, int rowbase, int t, int n, int chcol) {
    const float u0 = t > 0 ? bf2f(U[(size_t)(rowbase + t - 1) * UA_W + UA_HY + chcol]) : 0.f;
    const float u1 = bf2f(U[(size_t)(rowbase + t) * UA_W + UA_HY + chcol]);
    const float u2 = t < n - 1 ? bf2f(U[(size_t)(rowbase + t + 1) * UA_W + UA_HY + chcol]) : 0.f;
    return cb + cw[0] * u0 + cw[HY_IN] * u1 + cw[2 * HY_IN] * u2;
}
__device__ __forceinline__ void hy_job(Frame& F, int li, int seg, int b, int cg) {
    const int n = seg ? LC : SEQ, rowbase = seg ? NL + b * LC : b * SEQ;
    bf16* U = F.wsp<bf16>(WS_R1);
    LAS bf16* zA = (LAS bf16*)F.lds; LAS bf16* zB = zA + 2048 * 8; LAS bf16* Fl = zB + 2048 * 8;
    const float* cw = F.in[I_HYCW] + (size_t)li * 3 * HY_IN; const float* cbv = F.in[I_HYCB] + (size_t)li * HY_IN;
    __syncthreads();
    for (int idx = F.tid; idx < n * 8; idx += NTHREADS) { const int t = idx >> 3, c = idx & 7, ch = cg * 8 + c;
        zA[idx] = (bf16)f2bf(hy_short(U, cw + ch, cbv[ch], rowbase, t, n, ch)); }
    LAS bf16* zin = zA; LAS bf16* zout = zB;
    for (int o = 0; o < 2; ++o) {
        const bf16* fsrc = seg ? F.wsp<bf16>(WS_FILTC) + (size_t)(o * 256 + cg * 8) * 512 : F.wsp<bf16>(WS_FILT) + (size_t)((li * 2 + o) * 256 + cg * 8) * 4096;
        __syncthreads();
        for (int idx = F.tid; idx < 8 * 2 * n / 8; idx += NTHREADS) ((LAS v4u*)Fl)[idx] = ((const v4u*)fsrc)[idx];
        __syncthreads();
        const int c = F.tid & 7, tq = F.tid >> 3, ch = cg * 8 + c;
        const LAS bf16* fl = Fl + c * 2 * n;
        const float skip = F.in[I_HYSKIP][(li * 2 + o) * HY_W + ch];
        const int xcol = (o + 1) * HY_W + ch;
        for (int blk = 0; blk < n / 512 + (n < 512 ? 1 : 0); ++blk) { const int t0 = (blk * 64 + tq) * 8;
            if (t0 < n) {
                float acc[8];
#pragma unroll
                for (int j = 0; j < 8; ++j) acc[j] = 0.f;
                for (int s8 = 0; s8 < n; s8 += 8) {
                    float fw[15], zz[8];
                    const int fb = t0 - s8 - 7 + n;
#pragma unroll
                    for (int i = 0; i < 15; ++i) fw[i] = bf2f(fl[fb + i]);
#pragma unroll
                    for (int q = 0; q < 8; ++q) zz[q] = bf2f(zin[(s8 + q) * 8 + c]);
#pragma unroll
                    for (int j = 0; j < 8; ++j)
#pragma unroll
                        for (int q = 0; q < 8; ++q) acc[j] += fw[j - q + 7] * zz[q];
                }
#pragma unroll
                for (int j = 0; j < 8; ++j) { const int t = t0 + j; const float xo = hy_short(U, cw + xcol, cbv[xcol], rowbase, t, n, xcol);
                    const float zo = bf2f(zin[t * 8 + c]); const float zn = xo * (acc[j] + skip * zo);
                    if (o == 0) zout[t * 8 + c] = (bf16)f2bf(zn); else U[(size_t)(rowbase + t) * UA_W + UA_HY + ch] = (bf16)f2bf(zn); }
            } }
        LAS bf16* tmp = zin; zin = zout; zout = tmp;
    }
    __syncthreads();
#undef HY_STAGE_RAW
#undef HY_CONV
}

__device__ __forceinline__ void na_job(Frame& F, int li, int kind, int b, int h, int blk) {
    bf16* U = F.wsp<bf16>(WS_R1);
    LAS float* qs = (LAS float*)F.lds; LAS float* ks = qs + 64 * 65; LAS float* Sc = ks + 64 * 65;
    constexpr int SP = 388;
    const int nloc = kind == 0 ? 128 : 0, ntot = nloc + 256, nch = kind == 0 ? 12 : 4;
    const int qrow0 = kind == 0 ? b * SEQ + blk * 64 : NL + b * LC + blk * 64;
    const int gi = blk, r0 = min(max(gi - 4, 0), 24);
    const int qi = F.tid >> 3, sub = F.tid & 7, d0 = sub * 8;
    const int c0 = min(max(qi - 8, 0), 48);
    const float* qg = F.in[I_NAQG] + li * 64; const float* kg = F.in[I_NAKG] + li * 64;
    const float* rpb = F.in[I_NARPB] + (size_t)(li * 6 + h) * 15 * 31;
    __syncthreads();
    { const v4u w = *(const v4u*)(U + (size_t)(qrow0 + qi) * UA_W + UA_NA + h * 64 + d0);
      float x[8] = {bflo(w.x), bfhi(w.x), bflo(w.y), bfhi(w.y), bflo(w.z), bfhi(w.z), bflo(w.w), bfhi(w.w)}; float ss = 0.f;
#pragma unroll
      for (int e = 0; e < 8; ++e) ss += x[e] * x[e];
      ss += __shfl_xor(ss, 1); ss += __shfl_xor(ss, 2); ss += __shfl_xor(ss, 4);
      const float sc = 0.125f / sqrtf(ss * (1.f / 64.f) + NORM_EPS);
#pragma unroll
      for (int e = 0; e < 8; ++e) qs[qi * 65 + d0 + e] = x[e] * sc * qg[d0 + e]; }
    for (int ch = 0; ch < nch; ++ch) {
        const bool loc = kind == 0 && ch < 8; const int cc = kind == 0 ? ch - 8 : ch;
        const int krow0 = loc ? b * SEQ + (r0 + ch) * 64 : NL + b * LC + cc * 64;
        __syncthreads();
        { const v4u w = *(const v4u*)(U + (size_t)(krow0 + qi) * UA_W + UA_NA + NA_W + h * 64 + d0);
          float x[8] = {bflo(w.x), bfhi(w.x), bflo(w.y), bfhi(w.y), bflo(w.z), bfhi(w.z), bflo(w.w), bfhi(w.w)}; float ss = 0.f;
#pragma unroll
          for (int e = 0; e < 8; ++e) ss += x[e] * x[e];
          ss += __shfl_xor(ss, 1); ss += __shfl_xor(ss, 2); ss += __shfl_xor(ss, 4);
          const float sc = 1.0f / sqrtf(ss * (1.f / 64.f) + NORM_EPS);
#pragma unroll
          for (int e = 0; e < 8; ++e) ks[qi * 65 + d0 + e] = x[e] * sc * kg[d0 + e]; }
        __syncthreads();
        if (loc) {
#pragma unroll 1
            for (int e = 0; e < 2; ++e) { const int kc = c0 + sub * 2 + e; float s = 0.f;
#pragma unroll 8
                for (int dd = 0; dd < 64; ++dd) s += qs[qi * 65 + dd] * ks[kc * 65 + dd];
                const int dr = (r0 + ch) - gi + 7, dc = min(max(kc - qi + 15, 0), 30);
                Sc[qi * SP + ch * 16 + sub * 2 + e] = s + rpb[dr * 31 + dc]; }
        } else {
#pragma unroll 1
            for (int e = 0; e < 8; ++e) { const int kj = sub * 8 + e; float s = 0.f;
#pragma unroll 8
                for (int dd = 0; dd < 64; ++dd) s += qs[qi * 65 + dd] * ks[kj * 65 + dd];
                Sc[qi * SP + nloc + cc * 64 + kj] = s; }
        }
    }
    __syncthreads();
    { float mx = -3.0e38f;
      for (int idx = sub; idx < ntot; idx += 8) mx = fmaxf(mx, Sc[qi * SP + idx]);
      mx = fmaxf(mx, __shfl_xor(mx, 1)); mx = fmaxf(mx, __shfl_xor(mx, 2)); mx = fmaxf(mx, __shfl_xor(mx, 4));
      float sm = 0.f;
      for (int idx = sub; idx < ntot; idx += 8) { const float p = __expf(Sc[qi * SP + idx] - mx); Sc[qi * SP + idx] = p; sm += p; }
      sm += __shfl_xor(sm, 1); sm += __shfl_xor(sm, 2); sm += __shfl_xor(sm, 4);
      const float inv = 1.0f / sm;
      for (int idx = sub; idx < ntot; idx += 8) Sc[qi * SP + idx] *= inv; }
    float acc[8];
#pragma unroll
    for (int e = 0; e < 8; ++e) acc[e] = 0.f;
    for (int ch = 0; ch < nch; ++ch) {
        const bool loc = kind == 0 && ch < 8; const int cc = kind == 0 ? ch - 8 : ch;
        const int krow0 = loc ? b * SEQ + (r0 + ch) * 64 : NL + b * LC + cc * 64;
        __syncthreads();
        { const v4u w = *(const v4u*)(U + (size_t)(krow0 + qi) * UA_W + UA_NA + 2 * NA_W + h * 64 + d0);
          ks[qi * 65 + d0 + 0] = bflo(w.x); ks[qi * 65 + d0 + 1] = bfhi(w.x); ks[qi * 65 + d0 + 2] = bflo(w.y); ks[qi * 65 + d0 + 3] = bfhi(w.y);
          ks[qi * 65 + d0 + 4] = bflo(w.z); ks[qi * 65 + d0 + 5] = bfhi(w.z); ks[qi * 65 + d0 + 6] = bflo(w.w); ks[qi * 65 + d0 + 7] = bfhi(w.w); }
        __syncthreads();
        if (loc) {
#pragma unroll 4
            for (int e = 0; e < 16; ++e) { const float p = Sc[qi * SP + ch * 16 + e]; const int kc = c0 + e;
#pragma unroll
                for (int dd = 0; dd < 8; ++dd) acc[dd] += p * ks[kc * 65 + d0 + dd]; } }
        else {
#pragma unroll 4
            for (int kj = 0; kj < 64; ++kj) { const float p = Sc[qi * SP + nloc + cc * 64 + kj];
#pragma unroll
                for (int dd = 0; dd < 8; ++dd) acc[dd] += p * ks[kj * 65 + d0 + dd]; } }
    }
    v4u w; w.x = pk2(acc[0], acc[1]); w.y = pk2(acc[2], acc[3]); w.z = pk2(acc[4], acc[5]); w.w = pk2(acc[6], acc[7]);
    *(v4u*)(U + (size_t)(qrow0 + qi) * UA_W + UA_NA + h * 64 + d0) = w;
    __syncthreads();
}
__device__ __forceinline__ void p5_rw_readout(Frame& F, int li, int row_lo, int row_hi) {
    const int gw = F.wave, NGW = NWAVES, lane = F.lane;
    const bf16* FEAT = F.wsp<bf16>(WS_R1 + R1_FEAT); const bf16* Y = F.wsp<bf16>(WS_RB); bf16* U = F.wsp<bf16>(WS_R1);
    const int nrows = row_hi;
    if (lane >= 48) return;
    const int j0 = 8 * lane;
    float gg[8], gb[8], ka[8], rk[8];
#pragma unroll
    for (int e = 0; e < 8; ++e) { gg[e] = F.in[I_RWGNG][li * RW_W + j0 + e]; gb[e] = F.in[I_RWGNB][li * RW_W + j0 + e]; ka[e] = F.in[I_RWKA][li * RW_W + j0 + e]; rk[e] = F.in[I_RWRK][li * RW_W + j0 + e]; }
#pragma unroll 1
    for (int row0 = row_lo + gw; row0 < nrows; row0 += 2 * NGW) {
        v4u wy0[2], wy1[2], wr[2], wk[2], wv[2], wi0[2], wi1[2], wg[2];
#pragma unroll
        for (int u = 0; u < 2; ++u) { const int row = min(row0 + u * NGW, nrows - 1);
            wy0[u] = *(const v4u*)(Y + (size_t)row * RW_W + j0); wy1[u] = *(const v4u*)(Y + ((size_t)MT + row) * RW_W + j0);
            const bf16* fp = FEAT + (size_t)row * NFEAT * RW_W + j0;
            wr[u] = *(const v4u*)fp; wk[u] = *(const v4u*)(fp + RW_W); wv[u] = *(const v4u*)(fp + 2 * RW_W); wi0[u] = *(const v4u*)(fp + 5 * RW_W); wi1[u] = *(const v4u*)(fp + 6 * RW_W); wg[u] = *(const v4u*)(fp + 7 * RW_W); }
#pragma unroll
        for (int u = 0; u < 2; ++u) { const int row = row0 + u * NGW;
            float y0[8], y1[8], r[8], k[8], v[8], i0[8], i1[8], g[8];
            unpack8(wy0[u], y0); unpack8(wy1[u], y1); unpack8(wr[u], r); unpack8(wk[u], k); unpack8(wv[u], v); unpack8(wi0[u], i0); unpack8(wi1[u], i1); unpack8(wg[u], g);
            float sm = 0.f;
#pragma unroll
            for (int e = 0; e < 8; ++e) { y0[e] += y1[e]; sm += y0[e]; }
            sm += __shfl_xor(sm, 1); sm += __shfl_xor(sm, 2); sm += __shfl_xor(sm, 4);
            const float mu = sm * (1.f / 64.f); float sq = 0.f, bs = 0.f;
#pragma unroll
            for (int e = 0; e < 8; ++e) { y0[e] -= mu; sq += y0[e] * y0[e]; bs += r[e] * (k[e] * (2.0f + (i0[e] + i1[e] - 2.0f) * ka[e])) * rk[e]; }
            sq += __shfl_xor(sq, 1); sq += __shfl_xor(sq, 2); sq += __shfl_xor(sq, 4);
            bs += __shfl_xor(bs, 1); bs += __shfl_xor(bs, 2); bs += __shfl_xor(bs, 4);
            const float rs = 1.0f / sqrtf(sq * (1.f / 64.f) + RW_GN_EPS);
            float o[8];
#pragma unroll
            for (int e = 0; e < 8; ++e) o[e] = (y0[e] * rs * gg[e] + gb[e] + bs * v[e]) * g[e];
            if (row < nrows) *(v4u*)(U + (size_t)row * UA_W + j0) = pack8(o); }
    }
}

__device__ __forceinline__ void p8_norm2(Frame& F, int li, int dry) {
    const int gw = F.bid * NWAVES + F.wave, NGW = F.G * NWAVES, lane = F.lane;
    const float* g = F.in[I_N2G] + li * D;
    if (li == 0) {
        bf16* H2 = F.wsp<bf16>(WS_RA);
        for (int row = gw; row < MT; row += NGW) { const bool isl = row < NL; const int r9 = isl ? row >> 11 : 8;
            const float* xr = isl ? F.out + (size_t)row * D : F.wsp<float>(WS_CTXRES) + (size_t)(row - NL) * D; const float* md = F.mods(li, r9);
            f32x4 v[4]; norm_row(xr, g, md + 3 * D, md + 4 * D, lane, v); store_row_bf16(H2 + (size_t)row * D, lane, v); }
    } else {
        bf16* H2 = F.wsp<bf16>(WS_R1 + R1_H2U);
        int* rowtok = (int*)(F.ws + WS_MISC + MISC_ROWTOK);
        if (!dry) for (int i = F.bid * NTHREADS + F.tid; i < MOE_ROWS; i += F.G * NTHREADS) rowtok[i] = -1;
        unsigned* cnt = (unsigned*)(F.ws + WS_CTL) + CW_MOECNT;
        const float* router = F.in[I_MOER];
        int* sel = (int*)(F.ws + WS_MISC + MISC_SEL);
        for (int row = gw; row < NL; row += NGW) { const float* md = F.mods(li, row >> 11);
            f32x4 v[4]; norm_row(F.out + (size_t)row * D, g, md + 3 * D, md + 4 * D, lane, v);
            { unsigned* o4 = (unsigned*)((unsigned char*)H2 + (size_t)row * D) + lane;
#pragma unroll
              for (int j = 0; j < 4; ++j) o4[64 * j] = pk4_fp8(v[j].x, v[j].y, v[j].z, v[j].w); }
            float lg[8];
#pragma unroll
            for (int e = 0; e < 8; ++e) lg[e] = 0.f;
#pragma unroll
            for (int j = 0; j < 4; ++j) { const int k0 = 4 * lane + 256 * j;
#pragma unroll
                for (int q = 0; q < 4; ++q) { const f32x4 ra = ((const f32x4*)(router + (size_t)(k0 + q) * 8))[0], rb = ((const f32x4*)(router + (size_t)(k0 + q) * 8))[1]; const float x = v[j][q];
                    lg[0] += x * ra.x; lg[1] += x * ra.y; lg[2] += x * ra.z; lg[3] += x * ra.w; lg[4] += x * rb.x; lg[5] += x * rb.y; lg[6] += x * rb.z; lg[7] += x * rb.w; } }
#pragma unroll
            for (int e = 0; e < 8; ++e) lg[e] = wave_sum(lg[e]);
            int ea = 0; float la = lg[0];
#pragma unroll
            for (int e = 1; e < 8; ++e) if (lg[e] > la) { la = lg[e]; ea = e; }
            int eb = -1; float lb = -3.0e38f;
#pragma unroll
            for (int e = 0; e < 8; ++e) if (e != ea && lg[e] > lb) { lb = lg[e]; eb = e; }
            const float wa = 1.0f / (1.0f + __expf(lb - la)), wb = 1.0f - wa;
            if (lane == 0) { const unsigned inc = dry ? 0u : 1u; const unsigned ra = __hip_atomic_fetch_add(cnt + 64 * ea, inc, __ATOMIC_RELAXED, __HIP_MEMORY_SCOPE_AGENT), rb = __hip_atomic_fetch_add(cnt + 64 * eb, inc, __ATOMIC_RELAXED, __HIP_MEMORY_SCOPE_AGENT);
                if (!dry) {
                int* s = sel + (size_t)row * 8; s[0] = ea; s[1] = (int)ra; s[2] = __float_as_int(wa); s[3] = eb; s[4] = (int)rb; s[5] = __float_as_int(wb); } }
        }
    }
}
__device__ __forceinline__ void p8b_gather(Frame& F) {
    const int gw = F.bid * NWAVES + F.wave, NGW = F.G * NWAVES, lane = F.lane;
    const unsigned* cnt = (const unsigned*)(F.ws + WS_CTL) + CW_MOECNT;
    int off[8]; { int t = 0;
#pragma unroll
        for (int e = 0; e < 8; ++e) { off[e] = t * 256; t += (int)((__builtin_amdgcn_readfirstlane(cnt[64 * e]) + 255u) >> 8); } }
    const bf16* H2 = F.wsp<bf16>(WS_R1 + R1_H2U); bf16* AS = F.wsp<bf16>(WS_RA);
    int* rowtok = (int*)(F.ws + WS_MISC + MISC_ROWTOK); float* rowwgt = (float*)(F.ws + WS_MISC + MISC_ROWWGT);
    const int* sel = (const int*)(F.ws + WS_MISC + MISC_SEL);
    for (int row = gw; row < NL; row += NGW) { const int* s = sel + (size_t)row * 8;
        const int ea = s[0], ra = s[1], eb = s[3], rb = s[4];
        int oa = 0, ob = 0;
#pragma unroll
        for (int e = 0; e < 8; ++e) { oa = (e == ea) ? off[e] : oa; ob = (e == eb) ? off[e] : ob; }
        const int pa = oa + ra, pb = ob + rb;
        const v4u* src = (const v4u*)((const unsigned char*)H2 + (size_t)row * D); v4u* da = (v4u*)((unsigned char*)AS + (size_t)pa * D); v4u* db = (v4u*)((unsigned char*)AS + (size_t)pb * D);
        { const v4u w = src[lane]; da[lane] = w; db[lane] = w; }
        if (lane == 0) { rowtok[pa] = row; rowwgt[pa] = __int_as_float(s[2]); rowtok[pb] = row; rowwgt[pb] = __int_as_float(s[5]); }
    }
}

__device__ __forceinline__ void p11_moe_combine(Frame& F, int li, int dry) {
    const int gw = F.bid * NWAVES + F.wave, NGW = F.G * NWAVES, lane = F.lane;
    const unsigned* cnt = (const unsigned*)(F.ws + WS_CTL) + CW_MOECNT;
    int off[8]; { int t = 0;
#pragma unroll
        for (int e = 0; e < 8; ++e) { off[e] = t * 256; t += (int)((__builtin_amdgcn_readfirstlane(cnt[64 * e]) + 255u) >> 8); } }
    const bf16* YP = F.wsp<bf16>(WS_RA); const int* sel = (const int*)(F.ws + WS_MISC + MISC_SEL);
    for (int row = gw; row < NL; row += NGW) { const int* s = sel + (size_t)row * 8;
        const int ea = s[0], ra = s[1], eb = s[3], rb = s[4]; const float wa = dry ? 0.f : __int_as_float(s[2]), wb = dry ? 0.f : __int_as_float(s[5]);
        int oa = 0, ob = 0;
#pragma unroll
        for (int e = 0; e < 8; ++e) { oa = (e == ea) ? off[e] : oa; ob = (e == eb) ? off[e] : ob; }
        const v2u* ya = (const v2u*)(YP + (size_t)(oa + ra) * D) + lane; const v2u* yb = (const v2u*)(YP + (size_t)(ob + rb) * D) + lane;
        const float* gate = F.mods(li, row >> 11) + 5 * D; f32x4* op = (f32x4*)(F.out + (size_t)row * D) + lane;
#pragma unroll
        for (int j = 0; j < 4; ++j) { const v2u a = ya[64 * j], b = yb[64 * j]; const f32x4 g = ((const f32x4*)gate)[lane + 64 * j]; f32x4 x = op[64 * j];
            x.x += g.x * (wa * bflo(a.x) + wb * bflo(b.x)); x.y += g.y * (wa * bfhi(a.x) + wb * bfhi(b.x));
            x.z += g.z * (wa * bflo(a.y) + wb * bflo(b.y)); x.w += g.w * (wa * bfhi(a.y) + wb * bfhi(b.y));
            op[64 * j] = x; }
    }
}

constexpr int NCHUNK = 36, NCHAIN = 96;
constexpr size_t SCR_GH = WS_WM13;
constexpr size_t SZ_GHSLOT = 2 * 64 * 64 * 2;
constexpr size_t SCR_AW = SCR_GH + (size_t)NCHAIN * NCHUNK * SZ_GHSLOT;
constexpr size_t SZ_AWSLOT = 128 * 64 * 2;
static_assert(WS_W13F8 == SCR_AW + (size_t)NCHAIN * NCHUNK * SZ_AWSLOT, "fp8 w13 copies start right behind the RWKV scratch");
static_assert(WS_W13F8 + (size_t)NE * 2 * FFE * D <= WS_CTXRES, "RWKV scratch + fp8 w13 copies fit in the MoE weight region");
static_assert((size_t)MT * GATE_IN * 2 <= WS_W13F8 - WS_WM13, "gate buffer stays below the fp8 w13 copies");
constexpr int LDK = 72;
constexpr int LDF = 68;
constexpr int MATB = 64 * LDK * 2, MATF = 64 * LDF * 4;
typedef short bf16x8_t __attribute__((ext_vector_type(8)));

__device__ __forceinline__ int rw_row(int b, int d, int p) {
    if (p < LC) { const int t = d ? LC - 1 - p : p; return NL + b * LC + t; }
    const int q = p - LC, t = d ? SEQ - 1 - q : q; return b * SEQ + t;
}
__device__ __forceinline__ f32x4 rw_mma(const LAS bf16* A, const LAS bf16* Bt, int lane, f32x4 acc) {
    const int r = lane & 15, q = lane >> 4;
#pragma unroll
    for (int ks = 0; ks < 2; ++ks) { const bf16x8_t a = *(const LAS bf16x8_t*)(A + r * LDK + ks * 32 + q * 8); const bf16x8_t b = *(const LAS bf16x8_t*)(Bt + r * LDK + ks * 32 + q * 8);
        acc = __builtin_amdgcn_mfma_f32_16x16x32_bf16(a, b, acc, 0, 0, 0); }
    return acc;
}

template <int PH>
__device__ __forceinline__ void rw_stage(Frame& F, int li, int b, int h, int d, int c, LAS unsigned char* L, LAS float* ecum,
                                         LAS bf16* m0, LAS bf16* m1, LAS bf16* m2, LAS bf16* t0, LAS bf16* t1, LAS bf16* vt, LAS float* xa, LAS float* gC) {
    const int t = F.tid >> 3, d0 = (F.tid & 7) * 8;
    const int row = rw_row(b, d, c * 64 + t);
    const bf16* fp = F.wsp<bf16>(WS_R1 + R1_FEAT) + (size_t)row * NFEAT * RW_W + h * 64 + d0;
    float r[8], k[8], v[8], e[8], ic[8], kk[8];
    unpack8(*(const v4u*)(fp), r); unpack8(*(const v4u*)(fp + RW_W), k); unpack8(*(const v4u*)(fp + 2 * RW_W), v); unpack8(*(const v4u*)(fp + (3 + d) * RW_W), e); unpack8(*(const v4u*)(fp + (5 + d) * RW_W), ic);
    const float* kkp = F.in[I_RWKK] + li * RW_W + h * 64 + d0; const float* kap = F.in[I_RWKA] + li * RW_W + h * 64 + d0;
    float ss = 0.f;
#pragma unroll
    for (int j = 0; j < 8; ++j) { kk[j] = k[j] * kkp[j]; ss += kk[j] * kk[j]; }
    ss += __shfl_xor(ss, 1); ss += __shfl_xor(ss, 2); ss += __shfl_xor(ss, 4);
    const float inv = 1.0f / fmaxf(sqrtf(ss), 1e-12f);
    float cs[8];
#pragma unroll
    for (int j = 0; j < 8; ++j) { kk[j] *= inv; cs[j] = e[j]; }
#pragma unroll
    for (int off = 8; off < 64; off <<= 1) {
#pragma unroll
        for (int j = 0; j < 8; ++j) { const float u = __shfl_up(cs[j], off); if ((F.tid & 63) >= off) cs[j] += u; } }
    if (((F.tid & 63) >> 3) == 7) {
#pragma unroll
        for (int j = 0; j < 8; ++j) ecum[(F.tid >> 6) * 64 + d0 + j] = cs[j]; }
    __syncthreads();
#pragma unroll
    for (int wq = 0; wq < 7; ++wq) { if (wq < (F.tid >> 6)) { const f32x4 o0 = *(const LAS f32x4*)(ecum + wq * 64 + d0), o1 = *(const LAS f32x4*)(ecum + wq * 64 + d0 + 4);
        cs[0] += o0.x; cs[1] += o0.y; cs[2] += o0.z; cs[3] += o0.w; cs[4] += o1.x; cs[5] += o1.y; cs[6] += o1.z; cs[7] += o1.w; } }
    float at[8], bt[8], kt[8], rt[8];
#pragma unroll
    for (int j = 0; j < 8; ++j) { const float cv = cs[j]; const float g = __expf(-cv), gi = __expf(cv), gp = __expf(e[j] - cv);
        at[j] = -kk[j] * gp; bt[j] = kk[j] * ic[j] * gi; kt[j] = k[j] * (1.0f + (ic[j] - 1.0f) * kap[j]) * gi; rt[j] = r[j] * g;
        if (PH == 0 && t == 63) gC[d0 + j] = g; }
    if (PH == 0) {
        *(LAS v4u*)(m0 + t * LDK + d0) = pack8(at); *(LAS v4u*)(m1 + t * LDK + d0) = pack8(bt); *(LAS v4u*)(m2 + t * LDK + d0) = pack8(kt);
#pragma unroll
        for (int j = 0; j < 8; ++j) { t0[(d0 + j) * LDK + t] = (bf16)f2bf(bt[j]); t1[(d0 + j) * LDK + t] = (bf16)f2bf(kt[j]); vt[(d0 + j) * LDK + t] = (bf16)f2bf(v[j]); xa[(d0 + j) * LDF + t] = at[j]; }
    } else {
        *(LAS v4u*)(m0 + t * LDK + d0) = pack8(bt); *(LAS v4u*)(m1 + t * LDK + d0) = pack8(kt); *(LAS v4u*)(m2 + t * LDK + d0) = pack8(rt);
#pragma unroll
        for (int j = 0; j < 8; ++j) vt[(d0 + j) * LDK + t] = (bf16)f2bf(v[j]);
    }
}

__device__ __forceinline__ void rw_phaseA_job(Frame& F, int li, int chain, int c) {
    const int b = chain / 12, h = (chain % 12) >> 1, d = chain & 1, lane = F.lane, w = F.wave;
    LAS unsigned char* L = F.lds;
    LAS bf16* At = (LAS bf16*)(L + 0 * MATB); LAS bf16* Bt = (LAS bf16*)(L + 1 * MATB); LAS bf16* Kt = (LAS bf16*)(L + 2 * MATB);
    LAS bf16* BtT = (LAS bf16*)(L + 3 * MATB); LAS bf16* KtT = (LAS bf16*)(L + 4 * MATB); LAS bf16* VT = (LAS bf16*)(L + 5 * MATB); LAS bf16* NakT = (LAS bf16*)(L + 6 * MATB);
    LAS bf16* AW = (LAS bf16*)(L + 7 * MATB);
    LAS float* Nab = (LAS float*)(L + 9 * MATB);
    LAS float* X = (LAS float*)(L + 9 * MATB + MATF);
    LAS float* gC = (LAS float*)(L + 9 * MATB + 3 * MATF);
    LAS float* MinvB = gC + 64;
    LAS bf16* NabT = At;
    __syncthreads();
    rw_stage<0>(F, li, b, h, d, c, L, Nab, At, Bt, Kt, BtT, KtT, VT, X, gC);
    __syncthreads();
    const int tr = w >> 1, tcb = (w & 1) * 2, q = lane >> 4, rr = lane & 15;
    f32x4 nab[2], nak[2];
#pragma unroll
    for (int i = 0; i < 2; ++i) { const f32x4 z = {0.f, 0.f, 0.f, 0.f}; nab[i] = rw_mma(Bt + tr * 16 * LDK, At + (tcb + i) * 16 * LDK, lane, z); nak[i] = rw_mma(Kt + tr * 16 * LDK, At + (tcb + i) * 16 * LDK, lane, z); }
    __syncthreads();
#pragma unroll
    for (int i = 0; i < 2; ++i)
#pragma unroll
        for (int g = 0; g < 4; ++g) { const int s = tr * 16 + q * 4 + g, t = (tcb + i) * 16 + rr; const bool keep = s < t;
            Nab[s * LDF + t] = keep ? nab[i][g] : 0.f; NakT[t * LDK + s] = (bf16)f2bf(keep ? nak[i][g] : 0.f); NabT[t * LDK + s] = (bf16)f2bf(keep ? nab[i][g] : 0.f); }
    __syncthreads();
#pragma unroll
    for (int i = 0; i < 2; ++i) { const f32x4 z = {0.f, 0.f, 0.f, 0.f}; const f32x4 o = rw_mma(VT + tr * 16 * LDK, NakT + (tcb + i) * 16 * LDK, lane, z);
#pragma unroll
        for (int g = 0; g < 4; ++g) X[(64 + tr * 16 + q * 4 + g) * LDF + (tcb + i) * 16 + rr] = o[g]; }
    if (F.tid < 64) { const int blk = F.tid >> 4, i = F.tid & 15; float m[16];
#pragma unroll
        for (int t = 0; t < 16; ++t) { float a = (t == i) ? 1.f : 0.f;
#pragma unroll
            for (int s = 0; s < 16; ++s) if (s < t) a += m[s] * Nab[(16 * blk + s) * LDF + 16 * blk + t];
            m[t] = a; }
#pragma unroll
        for (int t = 0; t < 16; ++t) MinvB[(blk * 16 + i) * 16 + t] = m[t]; }
    __syncthreads();
    { typedef short bf16x4_t __attribute__((ext_vector_type(4)));
      const int row = 16 * w + rr; bf16* gslot = (bf16*)(F.ws + SCR_AW + (size_t)(chain * NCHUNK + c) * SZ_AWSLOT);
#pragma unroll
      for (int jb = 0; jb < 4; ++jb) {
          f32x4 t4 = *(const LAS f32x4*)(X + row * LDF + 16 * jb + 4 * q);
#pragma unroll
          for (int j = 0; j < jb; ++j) { const v2u na = *(const LAS v2u*)(NabT + (16 * jb + rr) * LDK + 16 * j + 4 * q), xb = *(const LAS v2u*)(AW + row * LDK + 16 * j + 4 * q);
              t4 = __builtin_amdgcn_mfma_f32_16x16x16bf16_1k(__builtin_bit_cast(bf16x4_t, na), __builtin_bit_cast(bf16x4_t, xb), t4, 0, 0, 0); }
          const v2u tb = {pk2(t4[0], t4[1]), pk2(t4[2], t4[3])};
          const LAS float* mp = MinvB + (jb * 16 + 4 * q) * 16 + rr;
          const v2u ma = {pk2(mp[0], mp[16]), pk2(mp[32], mp[48])};
          const f32x4 z0 = {0.f, 0.f, 0.f, 0.f};
          const f32x4 z = __builtin_amdgcn_mfma_f32_16x16x16bf16_1k(__builtin_bit_cast(bf16x4_t, ma), __builtin_bit_cast(bf16x4_t, tb), z0, 0, 0, 0);
          const v2u pw = {pk2(z[0], z[1]), pk2(z[2], z[3])};
          *(LAS v2u*)(AW + row * LDK + 16 * jb + 4 * q) = pw; *(v2u*)(gslot + row * 64 + 16 * jb + 4 * q) = pw;
      } }
    __syncthreads();
    { bf16* gh = (bf16*)(F.ws + SCR_GH + (size_t)(chain * NCHUNK + c) * SZ_GHSLOT);
#pragma unroll
      for (int i = 0; i < 2; ++i) { const f32x4 z = {0.f, 0.f, 0.f, 0.f};
          const f32x4 gg = rw_mma(AW + tr * 16 * LDK, BtT + (tcb + i) * 16 * LDK, lane, z);
          f32x4 hh = rw_mma(AW + (64 + tr * 16) * LDK, BtT + (tcb + i) * 16 * LDK, lane, z); hh = rw_mma(VT + tr * 16 * LDK, KtT + (tcb + i) * 16 * LDK, lane, hh);
          const int kc = (tcb + i) * 16 + rr; const float gk = gC[kc];
          float gv[4], hv[4];
#pragma unroll
          for (int g = 0; g < 4; ++g) { const int j = tr * 16 + q * 4 + g; gv[g] = gg[g] * gk + (j == kc ? gk : 0.f); hv[g] = hh[g] * gk; }
          *(v2u*)(gh + kc * 64 + tr * 16 + q * 4) = (v2u){pk2(gv[0], gv[1]), pk2(gv[2], gv[3])}; *(v2u*)(gh + 4096 + kc * 64 + tr * 16 + q * 4) = (v2u){pk2(hv[0], hv[1]), pk2(hv[2], hv[3])}; } }
}

__device__ __forceinline__ void rw_phaseB_chain(Frame& F, int chain, int dry) {
    LAS bf16* Sl = (LAS bf16*)F.lds;
    const int lane = F.lane, w = F.wave, r = lane & 15, q = lane >> 4, vt = w >> 1, kt0 = 2 * (w & 1);
    const int sv = F.tid >> 3, sk0 = (F.tid & 7) * 8;
    const unsigned char* base = F.ws + SCR_GH + (size_t)chain * NCHUNK * SZ_GHSLOT;
    f32x4 st[2] = {{0.f, 0.f, 0.f, 0.f}, {0.f, 0.f, 0.f, 0.f}};
    v4u bq[2][2][2]; v2u hq[2][2];
#pragma unroll
    for (int p = 0; p < 2; ++p) { const bf16* gh = (const bf16*)(base + (size_t)p * SZ_GHSLOT);
#pragma unroll
        for (int i = 0; i < 2; ++i) { const int kc = 16 * (kt0 + i) + r;
            bq[p][i][0] = *(const v4u*)(gh + kc * 64 + 8 * q); bq[p][i][1] = *(const v4u*)(gh + kc * 64 + 32 + 8 * q); hq[p][i] = *(const v2u*)(gh + 4096 + kc * 64 + 16 * vt + 4 * q); } }
    __syncthreads();
#pragma unroll 1
    for (int c2 = 0; c2 < NCHUNK; c2 += 2) {
#pragma unroll
        for (int p = 0; p < 2; ++p) { const int c = c2 + p; LAS bf16* Sb = Sl + p * 64 * LDK;
#pragma unroll
            for (int i = 0; i < 2; ++i)
#pragma unroll
                for (int e = 0; e < 4; ++e) Sb[(16 * vt + 4 * q + e) * LDK + 16 * (kt0 + i) + r] = (bf16)f2bf(st[i][e]);
            __syncthreads();
            const bf16x8_t a0 = *(const LAS bf16x8_t*)(Sb + (16 * vt + r) * LDK + 8 * q), a1 = *(const LAS bf16x8_t*)(Sb + (16 * vt + r) * LDK + 32 + 8 * q);
            if (c >= 1 && !dry) *(v4u*)((bf16*)(base + (size_t)(c - 1) * SZ_GHSLOT) + sv * 64 + sk0) = *(const LAS v4u*)(Sb + sv * LDK + sk0);
#pragma unroll
            for (int i = 0; i < 2; ++i) { f32x4 acc = {bflo(hq[p][i].x), bfhi(hq[p][i].x), bflo(hq[p][i].y), bfhi(hq[p][i].y)};
                acc = __builtin_amdgcn_mfma_f32_16x16x32_bf16(a0, __builtin_bit_cast(bf16x8_t, bq[p][i][0]), acc, 0, 0, 0);
                acc = __builtin_amdgcn_mfma_f32_16x16x32_bf16(a1, __builtin_bit_cast(bf16x8_t, bq[p][i][1]), acc, 0, 0, 0);
                st[i] = acc; }
            if (c + 2 < NCHUNK) { const bf16* gh = (const bf16*)(base + (size_t)(c + 2) * SZ_GHSLOT);
#pragma unroll
                for (int i = 0; i < 2; ++i) { const int kc = 16 * (kt0 + i) + r;
                    bq[p][i][0] = *(const v4u*)(gh + kc * 64 + 8 * q); bq[p][i][1] = *(const v4u*)(gh + kc * 64 + 32 + 8 * q); hq[p][i] = *(const v2u*)(gh + 4096 + kc * 64 + 16 * vt + 4 * q); } }
        }
    }
    __syncthreads();
}

__device__ __forceinline__ void rw_phaseC_job(Frame& F, int li, int chain, int c, int dry) {
    const int b = chain / 12, h = (chain % 12) >> 1, d = chain & 1, lane = F.lane, w = F.wave;
    LAS unsigned char* L = F.lds;
    LAS bf16* Bt = (LAS bf16*)(L + 0 * MATB); LAS bf16* Kt = (LAS bf16*)(L + 1 * MATB); LAS bf16* Rt = (LAS bf16*)(L + 2 * MATB); LAS bf16* VT = (LAS bf16*)(L + 3 * MATB);
    LAS bf16* NrbT = (LAS bf16*)(L + 4 * MATB); LAS bf16* NrkT = (LAS bf16*)(L + 5 * MATB); LAS bf16* QT = (LAS bf16*)(L + 6 * MATB); LAS bf16* AW = (LAS bf16*)(L + 7 * MATB);
    LAS float* ecum = (LAS float*)(L + 9 * MATB); LAS bf16* Sb = (LAS bf16*)(L + 9 * MATB + MATF); LAS float* Yt = (LAS float*)(L + 10 * MATB + MATF);
    __syncthreads();
    rw_stage<1>(F, li, b, h, d, c, L, ecum, Bt, Kt, Rt, nullptr, nullptr, VT, nullptr, nullptr);
    { const bf16* gslot = (const bf16*)(F.ws + SCR_AW + (size_t)(chain * NCHUNK + c) * SZ_AWSLOT);
      const int row = F.tid >> 2, c0 = (F.tid & 3) * 16;
      *(LAS v4u*)(AW + row * LDK + c0) = *(const v4u*)(gslot + row * 64 + c0); *(LAS v4u*)(AW + row * LDK + c0 + 8) = *(const v4u*)(gslot + row * 64 + c0 + 8);
      const bf16* sg = (const bf16*)(F.ws + SCR_GH + (size_t)(chain * NCHUNK + (c > 0 ? c - 1 : 0)) * SZ_GHSLOT);
      const int v = F.tid >> 3, k0 = (F.tid & 7) * 8; v4u sw = *(const v4u*)(sg + v * 64 + k0); if (c == 0) sw = (v4u){0u, 0u, 0u, 0u}; *(LAS v4u*)(Sb + v * LDK + k0) = sw; }
    __syncthreads();
    const int tr = w >> 1, tcb = (w & 1) * 2, q = lane >> 4, rr = lane & 15;
#pragma unroll
    for (int i = 0; i < 2; ++i) { const f32x4 z = {0.f, 0.f, 0.f, 0.f}; const f32x4 nb = rw_mma(Bt + tr * 16 * LDK, Rt + (tcb + i) * 16 * LDK, lane, z), nk = rw_mma(Kt + tr * 16 * LDK, Rt + (tcb + i) * 16 * LDK, lane, z);
#pragma unroll
        for (int g = 0; g < 4; ++g) { const int s = tr * 16 + q * 4 + g, t = (tcb + i) * 16 + rr; const bool keep = s <= t;
            NrbT[t * LDK + s] = (bf16)f2bf(keep ? nb[g] : 0.f); NrkT[t * LDK + s] = (bf16)f2bf(keep ? nk[g] : 0.f); } }
    __syncthreads();
#pragma unroll
    for (int i = 0; i < 2; ++i) { const f32x4 z = {0.f, 0.f, 0.f, 0.f}; const f32x4 o = rw_mma(AW + tr * 16 * LDK, NrbT + (tcb + i) * 16 * LDK, lane, z);
#pragma unroll
        for (int g = 0; g < 4; ++g) { const int k = tr * 16 + q * 4 + g, t = (tcb + i) * 16 + rr; QT[t * LDK + k] = (bf16)f2bf(o[g] + bf2f(Rt[t * LDK + k])); } }
    __syncthreads();
#pragma unroll
    for (int i = 0; i < 2; ++i) { f32x4 o = {0.f, 0.f, 0.f, 0.f};
        o = rw_mma(Sb + tr * 16 * LDK, QT + (tcb + i) * 16 * LDK, lane, o); o = rw_mma(AW + (64 + tr * 16) * LDK, NrbT + (tcb + i) * 16 * LDK, lane, o); o = rw_mma(VT + tr * 16 * LDK, NrkT + (tcb + i) * 16 * LDK, lane, o);
#pragma unroll
        for (int g = 0; g < 4; ++g) Yt[((tcb + i) * 16 + rr) * LDF + tr * 16 + q * 4 + g] = o[g]; }
    __syncthreads();
    { const int t = F.tid >> 3, d0 = (F.tid & 7) * 8; const int row = rw_row(b, d, c * 64 + t); bf16* yp = F.wsp<bf16>(WS_RB) + ((size_t)d * MT + row) * RW_W + h * 64 + d0;
      float x[8];
#pragma unroll
      for (int j = 0; j < 8; ++j) x[j] = Yt[t * LDF + d0 + j];
      *(v4u*)yp = pack8(x); (void)dry; }
}


constexpr int P3_AS = 392;
constexpr int P3_WAVE_LDS = 16 * P3_AS * 2;
constexpr int P3_ROWS = 72;
__device__ __forceinline__ void p3_job(Frame& F, int li, int job) {
    const int lane = F.lane, r = lane & 15, g = lane >> 4;
    const int row0 = job * P3_ROWS;
    const bf16* U = F.wsp<bf16>(WS_R1); bf16* FEAT = F.wsp<bf16>(WS_R1 + R1_FEAT);
    LAS bf16* Ain = (LAS bf16*)F.lds;
    const float* mu0 = F.in[I_RWSHIFT] + (size_t)li * 2 * RW_IN; const float* mu1 = mu0 + RW_IN;
    const float* rope = F.wsp<float>(WS_MISC + MISC_ROPE);
    __syncthreads();
    for (int i = F.tid; i < 8 * P3_AS / 8; i += NTHREADS) *(LAS v4u*)(Ain + 72 * P3_AS + 8 * i) = (v4u){0u, 0u, 0u, 0u};
#pragma unroll 1
    for (int it = 0; it < 3; ++it) {
        const int idx = F.tid + NTHREADS * it, slot = idx % 192, run = idx / 192;
        int c1, c2, kindv;
        int fsel = 0, ocol1 = 0, half = 0, p = 0;
        if (slot < 96) { const int tensor = slot / 48, hd = (slot % 48) >> 3, sub = slot & 7; half = sub >> 2; p = (sub & 3) * 4; c1 = tensor * RW_W + hd * 64 + half * 32 + p; c2 = c1 + 16; kindv = 0; fsel = tensor; ocol1 = hd * 64 + half * 32 + p; }
        else if (slot < 144) { c1 = 2 * RW_W + (slot - 96) * 8; c2 = c1 + 4; kindv = 1; fsel = 2; ocol1 = (slot - 96) * 8; }
        else { c1 = 3 * RW_W + (slot - 144) * 8; c2 = c1 + 4; kindv = 2; ocol1 = (slot - 144) * 8; }
        float m0a[4], m0b[4], m1a[4], m1b[4];
#pragma unroll
        for (int e = 0; e < 4; ++e) { m0a[e] = mu0[c1 + e]; m0b[e] = mu0[c2 + e]; m1a[e] = mu1[c1 + e]; m1b[e] = mu1[c2 + e]; }
        v2u ra[11], rb[11];
#pragma unroll
        for (int i = 0; i < 11; ++i) { const int rw = min(max(row0 + 9 * run - 1 + i, 0), MT - 1); const bf16* up = U + (size_t)rw * UA_W; ra[i] = *(const v2u*)(up + c1); rb[i] = *(const v2u*)(up + c2); }
#pragma unroll
        for (int t9 = 0; t9 < 9; ++t9) { const int tt = 9 * run + t9, row = row0 + tt;
            const bool isl = row < NL; const int t = isl ? (row & (SEQ - 1)) : ((row - NL) & (LC - 1)); const int n = isl ? SEQ : LC;
            const bool hp = t > 0, hn = t < n - 1;
            float xa[4], xb[4];
            { const v2u pa = ra[t9], ca = ra[t9 + 1], na = ra[t9 + 2], pb2 = rb[t9], cb = rb[t9 + 1], nb = rb[t9 + 2];
              const float pav[4] = {bflo(pa.x), bfhi(pa.x), bflo(pa.y), bfhi(pa.y)}, cav[4] = {bflo(ca.x), bfhi(ca.x), bflo(ca.y), bfhi(ca.y)}, nav[4] = {bflo(na.x), bfhi(na.x), bflo(na.y), bfhi(na.y)};
              const float pbv[4] = {bflo(pb2.x), bfhi(pb2.x), bflo(pb2.y), bfhi(pb2.y)}, cbv[4] = {bflo(cb.x), bfhi(cb.x), bflo(cb.y), bfhi(cb.y)}, nbv[4] = {bflo(nb.x), bfhi(nb.x), bflo(nb.y), bfhi(nb.y)};
#pragma unroll
              for (int e = 0; e < 4; ++e) { const float pva = hp ? pav[e] : 0.f, nva = hn ? nav[e] : 0.f, pvb = hp ? pbv[e] : 0.f, nvb = hn ? nbv[e] : 0.f;
                  xa[e] = cav[e] + m0a[e] * (pva - cav[e]) + m1a[e] * (nva - cav[e]); xb[e] = cbv[e] + m0b[e] * (pvb - cbv[e]) + m1b[e] * (nvb - cbv[e]); } }
            if (kindv == 0) {
                float o1[4], o2[4];
                if (isl) { const int pos = half == 0 ? (t >> 6) : (t & 63); const float* rp = rope + (pos * 16 + p) * 2;
#pragma unroll
                    for (int e = 0; e < 4; ++e) { const float cs = rp[2 * e], sn = rp[2 * e + 1]; o1[e] = xa[e] * cs - xb[e] * sn; o2[e] = xa[e] * sn + xb[e] * cs; } }
                else {
#pragma unroll
                    for (int e = 0; e < 4; ++e) { o1[e] = xa[e]; o2[e] = xb[e]; } }
                bf16* fo = FEAT + ((size_t)row * NFEAT + fsel) * RW_W + ocol1;
                *(v2u*)fo = (v2u){pk2(o1[0], o1[1]), pk2(o1[2], o1[3])}; *(v2u*)(fo + 16) = (v2u){pk2(o2[0], o2[1]), pk2(o2[2], o2[3])};
            } else if (kindv == 1) {
                bf16* fo = FEAT + ((size_t)row * NFEAT + 2) * RW_W + ocol1;
                *(v4u*)fo = (v4u){pk2(xa[0], xa[1]), pk2(xa[2], xa[3]), pk2(xb[0], xb[1]), pk2(xb[2], xb[3])};
            } else {
                const int lc = ocol1;
#pragma unroll
                for (int e = 0; e < 4; ++e) { if (lc < 128) { xa[e] = tanhf(xa[e]); xb[e] = tanhf(xb[e]); } else if (lc >= 256) { xa[e] = sigmoidf_(xa[e]); xb[e] = sigmoidf_(xb[e]); } }
                *(LAS v4u*)(Ain + tt * P3_AS + lc) = (v4u){pk2(xa[0], xa[1]), pk2(xa[2], xa[3]), pk2(xb[0], xb[1]), pk2(xb[2], xb[3])};
            }
        }
    }
    __syncthreads();
    const bf16* RWT = F.wsp<bf16>(WS_MISC + MISC_RWT) + (size_t)li * RWT_PER_LAYER;
#pragma unroll 1
    for (int q3 = 0; q3 < 3; ++q3) { const int nt = 3 * F.wave + q3, nc = nt * 16 + r;
        v4u wc[12];
#pragma unroll
        for (int pr = 0; pr < 4; ++pr) { const bf16* wt = RWT + (size_t)pr * 384 * 64 + (size_t)nc * 64 + 8 * g; wc[2 * pr] = *(const v4u*)wt; wc[2 * pr + 1] = *(const v4u*)(wt + 32); }
        { const bf16* wt = RWT + RWT_G2 + (size_t)nc * 128 + 8 * g;
#pragma unroll
          for (int ks = 0; ks < 4; ++ks) wc[8 + ks] = *(const v4u*)(wt + 32 * ks); }
        const int nc0 = nt * 16 + 4 * g;
        const f32x4 w00 = *(const f32x4*)(F.in[I_RWW0] + (li * 2 + 0) * RW_W + nc0), w01 = *(const f32x4*)(F.in[I_RWW0] + (li * 2 + 1) * RW_W + nc0);
        const f32x4 a00 = *(const f32x4*)(F.in[I_RWA0] + (li * 2 + 0) * RW_W + nc0), a01 = *(const f32x4*)(F.in[I_RWA0] + (li * 2 + 1) * RW_W + nc0);
#pragma unroll 1
        for (int mt = 0; mt < 5; ++mt) {
            f32x4 acc[5];
#pragma unroll
            for (int pr = 0; pr < 5; ++pr) acc[pr] = (f32x4){0.f, 0.f, 0.f, 0.f};
            const LAS bf16* ap = Ain + (mt * 16 + r) * P3_AS + 8 * g;
#pragma unroll
            for (int pr = 0; pr < 4; ++pr)
#pragma unroll
                for (int ks = 0; ks < 2; ++ks) acc[pr] = __builtin_amdgcn_mfma_f32_16x16x32_bf16(__builtin_bit_cast(bf16x8_t, wc[2 * pr + ks]), *(const LAS bf16x8_t*)(ap + 32 * (2 * pr + ks)), acc[pr], 0, 0, 0);
#pragma unroll
            for (int ks = 0; ks < 4; ++ks) acc[4] = __builtin_amdgcn_mfma_f32_16x16x32_bf16(__builtin_bit_cast(bf16x8_t, wc[8 + ks]), *(const LAS bf16x8_t*)(ap + 32 * (8 + ks)), acc[4], 0, 0, 0);
            const int tt = mt * 16 + r;
            if (tt < P3_ROWS) { bf16* fo = FEAT + (size_t)(row0 + tt) * NFEAT * RW_W + nc0; float o[4];
#pragma unroll
                for (int e = 0; e < 4; ++e) o[e] = 0.6065306597126334f * sigmoidf_(acc[0][e] + w00[e]);
                *(v2u*)(fo + 3 * RW_W) = (v2u){pk2(o[0], o[1]), pk2(o[2], o[3])};
#pragma unroll
                for (int e = 0; e < 4; ++e) o[e] = 0.6065306597126334f * sigmoidf_(acc[1][e] + w01[e]);
                *(v2u*)(fo + 4 * RW_W) = (v2u){pk2(o[0], o[1]), pk2(o[2], o[3])};
#pragma unroll
                for (int e = 0; e < 4; ++e) o[e] = sigmoidf_(acc[2][e] + a00[e]);
                *(v2u*)(fo + 5 * RW_W) = (v2u){pk2(o[0], o[1]), pk2(o[2], o[3])};
#pragma unroll
                for (int e = 0; e < 4; ++e) o[e] = sigmoidf_(acc[3][e] + a01[e]);
                *(v2u*)(fo + 6 * RW_W) = (v2u){pk2(o[0], o[1]), pk2(o[2], o[3])};
                *(v2u*)(fo + 7 * RW_W) = (v2u){pk2(acc[4][0], acc[4][1]), pk2(acc[4][2], acc[4][3])}; }
        }
    }
}
__device__ __forceinline__ void p3_rw_features(Frame& F, int li) {
#pragma unroll 1
    for (int job = F.bid; job < MT / P3_ROWS; job += F.G) p3_job(F, li, job);
    __syncthreads();
}

typedef float f32x16 __attribute__((ext_vector_type(16)));
constexpr int HY_ZS = 72;
__device__ __forceinline__ void hy_job_mfma(Frame& F, int li, int seg, int c, int dry) {
    const int n = seg ? LC : SEQ, nI = n >> 6, lane = F.lane, b = F.wave, zb = nI * HY_ZS + 8;
    bf16* U = F.wsp<bf16>(WS_R1);
    LAS unsigned char* L = F.lds;
    const int cstride = 2 * n + 16;
    LAS bf16* frev8 = (LAS bf16*)L;
    constexpr int FREV_BYTES = 8 * (2 * SEQ + 16) * 2;
    constexpr int Z_BYTES = 8 * (32 * HY_ZS + 8) * 2;
    LAS bf16* zin = (LAS bf16*)(L + FREV_BYTES); LAS bf16* zout = (LAS bf16*)(L + FREV_BYTES + Z_BYTES);
    LAS bf16* xg = (LAS bf16*)L;
    static_assert(FREV_BYTES + 2 * Z_BYTES <= LDS_CTL_OFF, "hyena LDS map");
    const float* cw = F.in[I_HYCW] + (size_t)li * 3 * HY_IN; const float* cbv = F.in[I_HYCB] + (size_t)li * HY_IN;
    __syncthreads();
#define HY_STAGE_RAW(dst_, col_, tid_) do { const int s_ = (col_) >> 8, c_ = (col_) & 255; _Pragma("unroll 1") for (int v0_ = (tid_); v0_ < 8 * nI * 8; v0_ += 4 * NTHREADS) { v4u rv_[4]; \
        _Pragma("unroll") for (int k_ = 0; k_ < 4; ++k_) { const int vec_ = v0_ + k_ * NTHREADS; rv_[k_] = (v4u){0u, 0u, 0u, 0u}; if (vec_ < 8 * nI * 8) { const int bb_ = vec_ / (nI * 8), I_ = (vec_ >> 3) % nI, p_ = vec_ & 7; \
            rv_[k_] = *(const v4u*)(U + (size_t)((seg ? NL + bb_ * LC : bb_ * SEQ) + 64 * I_ + (c_ >> 2)) * UA_W + UA_HY + s_ * 256 + (c_ & 3) * 64 + 8 * p_); } } \
        _Pragma("unroll") for (int k_ = 0; k_ < 4; ++k_) { const int vec_ = v0_ + k_ * NTHREADS; if (vec_ < 8 * nI * 8) { const int bb_ = vec_ / (nI * 8), I_ = (vec_ >> 3) % nI, p_ = vec_ & 7; *(LAS v4u*)((dst_) + (bb_ * zb + I_ * HY_ZS) + 8 * p_) = rv_[k_]; } } } } while (0)
#define HY_CONV(raw_, bb_, t_, col_) (cbv[col_] + cw[col_] * ((t_) > 0 ? bf2f((raw_)[((bb_) * zb + (((t_) - 1) >> 6) * HY_ZS) + (((t_) - 1) & 63)]) : 0.f) \
        + cw[HY_IN + (col_)] * bf2f((raw_)[((bb_) * zb + ((t_) >> 6) * HY_ZS) + ((t_) & 63)]) + cw[2 * HY_IN + (col_)] * ((t_) < n - 1 ? bf2f((raw_)[((bb_) * zb + (((t_) + 1) >> 6) * HY_ZS) + (((t_) + 1) & 63)]) : 0.f))
    HY_STAGE_RAW(zout, c, F.tid);
    __syncthreads();
#pragma unroll 1
    for (int idx = F.tid; idx < 8 * n; idx += NTHREADS) { const int bb = idx / n, t = idx - bb * n;
        zin[bb * zb + (t >> 6) * HY_ZS + (t & 63)] = (bf16)f2bf(HY_CONV(zout, bb, t, c)); }
#pragma unroll 1
    for (int o = 0; o < 2; ++o) {
        const bf16* fsrc = seg ? F.wsp<bf16>(WS_FILTC) + (size_t)(o * 256 + c) * 512 : F.wsp<bf16>(WS_FILT) + (size_t)((li * 2 + o) * 256 + c) * 4096;
        __syncthreads();
        int tid_o = F.tid; asm volatile("" : "+v"(tid_o));
#pragma unroll 1
        for (int m = tid_o; m < 2 * n / 8; m += NTHREADS) { float x[8];
#pragma unroll
            for (int e = 0; e < 8; ++e) { const int y = 8 * m + e; x[e] = y == 0 ? 0.f : bf2f(fsrc[2 * n - y]); }
            *(LAS v4u*)(frev8 + 8 * m) = pack8(x); }
        __syncthreads();
        if (b >= 1) { const int rho = b, q = rho >> 1; const bool odd = rho & 1; LAS bf16* dst = frev8 + rho * cstride;
#pragma unroll 1
            for (int m = (tid_o & 63); m < 2 * n / 8; m += 64) { const v4u lo = *(const LAS v4u*)(frev8 + 8 * m); v4u hi = {0u, 0u, 0u, 0u}; if (m + 1 < 2 * n / 8) hi = *(const LAS v4u*)(frev8 + 8 * m + 8);
                unsigned a0, a1, a2, a3, a4;
                if (q == 0) { a0 = lo.x; a1 = lo.y; a2 = lo.z; a3 = lo.w; a4 = hi.x; } else if (q == 1) { a0 = lo.y; a1 = lo.z; a2 = lo.w; a3 = hi.x; a4 = hi.y; }
                else if (q == 2) { a0 = lo.z; a1 = lo.w; a2 = hi.x; a3 = hi.y; a4 = hi.z; } else { a0 = lo.w; a1 = hi.x; a2 = hi.y; a3 = hi.z; a4 = hi.w; }
                v4u ov; if (odd) { ov.x = (a0 >> 16) | (a1 << 16); ov.y = (a1 >> 16) | (a2 << 16); ov.z = (a2 >> 16) | (a3 << 16); ov.w = (a3 >> 16) | (a4 << 16); } else { ov.x = a0; ov.y = a1; ov.z = a2; ov.w = a3; }
                *(LAS v4u*)(dst + 8 * m) = ov; } }
        __syncthreads();
        f32x16 acc0, acc1;
#pragma unroll
        for (int r = 0; r < 16; ++r) { acc0[r] = 0.f; acc1[r] = 0.f; }
        { const int ir = tid_o & 31, hh = (tid_o >> 5) & 1, bc = ir & 7, I = 4 * b + (ir >> 3);
          const int Dlo = max(4 * b - (nI - 1), -(nI - 1)), Dhi = 4 * b < nI ? min(4 * b + 3, nI - 1) : -nI;
#pragma unroll 1
          for (int Dd = Dlo; Dd <= Dhi; ++Dd) { const int J = I - Dd; const bool valid = (I < nI) && (J >= 0) && (J < nI);
              const LAS bf16* zrow = zin + bc * zb + (valid ? J : 0) * HY_ZS + 8 * hh;
              const int ybase = n - 64 * Dd - ir + 8 * hh;
#pragma unroll
              for (int ks = 0; ks < 4; ++ks) {
                  v4u bw = *(const LAS v4u*)(zrow + 16 * ks); if (!valid) bw = (v4u){0u, 0u, 0u, 0u};
                  const int y0 = ybase + 16 * ks, y1 = y0 - 32;
                  const v4u aw0 = *(const LAS v4u*)(frev8 + (y0 & 7) * cstride + (y0 & ~7)); const v4u aw1 = *(const LAS v4u*)(frev8 + (y1 & 7) * cstride + (y1 & ~7));
                  acc0 = __builtin_amdgcn_mfma_f32_32x32x16_bf16(__builtin_bit_cast(bf16x8_t, aw0), __builtin_bit_cast(bf16x8_t, bw), acc0, 0, 0, 0);
                  acc1 = __builtin_amdgcn_mfma_f32_32x32x16_bf16(__builtin_bit_cast(bf16x8_t, aw1), __builtin_bit_cast(bf16x8_t, bw), acc1, 0, 0, 0);
              } } }
        __syncthreads();
        const int xcol = (o + 1) * HY_W + c;
        HY_STAGE_RAW(xg, xcol, tid_o);
        __syncthreads();
        { const int ir = tid_o & 31, hh = (tid_o >> 5) & 1, bc = ir & 7, I = 4 * b + (ir >> 3); const float skip = F.in[I_HYSKIP][(li * 2 + o) * HY_W + c]; const int rowbase = seg ? NL + bc * LC : bc * SEQ;
          if (I < nI) {
#pragma unroll
              for (int ti = 0; ti < 2; ++ti)
#pragma unroll
                  for (int r = 0; r < 16; ++r) { const int i = 32 * ti + (r & 3) + 8 * (r >> 2) + 4 * hh; const int idx = bc * zb + I * HY_ZS + i;
                      const float a = ti == 0 ? acc0[r] : acc1[r]; const int tq = 64 * I + i; const float zn = HY_CONV(xg, bc, tq, xcol) * (a + skip * bf2f(zin[idx]));
                      if (o == 0) zout[idx] = (bf16)f2bf(zn); else { if (dry) U[(size_t)(rowbase + 64 * I + i) * UA_W + 3456 + (c & 127)] = (bf16)f2bf(zn); else F.wsp<bf16>(WS_RB + RB_YHY)[(size_t)(rowbase + 64 * I + i) * HY_W + c] = (bf16)f2bf(zn); } } } }
        LAS bf16* tmp = zin; zin = zout; zout = tmp;
    }
    __syncthreads();
#undef HY_STAGE_RAW
#undef HY_CONV
}


constexpr int NA_KS = 72;
constexpr int NA_BUF = 2 * 64 * NA_KS * 2 + 256;
template <int kind>
__device__ __forceinline__ void na_job(Frame& F, int li, int b, int h, int gi, int dry) {
    const int lane = F.lane, r = lane & 15, g = lane >> 4, w = F.wave, qg = w & 3, kh = w >> 2;
    bf16* U = F.wsp<bf16>(WS_R1);
    LAS unsigned char* L = F.lds;
    LAS float* rpbs = (LAS float*)(L + 4 * NA_BUF);
    LAS float* comb = (LAS float*)(L + 4 * NA_BUF + 2048);
    const int r0 = min(max(gi - 4, 0), 24);
    const int qrow0 = (kind == 0 ? b * SEQ + gi * 64 : NL + b * LC + gi * 64) + qg * 16;
    const int nloc = kind == 0 ? 8 : 0, nsteps = nloc + 4;
    __syncthreads();
    { const float* rp = F.in[I_NARPB] + (size_t)(li * 6 + h) * 465; if (F.tid < 465) rpbs[F.tid] = rp[F.tid]; }
    bf16x8_t aq[2];
    { const bf16* qp = U + (size_t)(qrow0 + r) * UA_W + UA_NA + h * 64 + 8 * g; float x0[8], x1[8]; unpack8(*(const v4u*)qp, x0); unpack8(*(const v4u*)(qp + 32), x1);
      float ss = 0.f;
#pragma unroll
      for (int e = 0; e < 8; ++e) ss += x0[e] * x0[e] + x1[e] * x1[e];
      ss += __shfl_xor(ss, 16); ss += __shfl_xor(ss, 32);
      const float rq = 0.125f / sqrtf(ss * (1.f / 64.f) + NORM_EPS);
      const float* qg_ = F.in[I_NAQG] + li * 64 + 8 * g; const float* kg_ = F.in[I_NAKG] + li * 64 + 8 * g;
#pragma unroll
      for (int e = 0; e < 8; ++e) { x0[e] *= rq * qg_[e] * kg_[e]; x1[e] *= rq * qg_[32 + e] * kg_[32 + e]; }
      aq[0] = __builtin_bit_cast(bf16x8_t, pack8(x0)); aq[1] = __builtin_bit_cast(bf16x8_t, pack8(x1)); }
    const int qj = qg * 16 + r, c0q = min(max(qj - 8, 0), 48);
    const int wlo = min(max(qg * 16 - 8, 0), 48), whi = min(max(qg * 16 + 15 - 8, 0), 48) + 15;
    const bool half_live = !(32 * kh > whi || 32 * kh + 31 < wlo);
    float lsum = 0.f;
    f32x4 O[4];
#pragma unroll
    for (int dt = 0; dt < 4; ++dt) O[dt] = (f32x4){0.f, 0.f, 0.f, 0.f};
    const int sx = F.tid >> 3, sp = F.tid & 7;
    const int cvs = h * 64 + sx, q6s = (cvs * 10923) >> 16, vsoff = q6s * UA_W + 3072 + (cvs - 6 * q6s) * 64 + 8 * sp;
    const int nst2 = nsteps >> 1;
#define NA_KROW0(rw_) (((rw_) < nloc) ? (b * SEQ + (r0 + (rw_)) * 64) : (NL + b * LC + 64 * ((rw_) - nloc)))
    v4u kA[2], vA[2], kB[2], vB[2];
#define NA_GLOAD(s_, K_, V_) do { _Pragma("unroll") for (int u_ = 0; u_ < 2; ++u_) { const int kb_ = NA_KROW0(2 * (s_) + u_); \
        K_[u_] = *(const v4u*)(U + (size_t)(kb_ + sx) * UA_W + UA_NA + NA_W + h * 64 + 8 * sp); V_[u_] = *(const v4u*)(U + (size_t)kb_ * UA_W + vsoff); } } while (0)
#define NA_LSTORE(buf_, K_, V_) do { _Pragma("unroll") for (int u_ = 0; u_ < 2; ++u_) { LAS unsigned char* B_ = L + (buf_) * (2 * NA_BUF) + u_ * NA_BUF; float y_[8]; unpack8(K_[u_], y_); float ss_ = 0.f; \
        _Pragma("unroll") for (int e = 0; e < 8; ++e) ss_ += y_[e] * y_[e]; \
        ss_ += __shfl_xor(ss_, 1); ss_ += __shfl_xor(ss_, 2); ss_ += __shfl_xor(ss_, 4); \
        *(LAS v4u*)((LAS bf16*)B_ + sx * NA_KS + 8 * sp) = K_[u_]; *(LAS v4u*)((LAS bf16*)(B_ + 64 * NA_KS * 2) + sx * NA_KS + 8 * sp) = V_[u_]; \
        if (sp == 0) ((LAS float*)(B_ + 2 * 64 * NA_KS * 2))[sx] = 1.0f / sqrtf(ss_ * (1.f / 64.f) + NORM_EPS); } } while (0)
    NA_GLOAD(0, kA, vA); NA_LSTORE(0, kA, vA);
    { const int s1 = 1 < nst2 ? 1 : 0; NA_GLOAD(s1, kA, vA); }
    __syncthreads();
#pragma unroll 1
    for (int s = 0; s < nst2; ++s) {
        { const int s2 = s + 2 < nst2 ? s + 2 : nst2 - 1; NA_GLOAD(s2, kB, vB); }
#pragma unroll
        for (int u = 0; u < 2; ++u) { const int rw = 2 * s + u; const bool loc = rw < nloc;
          if (!loc || half_live) {
            LAS unsigned char* B_ = L + (s & 1) * (2 * NA_BUF) + u * NA_BUF; const LAS bf16* Ks = (const LAS bf16*)B_; const LAS bf16* Vt = (const LAS bf16*)(B_ + 64 * NA_KS * 2); const LAS float* rks = (const LAS float*)(B_ + 2 * 64 * NA_KS * 2);
            float p[8];
#pragma unroll
            for (int kt = 0; kt < 2; ++kt) { const int key0 = 32 * kh + 16 * kt;
                const bf16x8_t k0 = *(const LAS bf16x8_t*)(Ks + (key0 + r) * NA_KS + 8 * g), k1 = *(const LAS bf16x8_t*)(Ks + (key0 + r) * NA_KS + 32 + 8 * g);
                const f32x4 rk = *(const LAS f32x4*)(rks + key0 + 4 * g);
                f32x4 acc = {0.f, 0.f, 0.f, 0.f};
                acc = __builtin_amdgcn_mfma_f32_16x16x32_bf16(k0, aq[0], acc, 0, 0, 0);
                acc = __builtin_amdgcn_mfma_f32_16x16x32_bf16(k1, aq[1], acc, 0, 0, 0);
#pragma unroll
                for (int e = 0; e < 4; ++e) { float v = acc[e] * rk[e]; bool ok = true;
                    if (loc) { const int kcol = key0 + 4 * g + e; ok = kcol >= c0q && kcol < c0q + 16; const int dr = r0 + rw - gi + 7, dc = min(max(kcol - qj + 15, 0), 30); v += rpbs[dr * 31 + dc]; }
                    const float pe = ok ? __expf(v) : 0.f; lsum += pe; p[4 * kt + e] = pe; } }
            const v4u pw = {pg8::cvt_pk_bf16(p[0], p[1]), pg8::cvt_pk_bf16(p[2], p[3]), pg8::cvt_pk_bf16(p[4], p[5]), pg8::cvt_pk_bf16(p[6], p[7])}; const bf16x8_t pb = __builtin_bit_cast(bf16x8_t, pw);
#pragma unroll
            for (int dt = 0; dt < 4; ++dt) { const v2u va = *(const LAS v2u*)(Vt + (16 * dt + r) * NA_KS + 32 * kh + 4 * g), vb = *(const LAS v2u*)(Vt + (16 * dt + r) * NA_KS + 32 * kh + 16 + 4 * g);
                const v4u vw = {va.x, va.y, vb.x, vb.y};
                O[dt] = __builtin_amdgcn_mfma_f32_16x16x32_bf16(__builtin_bit_cast(bf16x8_t, vw), pb, O[dt], 0, 0, 0); }
          } }
        NA_LSTORE((s + 1) & 1, kA, vA);
#pragma unroll
        for (int u = 0; u < 2; ++u) { kA[u] = kB[u]; vA[u] = vB[u]; }
        __syncthreads();
    }
#undef NA_KROW0
#undef NA_GLOAD
#undef NA_LSTORE
    if (kh == 1) { LAS float* cp = comb + (qg * 64 + lane) * 17;
#pragma unroll
        for (int dt = 0; dt < 4; ++dt)
#pragma unroll
            for (int e = 0; e < 4; ++e) cp[4 * dt + e] = O[dt][e];
        cp[16] = lsum; }
    __syncthreads();
    if (kh == 0) { const LAS float* cp = comb + (qg * 64 + lane) * 17;
#pragma unroll
        for (int dt = 0; dt < 4; ++dt)
#pragma unroll
            for (int e = 0; e < 4; ++e) O[dt][e] += cp[4 * dt + e];
        lsum += cp[16];
        lsum += __shfl_xor(lsum, 16); lsum += __shfl_xor(lsum, 32);
        const float inv = 1.0f / lsum;
        bf16* op = U + (size_t)(qrow0 + r) * UA_W + (dry ? 3456 + (h & 1) * 64 : UA_NA + h * 64) + 4 * g;
#pragma unroll
        for (int dt = 0; dt < 4; ++dt) *(v2u*)(op + 16 * dt) = (v2u){pk2(O[dt][0] * inv, O[dt][1] * inv), pk2(O[dt][2] * inv, O[dt][3] * inv)}; }
}

__device__ __forceinline__ void na2_job(Frame& F, int li, int b, int h, int gp, int dry) {
    const int lane = F.lane, r = lane & 15, g = lane >> 4, w = F.wave, qg = w & 3, qi = w >> 2;
    bf16* U = F.wsp<bf16>(WS_R1);
    LAS unsigned char* L = F.lds;
    LAS float* rpbs = (LAS float*)(L + 4 * NA_BUF) + 16;
    const int gi = 2 * gp + qi, r0 = min(max(gi - 4, 0), 24), R0 = min(max(2 * gp - 4, 0), 24);
    const int qrow0 = b * SEQ + gi * 64 + qg * 16;
    __syncthreads();
    { const float* rp = F.in[I_NARPB] + (size_t)(li * 6 + h) * 465; if (F.tid < 497) rpbs[F.tid - 16] = (F.tid >= 16 && F.tid < 481) ? rp[F.tid - 16] : 0.f; }
    bf16x8_t aq[2];
    { const bf16* qp = U + (size_t)(qrow0 + r) * UA_W + UA_NA + h * 64 + 8 * g; float x0[8], x1[8]; unpack8(*(const v4u*)qp, x0); unpack8(*(const v4u*)(qp + 32), x1);
      float ss = 0.f;
#pragma unroll
      for (int e = 0; e < 8; ++e) ss += x0[e] * x0[e] + x1[e] * x1[e];
      ss += __shfl_xor(ss, 16); ss += __shfl_xor(ss, 32);
      const float rq = 0.125f / sqrtf(ss * (1.f / 64.f) + NORM_EPS);
      const float* qg_ = F.in[I_NAQG] + li * 64 + 8 * g; const float* kg_ = F.in[I_NAKG] + li * 64 + 8 * g;
#pragma unroll
      for (int e = 0; e < 8; ++e) { x0[e] *= rq * qg_[e] * kg_[e]; x1[e] *= rq * qg_[32 + e] * kg_[32 + e]; }
      aq[0] = __builtin_bit_cast(bf16x8_t, pack8(x0)); aq[1] = __builtin_bit_cast(bf16x8_t, pack8(x1)); }
    const int qj = qg * 16 + r, c0q = min(max(qj - 8, 0), 48);
    const int ks = qg == 0 ? 0 : (qg == 1 ? 8 : (qg == 2 ? 24 : 32));
    float lsum = 0.f;
    f32x4 O[4];
#pragma unroll
    for (int dt = 0; dt < 4; ++dt) O[dt] = (f32x4){0.f, 0.f, 0.f, 0.f};
    const int sx = F.tid >> 3, sp = F.tid & 7;
    const int cvs = h * 64 + sx, q6s = (cvs * 10923) >> 16, vsoff = q6s * UA_W + 3072 + (cvs - 6 * q6s) * 64 + 8 * sp;
    constexpr int NBLK = 13, NST = 7;
#define NA2_KROW0(bk_) (((bk_) < 9) ? (b * SEQ + min(R0 + (bk_), 31) * 64) : (NL + b * LC + 64 * ((bk_) - 9)))
    v4u kA[2], vA[2], kB[2], vB[2];
#define NA2_GLOAD(s_, K_, V_) do { _Pragma("unroll") for (int u_ = 0; u_ < 2; ++u_) { const int bk_ = min(2 * (s_) + u_, NBLK - 1); const int kb_ = NA2_KROW0(bk_); \
        K_[u_] = *(const v4u*)(U + (size_t)(kb_ + sx) * UA_W + UA_NA + NA_W + h * 64 + 8 * sp); V_[u_] = *(const v4u*)(U + (size_t)kb_ * UA_W + vsoff); } } while (0)
#define NA2_LSTORE(buf_, K_, V_) do { _Pragma("unroll") for (int u_ = 0; u_ < 2; ++u_) { LAS unsigned char* B_ = L + (buf_) * (2 * NA_BUF) + u_ * NA_BUF; float y_[8]; unpack8(K_[u_], y_); float ss_ = 0.f; \
        _Pragma("unroll") for (int e = 0; e < 8; ++e) ss_ += y_[e] * y_[e]; \
        ss_ += __shfl_xor(ss_, 1); ss_ += __shfl_xor(ss_, 2); ss_ += __shfl_xor(ss_, 4); \
        *(LAS v4u*)((LAS bf16*)B_ + sx * NA_KS + 8 * sp) = K_[u_]; *(LAS v4u*)((LAS bf16*)(B_ + 64 * NA_KS * 2) + sx * NA_KS + 8 * sp) = V_[u_]; \
        if (sp == 0) ((LAS float*)(B_ + 2 * 64 * NA_KS * 2))[sx] = 1.0f / sqrtf(ss_ * (1.f / 64.f) + NORM_EPS); } } while (0)
#define NA2_PASS(kb_, HASB_, BS_) do { float p[8]; \
        _Pragma("unroll") for (int kt = 0; kt < 2; ++kt) { const int key0 = (kb_) + 16 * kt; \
            const bf16x8_t k0 = *(const LAS bf16x8_t*)(Ks + (key0 + r) * NA_KS + 8 * g), k1 = *(const LAS bf16x8_t*)(Ks + (key0 + r) * NA_KS + 32 + 8 * g); \
            const f32x4 rk = *(const LAS f32x4*)(rks + key0 + 4 * g); \
            f32x4 acc = {0.f, 0.f, 0.f, 0.f}; \
            acc = __builtin_amdgcn_mfma_f32_16x16x32_bf16(k0, aq[0], acc, 0, 0, 0); \
            acc = __builtin_amdgcn_mfma_f32_16x16x32_bf16(k1, aq[1], acc, 0, 0, 0); \
            _Pragma("unroll") for (int e = 0; e < 4; ++e) { const float pe = __expf(HASB_ ? fmaf(acc[e], rk[e], (BS_)[4 * kt + e]) : acc[e] * rk[e]); lsum += pe; p[4 * kt + e] = pe; } } \
        const v4u pw = {pg8::cvt_pk_bf16(p[0], p[1]), pg8::cvt_pk_bf16(p[2], p[3]), pg8::cvt_pk_bf16(p[4], p[5]), pg8::cvt_pk_bf16(p[6], p[7])}; const bf16x8_t pb = __builtin_bit_cast(bf16x8_t, pw); \
        _Pragma("unroll") for (int dt = 0; dt < 4; ++dt) { const v2u va = *(const LAS v2u*)(Vt + (16 * dt + r) * NA_KS + (kb_) + 4 * g), vb = *(const LAS v2u*)(Vt + (16 * dt + r) * NA_KS + (kb_) + 16 + 4 * g); \
            const v4u vw = {va.x, va.y, vb.x, vb.y}; \
            O[dt] = __builtin_amdgcn_mfma_f32_16x16x32_bf16(__builtin_bit_cast(bf16x8_t, vw), pb, O[dt], 0, 0, 0); } } while (0)
    NA2_GLOAD(0, kA, vA); NA2_LSTORE(0, kA, vA);
    NA2_GLOAD(1, kA, vA);
    __syncthreads();
    float mk[8];
#pragma unroll
    for (int j = 0; j < 8; ++j) { const int kcol = ks + 16 * (j >> 2) + 4 * g + (j & 3); mk[j] = (kcol >= c0q && kcol < c0q + 16) ? 0.f : -1.0e30f; }
    const int bcol = ks + 4 * g - qj + 15;
#pragma unroll 1
    for (int s = 0; s < NST; ++s) {
        { const int s2 = s + 2 < NST ? s + 2 : NST - 1; NA2_GLOAD(s2, kB, vB); }
#pragma unroll
        for (int u = 0; u < 2; ++u) { const int bk = 2 * s + u;
          if (bk < NBLK) {
            LAS unsigned char* B_ = L + (s & 1) * (2 * NA_BUF) + u * NA_BUF; const LAS bf16* Ks = (const LAS bf16*)B_; const LAS bf16* Vt = (const LAS bf16*)(B_ + 64 * NA_KS * 2); const LAS float* rks = (const LAS float*)(B_ + 2 * 64 * NA_KS * 2);
            if (bk < 9) { const int krow = R0 + bk;
                if (krow >= r0 && krow < r0 + 8) { const LAS float* bp = rpbs + (krow - gi + 7) * 31 + bcol; float bs[8];
#pragma unroll
                    for (int j = 0; j < 8; ++j) bs[j] = bp[16 * (j >> 2) + (j & 3)] + mk[j];
                    NA2_PASS(ks, true, bs); } }
            else { NA2_PASS(0, false, mk); NA2_PASS(32, false, mk); }
          } }
        NA2_LSTORE((s + 1) & 1, kA, vA);
#pragma unroll
        for (int u = 0; u < 2; ++u) { kA[u] = kB[u]; vA[u] = vB[u]; }
        __syncthreads();
    }
#undef NA2_PASS
#undef NA2_KROW0
#undef NA2_GLOAD
#undef NA2_LSTORE
    lsum += __shfl_xor(lsum, 16); lsum += __shfl_xor(lsum, 32);
    const float inv = 1.0f / lsum;
    bf16* op = U + (size_t)(qrow0 + r) * UA_W + (dry ? 3456 + (h & 1) * 64 : UA_NA + h * 64) + 4 * g;
#pragma unroll
    for (int dt = 0; dt < 4; ++dt) *(v2u*)(op + 16 * dt) = (v2u){pk2(O[dt][0] * inv, O[dt][1] * inv), pk2(O[dt][2] * inv, O[dt][3] * inv)};
}

constexpr int CW_HYQ = 9216, CW_ROQ = 9216 + 64;
__device__ __forceinline__ void p4_hy_na(Frame& F, int li, int dry) {
    unsigned* qh = (unsigned*)(F.ws + WS_CTL) + CW_HYQ + li + 4 * dry;
    volatile LAS unsigned* slot = (volatile LAS unsigned*)(F.lds + LDS_CTL_OFF) + 16;
    const int nhl = (dry && (PROBE_SUB == 2 || PROBE_SUB == 3)) ? 0 : 256, nhc = (dry && (PROBE_SUB == 2 || PROBE_SUB == 3)) ? 0 : (li == 0 ? 256 : 0);
    const int nnl = (dry && (PROBE_SUB == 1 || PROBE_SUB == 3)) ? 0 : 768, nnc = (dry && (PROBE_SUB == 1 || PROBE_SUB == 3)) ? 0 : (li == 0 ? 192 : 0);
#pragma unroll 1
    for (;;) {
        __syncthreads();
        if (F.tid == 0) *slot = __hip_atomic_fetch_add(qh, 1u, __ATOMIC_RELAXED, __HIP_MEMORY_SCOPE_AGENT);
        __syncthreads();
        int job = (int)*slot;
        if (job >= nhl + nnl + nhc + nnc) break;
        if (job < nhl) { hy_job_mfma(F, li, 0, job, dry); continue; } job -= nhl;
        if (job < nnl) { const int bb = job / 96, q = job % 96; na2_job(F, li, bb, q >> 4, q & 15, dry); continue; } job -= nnl;
        if (job < nhc) { hy_job_mfma(F, li, 1, job, dry); continue; } job -= nhc;
        { const int bb = job / 24, q = job % 24; na_job<1>(F, li, bb, q >> 2, q & 3, dry); }
    }
    __syncthreads();
}

constexpr int PPL = 14;
constexpr int N_PHASES = 1 + PPL * NLAYER + 1;
#define IN(k) (lo <= (k) && (k) < hi)
#define SEAM(k) do { if (IN(k) && IN((k) + 1)) xcd_barrier(bar); } while (0)
template <int li> __device__ __forceinline__ void layer_body(Frame& F, const int lo, const int hi, const XcdBarrier& bar) {
    LAS unsigned char* L = F.lds;
    constexpr int pb = 1 + PPL * li;
    constexpr bool last = li == NLAYER - 1;
    constexpr int Mrows = last ? NL : MT;
    bf16* const RA = F.wsp<bf16>(WS_RA); bf16* const UA = F.wsp<bf16>(WS_R1); bf16* const GT = F.wsp<bf16>(WS_WM13);
    const bf16* const WIN = F.wsp<bf16>(WS_WIN + li * SZ_WIN1);
    if (IN(pb + 0)) { for (int rep_ = 0; rep_ < (PROBE_ID == (pb + 0) ? PROBE_REPS : 1); ++rep_) { const int dry = rep_ > 0; (void)dry; F.fresh(); if (rep_) { VM_WAIT(); __syncthreads(); } p1_norm1(F, li); } } SEAM(pb + 0);
    if (IN(pb + 1)) { for (int rep_ = 0; rep_ < (PROBE_ID == (pb + 1) ? PROBE_REPS : 1); ++rep_) { const int dry = rep_ > 0; (void)dry; F.fresh(); if (rep_) { VM_WAIT(); __syncthreads(); }
        pg8::Gemm g{RA, WIN, MT, UA_W, D, D}; pg8::StaticOrder S; S.init(MT, UA_W, F.G, F.bid);
        EpiBf16S<0> E{UA, UA_W, 1.0f};
        GEMM_CALL(EpiBf16S<0>, pg8::StaticOrder, L, g, S, E);
    } } SEAM(pb + 1);
    if (IN(pb + 2)) { for (int rep_ = 0; rep_ < (PROBE_ID == (pb + 2) ? PROBE_REPS : 1); ++rep_) { const int dry = rep_ > 0; (void)dry; F.fresh(); if (rep_) { VM_WAIT(); __syncthreads(); } p3_rw_features(F, li); } } SEAM(pb + 2);
    if (IN(pb + 3)) { for (int rep_ = 0; rep_ < (PROBE_ID == (pb + 3) ? PROBE_REPS : 1); ++rep_) { const int dry = rep_ > 0; (void)dry; F.fresh(); if (rep_) { VM_WAIT(); __syncthreads(); }
#pragma unroll 1
        for (int job = F.bid; job < NCHAIN * NCHUNK; job += F.G) rw_phaseA_job(F, li, job / NCHUNK, job % NCHUNK);
    } } SEAM(pb + 3);
    if (IN(pb + 4)) { for (int rep_ = 0; rep_ < (PROBE_ID == (pb + 4) ? PROBE_REPS : 1); ++rep_) { const int dry = rep_ > 0; (void)dry; F.fresh(); if (rep_) { VM_WAIT(); __syncthreads(); }
        if (F.bid < NCHAIN && !(dry && (PROBE_SUB == 1 || PROBE_SUB == 2))) rw_phaseB_chain(F, F.bid, dry);
        p4_hy_na(F, li, dry);
    } } SEAM(pb + 4);
    if (IN(pb + 5)) { for (int rep_ = 0; rep_ < (PROBE_ID == (pb + 5) ? PROBE_REPS : 1); ++rep_) { const int dry = rep_ > 0; (void)dry; F.fresh(); if (rep_) { VM_WAIT(); __syncthreads(); }
#pragma unroll 1
        for (int job = F.bid; job < NCHAIN * NCHUNK; job += F.G) rw_phaseC_job(F, li, job / NCHUNK, job % NCHUNK, dry);
    } } SEAM(pb + 5);
    if (IN(pb + 6)) { for (int rep_ = 0; rep_ < (PROBE_ID == (pb + 6) ? PROBE_REPS : 1); ++rep_) { const int dry = rep_ > 0; (void)dry; F.fresh(); if (rep_) { VM_WAIT(); __syncthreads(); }
        { pg8::Gemm g{(const bf16*)A1F8_PTR(F, li), WIN + (size_t)UA_W * D, Mrows, GATE_IN, D, D}; pg8::StaticOrder S; S.init(Mrows, GATE_IN, F.G, F.bid);
          EpiBf16S<1> E{GT, GATE_IN, 1.0f / 32.0f};
          GEMM_CALL_F8(EpiBf16S<1>, pg8::StaticOrder, L, g, S, E); }
        { unsigned* qr = (unsigned*)(F.ws + WS_CTL) + CW_ROQ + li + 4 * dry; volatile LAS unsigned* slot = (volatile LAS unsigned*)(F.lds + LDS_CTL_OFF) + 20;
#pragma unroll 1
          for (;;) { __syncthreads();
              if (F.tid == 0) *slot = __hip_atomic_fetch_add(qr, 1u, __ATOMIC_RELAXED, __HIP_MEMORY_SCOPE_AGENT);
              __syncthreads();
              const int blk = (int)*slot; if (blk >= Mrows / 64) break;
              p5_rw_readout(F, li, blk * 64, blk * 64 + 64); } }
    } } SEAM(pb + 6);
    if (IN(pb + 8)) { for (int rep_ = 0; rep_ < (PROBE_ID == (pb + 8) ? PROBE_REPS : 1); ++rep_) { const int dry = rep_ > 0; (void)dry; F.fresh(); if (rep_) { VM_WAIT(); __syncthreads(); }
        const bf16* WBR = F.wsp<bf16>(WS_WBR + li * SZ_WBR1);
        { pg8::Gemm g{UA, WBR, Mrows, D, RW_W, UA_W}; pg8::StaticOrder S; S.init(Mrows, D, F.G, F.bid); EpiMerge<0> E{GT, GATE_IN, RA};
          GEMM_CALL(EpiMerge<0>, pg8::StaticOrder, L, g, S, E); }
        VM_WAIT(); __syncthreads();
        { pg8::Gemm g{F.wsp<bf16>(WS_RB + RB_YHY), WBR + (size_t)D * RW_W, Mrows, D, HY_W, HY_W}; pg8::StaticOrder S; S.init(Mrows, D, F.G, F.bid); EpiMerge<1> E{GT + D, GATE_IN, RA};
          GEMM_CALL(EpiMerge<1>, pg8::StaticOrder, L, g, S, E); }
        VM_WAIT(); __syncthreads();
        { pg8::Gemm g{UA + UA_NA, WBR + (size_t)D * (RW_W + HY_W), Mrows, D, NA_W, UA_W}; pg8::StaticOrder S; S.init(Mrows, D, F.G, F.bid); EpiMerge<1> E{GT + 2 * D, GATE_IN, RA};
          GEMM_CALL(EpiMerge<1>, pg8::StaticOrder, L, g, S, E); }
    } } SEAM(pb + 8);
    if (IN(pb + 9)) { for (int rep_ = 0; rep_ < (PROBE_ID == (pb + 9) ? PROBE_REPS : 1); ++rep_) { const int dry = rep_ > 0; (void)dry; F.fresh(); if (rep_) { VM_WAIT(); __syncthreads(); }
        pg8::Gemm g{RA, F.wsp<bf16>(WS_WOUT + li * SZ_WOUT1), Mrows, D, D, D}; pg8::StaticOrder S; S.init(Mrows, D, F.G, F.bid);
        EpiRes E{li == 0 ? F.in[I_X] : F.out, F.out, li == 0 ? F.in[I_CTX] : F.wsp<float>(WS_CTXRES), F.wsp<float>(WS_CTXRES), F.mods(li, 0), 2 * D, (dry && li > 0) ? 0.f : 1.f};
        GEMM_CALL(EpiRes, pg8::StaticOrder, L, g, S, E);
    } } SEAM(pb + 9);
    if (IN(pb + 10)) { for (int rep_ = 0; rep_ < (PROBE_ID == (pb + 10) ? PROBE_REPS : 1); ++rep_) { const int dry = rep_ > 0; (void)dry; F.fresh(); if (rep_) { VM_WAIT(); __syncthreads(); } p8_norm2(F, li, dry); if (last) { __syncthreads(); moe_weight_transposes(F, 1, 0, F.G); } } } SEAM(pb + 10);
    if (!last) {
        if (IN(pb + 11) && IN(pb + 12)) {}
        if (IN(pb + 12)) { for (int rep_ = 0; rep_ < (PROBE_ID == (pb + 12) ? PROBE_REPS : 1); ++rep_) { const int dry = rep_ > 0; (void)dry; F.fresh(); if (rep_) { VM_WAIT(); __syncthreads(); }
            pg8::Gemm g{RA, F.wsp<bf16>(WS_WFF13), MT, 2 * FF, D, D}; pg8::StaticOrder S; S.init(MT, 2 * FF, F.G, F.bid);
            EpiSwiGLU<false> E{F.wsp<bf16>(WS_R1), FF, 2 * FF / 256, 1.0f};
            GEMM_CALL(EpiSwiGLU<false>, pg8::StaticOrder, L, g, S, E);
        } } SEAM(pb + 12);
        if (IN(pb + 13)) { for (int rep_ = 0; rep_ < (PROBE_ID == (pb + 13) ? PROBE_REPS : 1); ++rep_) { const int dry = rep_ > 0; (void)dry; F.fresh(); if (rep_) { VM_WAIT(); __syncthreads(); }
            pg8::Gemm g{F.wsp<bf16>(WS_R1), F.wsp<bf16>(WS_WFF2), MT, D, FF, FF}; pg8::StaticOrder S; S.init(MT, D, F.G, F.bid);
            EpiRes E{F.out, F.out, F.wsp<float>(WS_CTXRES), F.wsp<float>(WS_CTXRES), F.mods(li, 0), 5 * D, dry ? 0.f : 1.f};
            GEMM_CALL(EpiRes, pg8::StaticOrder, L, g, S, E);
            if (!dry) { const int busy = MT / 256 * (D / 256) - F.G; if (busy > 0 && busy < F.G) { __syncthreads(); moe_weight_transposes(F, 0, busy, F.G - busy); } else { __syncthreads(); moe_weight_transposes(F, 0, 0, F.G); } }
        } } SEAM(pb + 13);
    } else {
        if (IN(pb + 11)) { for (int rep_ = 0; rep_ < (PROBE_ID == (pb + 11) ? PROBE_REPS : 1); ++rep_) { const int dry = rep_ > 0; (void)dry; F.fresh(); if (rep_) { VM_WAIT(); __syncthreads(); } p8b_gather(F); } } SEAM(pb + 11);
        const unsigned* cnt = (const unsigned*)(F.ws + WS_CTL) + CW_MOECNT;
        if (IN(pb + 12)) { for (int rep_ = 0; rep_ < (PROBE_ID == (pb + 12) ? PROBE_REPS : 1); ++rep_) { const int dry = rep_ > 0; (void)dry; F.fresh(); if (rep_) { VM_WAIT(); __syncthreads(); }
            pg8::Gemm g{RA, F.wsp<bf16>(WS_W13F8), MOE_ROWS, 2 * FFE, D, D}; pg8::MoeOrder S; S.init(cnt, 2 * FFE / 256, F.G, F.bid);
            EpiSwiGLU<true> E{F.wsp<bf16>(WS_R1), FFE, 2 * FFE / 256, 1.0f / 32.0f};
            GEMM_CALL_F8(EpiSwiGLU<true>, pg8::MoeOrder, L, g, S, E);
        } } SEAM(pb + 12);
        if (IN(pb + 13)) { for (int rep_ = 0; rep_ < (PROBE_ID == (pb + 13) ? PROBE_REPS : 1); ++rep_) { const int dry = rep_ > 0; (void)dry; F.fresh(); if (rep_) { VM_WAIT(); __syncthreads(); }
            pg8::Gemm g{F.wsp<bf16>(WS_R1), F.wsp<bf16>(WS_W2F8), MOE_ROWS, D, FFE, FFE}; pg8::MoeOrder S; S.init(cnt, D / 256, F.G, F.bid);
            EpiMoeY E{RA, 1.0f / 256.0f};
            GEMM_CALL_F8(EpiMoeY, pg8::MoeOrder, L, g, S, E);
        } } SEAM(pb + 13);
        if (IN(pb + 14)) { for (int rep_ = 0; rep_ < (PROBE_ID == (pb + 14) ? PROBE_REPS : 1); ++rep_) { const int dry = rep_ > 0; (void)dry; F.fresh(); if (rep_) { VM_WAIT(); __syncthreads(); } p11_moe_combine(F, li, dry); } }
    }
}
#undef IN
#undef SEAM
__global__ void __launch_bounds__(NTHREADS, 2) fwd_kernel(Args args) {
    extern __shared__ __attribute__((aligned(16))) unsigned char lds_raw[];
    Frame F;
    F.lds = (LAS unsigned char*)lds_raw;
    F.tid = threadIdx.x; F.lane = F.tid & 63; F.wave = __builtin_amdgcn_readfirstlane(F.tid >> 6);
    F.G = gridDim.x; F.bid = blockIdx.x;
    F.in = (const CAS cfp*)__builtin_amdgcn_kernarg_segment_ptr(); F.out = args.out; F.ws = args.ws;
    volatile LAS unsigned* MISC = (volatile LAS unsigned*)(F.lds + LDS_CTL_OFF);
    if (F.tid < 64) MISC[F.tid] = 0u;
    __syncthreads();
    const int lo = args.ph_lo, hi = args.ph_hi;
    XcdBarrier bar; bar.bar = (unsigned*)(F.ws + WS_CTL) + CW_BAR; bar.x = 0; bar.st = nullptr;
    if (hi - lo > 1) bar = xcd_barrier_post((unsigned*)(F.ws + WS_CTL) + CW_BAR, MISC + 8);
    if (lo <= 0 && 0 < hi) { for (int rep_ = 0; rep_ < (PROBE_ID == 0 ? PROBE_REPS : 1); ++rep_) { F.fresh(); if (rep_) { VM_WAIT(); __syncthreads(); } p0_prologue(F); } }
    if (lo <= 0 && 1 < hi) xcd_barrier(bar);
    layer_body<0>(F, lo, hi, bar);
    layer_body<1>(F, lo, hi, bar);
}

extern "C" void kernel_launch(void* const* d_in, const int* in_sizes, int n_in, void* d_out, int out_size, void* d_ws, size_t ws_size, hipStream_t stream) {
    static int grid = 0;
    if (grid == 0) {
        if (n_in != N_IN || out_size != NL * D || ws_size < WS_END) { fprintf(stderr, "kernel_launch: shape/workspace mismatch (n_in %d, out %d, ws %zu, need %zu); nothing launched\n", n_in, out_size, ws_size, (size_t)WS_END); grid = -1; return; }
        int dev = 0, cus = 0, per_cu = 0;
        if (hipGetDevice(&dev) != hipSuccess || hipDeviceGetAttribute(&cus, hipDeviceAttributeMultiprocessorCount, dev) != hipSuccess) { grid = -1; return; }
        if (hipFuncSetAttribute((const void*)fwd_kernel, hipFuncAttributeMaxDynamicSharedMemorySize, LDS_BYTES) != hipSuccess) { fprintf(stderr, "kernel_launch: hipFuncSetAttribute failed\n"); grid = -1; return; }
        if (hipOccupancyMaxActiveBlocksPerMultiprocessor(&per_cu, (const void*)fwd_kernel, NTHREADS, LDS_BYTES) != hipSuccess || per_cu < 1) fprintf(stderr, "kernel_launch: occupancy query says %d\n", per_cu);
        (void)hipGetLastError();
        grid = cus;
    }
    if (grid < 0) return;
    if (hipMemsetAsync((char*)d_ws + WS_CTL, 0, CTL_ZERO_BYTES, stream) != hipSuccess) return;
    Args a{};
    for (int i = 0; i < N_IN; ++i) a.in[i] = (const float*)d_in[i];
    a.out = (float*)d_out; a.ws = (unsigned char*)d_ws;
#if MK_ONE_LAUNCH
    a.ph_lo = 0; a.ph_hi = N_PHASES;
    hipLaunchKernelGGL(fwd_kernel, dim3(grid), dim3(NTHREADS), LDS_BYTES, stream, a);
#else
    for (int p = 0; p < N_PHASES; ++p) {
        if (p == 1 + 11) continue;
        a.ph_lo = p; a.ph_hi = p + 1;
        hipLaunchKernelGGL(fwd_kernel, dim3(grid), dim3(NTHREADS), LDS_BYTES, stream, a);
    }
#endif
}
```
